# Optimizing an MI355X kernel written in HIP

```python
import math
import jax, jax.numpy as jnp
from jax import lax
import numpy as np

D_MODEL = 1024
BATCH = 16
SEQ = 2048
DEPTH = 1

CHUNK = 64
Q_BLOCK = 128
D_MIX = D_MODEL
N_DIFF_HEADS = 4
DIFF_HEAD_DIM = 64
DIFF_V_DIM = 2 * DIFF_HEAD_DIM
D_ATTN = N_DIFF_HEADS * DIFF_V_DIM
D_RNN = D_MIX - D_ATTN
N_RNN_BLOCKS = 8
RNN_BLOCK = D_RNN // N_RNN_BLOCKS
CONV_WIDTH = 4
RG_C = 8.0
ROPE_THETA = 500000.0
ROPE_DIM = DIFF_HEAD_DIM // 4
D_FF = 2816
D_IN_PROJ = 3 * D_ATTN + 2 * D_RNN
EPS = 1e-6
NEG_INF = -1e30

kernel_name = "hybrid_diffattn_rglru_macaron"


def rms_norm(x, g):
    xf = x.astype(jnp.float32)
    y = xf * lax.rsqrt(jnp.mean(xf * xf, axis=-1, keepdims=True) + EPS)
    return (y * g.astype(jnp.float32)).astype(x.dtype)


def swiglu_ffn(h, w_in, w_out):
    gu = h @ w_in
    g, u = jnp.split(gu, 2, axis=-1)
    return (jax.nn.silu(g) * u) @ w_out


def rope_tables(positions):
    inv_freq = ROPE_THETA ** (-jnp.arange(0, ROPE_DIM, 2, dtype=jnp.float32) / ROPE_DIM)
    ang = positions.astype(jnp.float32)[..., None] * inv_freq
    return jnp.cos(ang)[:, :, None, None, :], jnp.sin(ang)[:, :, None, None, :]


def apply_partial_rope(x, cos, sin):
    xf = x.astype(jnp.float32)
    half = ROPE_DIM // 2
    x1, x2, rest = xf[..., :half], xf[..., half:ROPE_DIM], xf[..., ROPE_DIM:]
    out = jnp.concatenate([x1 * cos - x2 * sin, x2 * cos + x1 * sin, rest], axis=-1)
    return out.astype(x.dtype)


def diff_attention(q, k, v, cos, sin, q_norm, k_norm, lam, subln_norm, lambda_init):
    B, S, _ = q.shape
    q = q.reshape(B, S, N_DIFF_HEADS, 2, DIFF_HEAD_DIM)
    k = k.reshape(B, S, N_DIFF_HEADS, 2, DIFF_HEAD_DIM)
    v = v.reshape(B, S, N_DIFF_HEADS, DIFF_V_DIM)
    q = apply_partial_rope(rms_norm(q, q_norm), cos, sin)
    k = apply_partial_rope(rms_norm(k, k_norm), cos, sin)
    scale = DIFF_HEAD_DIM ** -0.5
    q = q.transpose(0, 2, 3, 1, 4) * scale
    k = k.transpose(0, 2, 3, 1, 4)
    v = v.transpose(0, 2, 1, 3)
    outs = []
    for blk in range(S // Q_BLOCK):
        q0 = blk * Q_BLOCK
        q1 = q0 + Q_BLOCK
        s = jnp.einsum('bhmqd,bhmkd->bhmqk', q[:, :, :, q0:q1], k[:, :, :, :q1]).astype(jnp.float32)
        q_chunk = (q0 + jnp.arange(Q_BLOCK)) // CHUNK
        k_chunk = jnp.arange(q1) // CHUNK
        mask = k_chunk[None, :] <= q_chunk[:, None]
        s = jnp.where(mask, s, NEG_INF)
        p = jax.nn.softmax(s, axis=-1)
        a = p[:, :, 0] - lam * p[:, :, 1]
        outs.append(jnp.einsum('bhqk,bhkd->bhqd', a.astype(v.dtype), v[:, :, :q1]))
    o = jnp.concatenate(outs, axis=2)
    o = rms_norm(o, subln_norm) * (1.0 - lambda_init)
    return o.transpose(0, 2, 1, 3).reshape(B, S, D_ATTN)


def _linear_combine(e1, e2):
    a1, b1 = e1
    a2, b2 = e2
    return a1 * a2, a2 * b1 + b2


def rg_lru_branch(xr, gate, conv_w, conv_b, w_a, b_a, w_x, b_x, a_param):
    B, S, _ = xr.shape
    xc = lax.conv_general_dilated(
        xr, conv_w[:, None, :], window_strides=(1,), padding=[(CONV_WIDTH - 1, 0)],
        dimension_numbers=('NWC', 'WIO', 'NWC'), feature_group_count=D_RNN) + conv_b
    xb = xc.reshape(B, S, N_RNN_BLOCKS, RNN_BLOCK)
    r = jax.nn.sigmoid((jnp.einsum('bsnc,ncd->bsnd', xb, w_a).reshape(B, S, D_RNN) + b_a).astype(jnp.float32))
    i = jax.nn.sigmoid((jnp.einsum('bsnc,ncd->bsnd', xb, w_x).reshape(B, S, D_RNN) + b_x).astype(jnp.float32))
    log_a = -RG_C * r * jax.nn.softplus(-a_param.astype(jnp.float32))
    a = jnp.exp(log_a)
    mult = jnp.sqrt(-jnp.expm1(2.0 * log_a))
    b = mult * i * xc.astype(jnp.float32)
    _, h = lax.associative_scan(_linear_combine, (a, b), axis=1)
    y = h * jax.nn.gelu(gate.astype(jnp.float32), approximate=True)
    return y.astype(xr.dtype)


def setup_inputs(seed: int = 0) -> dict:
    key = jax.random.key(seed)
    ks = jax.random.split(key, 26)
    f32 = jnp.float32

    def nrm(k, shape, scale):
        return jax.random.normal(k, shape, f32) * scale

    def gain(k, shape):
        return 1.0 + 0.05 * jax.random.normal(k, shape, f32)

    x = jax.random.normal(ks[0], (BATCH, SEQ, D_MODEL), f32)
    start = jax.random.randint(ks[1], (BATCH, 1), 0, 8 * SEQ, dtype=jnp.int32)
    positions = start + jnp.arange(SEQ, dtype=jnp.int32)[None, :]
    a_init = jax.random.uniform(ks[21], (DEPTH, D_RNN), f32, 0.9, 0.999)
    return {
        "x": x,
        "positions": positions,
        "ffn1_norm": gain(ks[2], (DEPTH, D_MODEL)),
        "ffn1_w_in": nrm(ks[3], (DEPTH, D_MODEL, 2 * D_FF), D_MODEL ** -0.5),
        "ffn1_w_out": nrm(ks[4], (DEPTH, D_FF, D_MODEL), D_FF ** -0.5),
        "mix_norm": gain(ks[5], (DEPTH, D_MODEL)),
        "w_in_proj": nrm(ks[6], (DEPTH, D_MODEL, D_IN_PROJ), D_MODEL ** -0.5),
        "q_norm": gain(ks[7], (DEPTH, DIFF_HEAD_DIM)),
        "k_norm": gain(ks[8], (DEPTH, DIFF_HEAD_DIM)),
        "lambda_q1": nrm(ks[9], (DEPTH, DIFF_HEAD_DIM), 0.1),
        "lambda_k1": nrm(ks[10], (DEPTH, DIFF_HEAD_DIM), 0.1),
        "lambda_q2": nrm(ks[11], (DEPTH, DIFF_HEAD_DIM), 0.1),
        "lambda_k2": nrm(ks[12], (DEPTH, DIFF_HEAD_DIM), 0.1),
        "subln_norm": gain(ks[13], (DEPTH, DIFF_V_DIM)),
        "conv_w": nrm(ks[14], (DEPTH, CONV_WIDTH, D_RNN), CONV_WIDTH ** -0.5),
        "conv_b": nrm(ks[15], (DEPTH, D_RNN), 0.01),
        "rg_w_a": nrm(ks[16], (DEPTH, N_RNN_BLOCKS, RNN_BLOCK, RNN_BLOCK), RNN_BLOCK ** -0.5),
        "rg_b_a": nrm(ks[17], (DEPTH, D_RNN), 0.01),
        "rg_w_x": nrm(ks[18], (DEPTH, N_RNN_BLOCKS, RNN_BLOCK, RNN_BLOCK), RNN_BLOCK ** -0.5),
        "rg_b_x": nrm(ks[19], (DEPTH, D_RNN), 0.01),
        "rg_a_param": jnp.log(a_init) - jnp.log1p(-a_init),
        "w_out_proj": nrm(ks[20], (DEPTH, D_MIX, D_MODEL), D_MIX ** -0.5),
        "ffn2_norm": gain(ks[22], (DEPTH, D_MODEL)),
        "ffn2_w_in": nrm(ks[23], (DEPTH, D_MODEL, 2 * D_FF), D_MODEL ** -0.5),
        "ffn2_w_out": nrm(ks[24], (DEPTH, D_FF, D_MODEL), D_FF ** -0.5),
    }


def reference(x, positions, ffn1_norm, ffn1_w_in, ffn1_w_out, mix_norm, w_in_proj,
              q_norm, k_norm, lambda_q1, lambda_k1, lambda_q2, lambda_k2, subln_norm,
              conv_w, conv_b, rg_w_a, rg_b_a, rg_w_x, rg_b_x, rg_a_param, w_out_proj,
              ffn2_norm, ffn2_w_in, ffn2_w_out):
    cos, sin = rope_tables(positions)
    for l in range(DEPTH):
        lambda_init = 0.8 - 0.6 * math.exp(-0.3 * l)
        x = x + 0.5 * swiglu_ffn(rms_norm(x, ffn1_norm[l]), ffn1_w_in[l], ffn1_w_out[l])
        h = rms_norm(x, mix_norm[l])
        proj = h @ w_in_proj[l]
        q, k, v, xr, gate = jnp.split(
            proj, [D_ATTN, 2 * D_ATTN, 3 * D_ATTN, 3 * D_ATTN + D_RNN], axis=-1)
        lam = (jnp.exp(jnp.sum(lambda_q1[l].astype(jnp.float32) * lambda_k1[l].astype(jnp.float32)))
               - jnp.exp(jnp.sum(lambda_q2[l].astype(jnp.float32) * lambda_k2[l].astype(jnp.float32)))
               + lambda_init)
        y_attn = diff_attention(q, k, v, cos, sin, q_norm[l], k_norm[l], lam,
                                subln_norm[l], lambda_init)
        y_rnn = rg_lru_branch(xr, gate, conv_w[l], conv_b[l], rg_w_a[l], rg_b_a[l],
                              rg_w_x[l], rg_b_x[l], rg_a_param[l])
        x = x + jnp.concatenate([y_attn, y_rnn], axis=-1) @ w_out_proj[l]
        x = x + 0.5 * swiglu_ffn(rms_norm(x, ffn2_norm[l]), ffn2_w_in[l], ffn2_w_out[l])
    return x
```

```cpp
#include <hip/hip_runtime.h>
#include <hip/hip_cooperative_groups.h>
#include <cstdio>
#include <cstdint>
#include <cmath>
namespace cg = cooperative_groups;

constexpr int DM = 1024, BATCH = 16, SEQ = 2048, MTOK = BATCH * SEQ;
constexpr int DFF = 2816, NFF = 2 * DFF, DATTN = 512, DRNN = 512, NPROJ = 2560;
constexpr int PQ = DFF;
constexpr float EPS = 1e-6f;
constexpr float LAMBDA_INIT = 0.2f;

typedef unsigned short bf16;
#define LAS __attribute__((address_space(3)))
typedef unsigned v4u __attribute__((ext_vector_type(4)));
typedef float v4f __attribute__((ext_vector_type(4)));

__device__ __forceinline__ unsigned f2bf(float f) { unsigned u = __builtin_bit_cast(unsigned, f); return (u + 0x7fffu + ((u >> 16) & 1u)) >> 16; }
typedef float f32x2_h __attribute__((ext_vector_type(2))); typedef __bf16 bf16x2_h __attribute__((ext_vector_type(2)));
__device__ __forceinline__ unsigned pk2(float lo, float hi) { const f32x2_h v = {lo, hi}; return __builtin_bit_cast(unsigned, __builtin_convertvector(v, bf16x2_h)); }
__device__ __forceinline__ float bf2f(bf16 h) { return __builtin_bit_cast(float, (unsigned)h << 16); }
__device__ __forceinline__ float wave_sum(float v) {
#pragma unroll
    for (int o = 1; o < 64; o <<= 1) v += __shfl_xor(v, o);
    return v;
}
__device__ __forceinline__ float rinv_of(const float* ss, size_t row) {
    const v4f* p = (const v4f*)(ss + row * 16); const v4f a = p[0], b = p[1], c = p[2], d = p[3];
    const float s = ((a.x + a.y) + (a.z + a.w)) + ((b.x + b.y) + (b.z + b.w)) + ((c.x + c.y) + (c.z + c.w)) + ((d.x + d.y) + (d.z + d.w));
    return 1.0f / sqrtf(s * (1.0f / DM) + EPS);
}

__device__ __forceinline__ float rinv_fq(const float* ss, size_t row, int fq) {
    const v4f a = *(const v4f*)(ss + row * 16 + 4 * fq); float s = (a.x + a.y) + (a.z + a.w);
    s += __shfl_xor(s, 16); s += __shfl_xor(s, 32);
    return 1.0f / sqrtf(s * (1.0f / DM) + EPS);
}

constexpr size_t MiB = 1u << 20;
constexpr size_t WS_CTL = 0;
constexpr size_t WS_W1T = 1 * MiB;
constexpr size_t WS_W2T = 12 * MiB;
constexpr size_t WS_W3T = 18 * MiB;
constexpr size_t WS_W4T = 23 * MiB;
constexpr size_t WS_W5T = 25 * MiB;
constexpr size_t WS_W6T = 36 * MiB;
constexpr size_t WS_ROPE = 42 * MiB;
constexpr size_t WS_SS = 44 * MiB;
constexpr size_t WS_XB = 50 * MiB;
constexpr size_t WS_Y = 114 * MiB;
constexpr size_t WS_ACT = 178 * MiB;
constexpr size_t WS_END = 354 * MiB;

namespace pg8 {
#define PG8_LAS __attribute__((address_space(3)))
typedef unsigned short bf16_t;
typedef short bf16x8 __attribute__((ext_vector_type(8)));
typedef float f32x4 __attribute__((ext_vector_type(4)));
typedef unsigned u32x4 __attribute__((ext_vector_type(4)));
constexpr int BM = 256, BK = 64, HALF = 128, HTB = HALF * BK * 2  , STAGE_BYTES = 8 * HTB, NXCD = 8, WGM = 8;

__host__ __device__ __forceinline__ int lds_byte(int r, int c) { const int st = (r >> 4) * 2 + (c >> 5), rr = r & 15, cc = c & 31, ob = rr * 64 + cc * 2; return st * 1024 + (ob ^ (((ob >> 9) & 1) << 5)); }
__host__ __device__ __forceinline__ void stage_rc(int b, int& R, int& C) { const int st = b / 1024, sb = b % 1024, swz = sb ^ (((sb >> 9) & 1) << 5); R = (st >> 1) * 16 + swz / 64; C = (st & 1) * 32 + (swz % 64) / 2; }
__host__ __device__ __forceinline__ int perm32(int rho) { const int n = rho >> 4, i = rho & 15; return 8 * (i >> 2) + 4 * n + (i & 3); }

struct Unit { int pm, pn; };
struct Gemm { const bf16_t* A; const bf16_t* Bt; int M, N, K; };

struct StaticOrder {
    int nM, nN, nwg, G, c;
    __host__ __device__ void init(int M, int N, int G_, int c_) { nM = M / BM; nN = N / BM; nwg = nM * nN; G = G_; c = c_; }
    __host__ __device__ bool next(int i, Unit& u) const {
        const long L = (long)i * G + c; if (L >= nwg) return false;
        int wgid = (int)L; { const int q = nwg / NXCD, r = nwg % NXCD, xcd = wgid % NXCD, off = wgid / NXCD; wgid = (xcd < r ? xcd * (q + 1) : r * (q + 1) + (xcd - r) * q) + off; }
        const int nig = WGM * nN, gid = wgid / nig, fm = gid * WGM, gsz = (nM - fm) < WGM ? (nM - fm) : WGM;
        u.pm = fm + ((wgid % nig) % gsz); u.pn = (wgid % nig) / gsz; return true;
    }
    __device__ __forceinline__ void a_ready(const Unit&) const {}
    __device__ __forceinline__ void done(const Unit&) const {}
};
__device__ __forceinline__ unsigned cvt_pk_bf16(float lo, float hi) { unsigned r; asm volatile("v_cvt_pk_bf16_f32 %0, %1, %2" : "=v"(r) : "v"(lo), "v"(hi)); return r; }
struct EpiSwiglu {
    static constexpr bool PERM = true, AFTER_DRAIN = false;
    bf16_t* act; const PG8_LAS float* rtab; int pmA;
    __device__ __forceinline__ void operator()(const f32x4 (&acc)[2][2][4][2], const Unit& u, int wr, int wc, int fr, int fq) const {
        const int row0 = u.pm * BM + wr * 64 + fr, col0 = (21 - u.pn) * 128 + wc * 32 + 8 * fq;
        const PG8_LAS float* rt = rtab + (u.pm == pmA ? 0 : 256) + wr * 64 + fr;
#pragma unroll
        for (int ai = 0; ai < 2; ++ai)
#pragma unroll
            for (int m = 0; m < 4; ++m) {
                const size_t row = (size_t)(row0 + ai * HALF + m * 16); const float r = rt[ai * HALF + m * 16];
                const float nr = -1.4426950408889634f * r, r2 = r * r;
                unsigned w[4];
#pragma unroll
                for (int n = 0; n < 2; ++n) {
                    typedef float f2 __attribute__((ext_vector_type(2)));
                    const f32x4 g = acc[ai][0][m][n], uu = acc[ai][1][m][n];
                    const f2 ga = {g[0], g[1]}, gb = {g[2], g[3]}, ua = {uu[0], uu[1]}, ub = {uu[2], uu[3]};
                    const f2 ta = ga * nr, tb = gb * nr;
                    f2 ea, eb; ea.x = __builtin_amdgcn_exp2f(ta.x); ea.y = __builtin_amdgcn_exp2f(ta.y); eb.x = __builtin_amdgcn_exp2f(tb.x); eb.y = __builtin_amdgcn_exp2f(tb.y);
                    const f2 da = ea + 1.0f, db = eb + 1.0f;
                    f2 ia, ib; ia.x = __builtin_amdgcn_rcpf(da.x); ia.y = __builtin_amdgcn_rcpf(da.y); ib.x = __builtin_amdgcn_rcpf(db.x); ib.y = __builtin_amdgcn_rcpf(db.y);
                    const f2 ha = (ga * ua) * (ia * r2), hb = (gb * ub) * (ib * r2);
                    w[2 * n] = cvt_pk_bf16(ha.x, ha.y); w[2 * n + 1] = cvt_pk_bf16(hb.x, hb.y); }
                *(u32x4*)(act + row * DFF + col0) = (u32x4){w[0], w[1], w[2], w[3]};
            }
    }
};
template <bool IN_BF16, bool OUT_BF16> struct EpiResid {
    static constexpr bool PERM = true, AFTER_DRAIN = false;
    const float* xin; bf16_t* xb; float* out; float* ssout; float alpha;
    __device__ __forceinline__ void operator()(const f32x4 (&acc)[2][2][4][2], const Unit& u, int wr, int wc, int fr, int fq) const {
        const int row0 = u.pm * BM + wr * 64 + fr, col0 = u.pn * BM + wc * 32 + 8 * fq;
        u32x4 w[2][4][2];
        if (IN_BF16) {
#pragma unroll
            for (int ai = 0; ai < 2; ++ai)
#pragma unroll
                for (int m = 0; m < 4; ++m)
#pragma unroll
                    for (int bj = 0; bj < 2; ++bj) w[ai][m][bj] = *(const u32x4*)(xb + (size_t)(row0 + ai * HALF + m * 16) * DM + col0 + bj * HALF);
        }
#pragma unroll
        for (int ai = 0; ai < 2; ++ai)
#pragma unroll
            for (int m = 0; m < 4; ++m) {
                const size_t row = (size_t)(row0 + ai * HALF + m * 16); float s = 0.f;
#pragma unroll
                for (int bj = 0; bj < 2; ++bj) { const size_t p = row * DM + col0 + bj * HALF;
                    f32x4 x0, x1;
                    if (IN_BF16) { const u32x4 wv = w[ai][m][bj];
                        x0 = (f32x4){__builtin_bit_cast(float, wv[0] << 16), __builtin_bit_cast(float, wv[0] & 0xffff0000u), __builtin_bit_cast(float, wv[1] << 16), __builtin_bit_cast(float, wv[1] & 0xffff0000u)};
                        x1 = (f32x4){__builtin_bit_cast(float, wv[2] << 16), __builtin_bit_cast(float, wv[2] & 0xffff0000u), __builtin_bit_cast(float, wv[3] << 16), __builtin_bit_cast(float, wv[3] & 0xffff0000u)}; }
                    else { x0 = __builtin_nontemporal_load((const f32x4*)(xin + p)); x1 = __builtin_nontemporal_load((const f32x4*)(xin + p + 4)); }
                    const f32x4 v0 = x0 + alpha * acc[ai][bj][m][0], v1 = x1 + alpha * acc[ai][bj][m][1];
                    if (OUT_BF16) { *(u32x4*)(xb + p) = (u32x4){cvt_pk_bf16(v0[0], v0[1]), cvt_pk_bf16(v0[2], v0[3]), cvt_pk_bf16(v1[0], v1[1]), cvt_pk_bf16(v1[2], v1[3])};
                        s += ((v0[0] * v0[0] + v0[1] * v0[1]) + (v0[2] * v0[2] + v0[3] * v0[3])) + ((v1[0] * v1[0] + v1[1] * v1[1]) + (v1[2] * v1[2] + v1[3] * v1[3])); }
                    else { __builtin_nontemporal_store(v0, (f32x4*)(out + p)); __builtin_nontemporal_store(v1, (f32x4*)(out + p + 4)); } }
                if (OUT_BF16) { s += __shfl_xor(s, 16); s += __shfl_xor(s, 32); if (fq == 0) ssout[row * 16 + 4 * u.pn + wc] = s; }
            }
    }
};
#ifndef EPI_ROPE_AHEAD
#define EPI_ROPE_AHEAD 3
#endif
struct EpiProj {
    static constexpr bool PERM = true, AFTER_DRAIN = false;
    const PG8_LAS float* rtab; int pmA; const float* tab; const float* qn; const float* kn; bf16_t* qkv; float qscale;
    __device__ __forceinline__ void operator()(const f32x4 (&acc)[2][2][4][2], const Unit& u, int wr, int wc, int fr, int fq) const {
        const int row0 = u.pm * BM + wr * 64 + fr, kind = u.pn >> 1, half = u.pn & 1;
        const PG8_LAS float* rt = rtab + (u.pm == pmA ? 0 : 256) + wr * 64 + fr;
        bf16_t* base = qkv + kind * 512;
        if (kind >= 2) {
            const int col0 = half * 256 + wc * 32 + 8 * fq;
#pragma unroll
            for (int ai = 0; ai < 2; ++ai)
#pragma unroll
                for (int m = 0; m < 4; ++m) { const size_t row = (size_t)(row0 + ai * HALF + m * 16); const float r = rt[ai * HALF + m * 16];
#pragma unroll
                    for (int bj = 0; bj < 2; ++bj) { const f32x4 v0 = acc[ai][bj][m][0] * r, v1 = acc[ai][bj][m][1] * r;
                        *(u32x4*)(base + row * PQ + col0 + bj * HALF) = (u32x4){cvt_pk_bf16(v0[0], v0[1]), cvt_pk_bf16(v0[2], v0[3]), cvt_pk_bf16(v1[0], v1[1]), cvt_pk_bf16(v1[2], v1[3])}; } }
        } else {
            const int g = 4 * half + wc; const float* gp = kind == 0 ? qn : kn; const float sc = kind == 0 ? qscale : 1.0f;
            const bool rot = fq < 2; const int d00 = rot ? 4 * fq : 8 * fq, d01 = rot ? 8 + 4 * fq : 8 * fq + 4;
            f32x4 gn[2][2];
            gn[0][0] = *(const f32x4*)(gp + d00); gn[0][1] = *(const f32x4*)(gp + d01); gn[1][0] = *(const f32x4*)(gp + 32 + 8 * fq); gn[1][1] = *(const f32x4*)(gp + 36 + 8 * fq);
            constexpr int AH = EPI_ROPE_AHEAD;
            const float* tcs = tab + (size_t)row0 * 16 + 4 * (fq & 1);
            f32x4 csq[AH + 1], snq[AH + 1];
#pragma unroll
            for (int i = 0; i < AH; ++i) { const size_t ro = (size_t)((i >> 2) * HALF + (i & 3) * 16) * 16; csq[i] = *(const f32x4*)(tcs + ro); snq[i] = *(const f32x4*)(tcs + ro + 8); }
#pragma unroll
            for (int ai = 0; ai < 2; ++ai)
#pragma unroll
                for (int m = 0; m < 4; ++m) { const size_t row = (size_t)(row0 + ai * HALF + m * 16); const float r = rt[ai * HALF + m * 16];
                    { const int i = ai * 4 + m + AH; if (i < 8) { const size_t ro = (size_t)((i >> 2) * HALF + (i & 3) * 16) * 16; csq[i % (AH + 1)] = *(const f32x4*)(tcs + ro); snq[i % (AH + 1)] = *(const f32x4*)(tcs + ro + 8); } }
                    const f32x4 cs = csq[(ai * 4 + m) % (AH + 1)], sn = snq[(ai * 4 + m) % (AH + 1)];
                    f32x4 v[2][2]; float s = 0.f;
#pragma unroll
                    for (int bj = 0; bj < 2; ++bj)
#pragma unroll
                        for (int n = 0; n < 2; ++n) { v[bj][n] = acc[ai][bj][m][n] * r; s += (v[bj][n][0] * v[bj][n][0] + v[bj][n][1] * v[bj][n][1]) + (v[bj][n][2] * v[bj][n][2] + v[bj][n][3] * v[bj][n][3]); }
                    s += __shfl_xor(s, 16); s += __shfl_xor(s, 32);
                    const float nrm = sc * __builtin_amdgcn_rsqf(s * (1.0f / 64.0f) + EPS);
#pragma unroll
                    for (int bj = 0; bj < 2; ++bj)
#pragma unroll
                        for (int n = 0; n < 2; ++n) v[bj][n] = v[bj][n] * nrm * gn[bj][n];
                    { const f32x4 x1 = v[0][0], x2 = v[0][1], o1 = x1 * cs - x2 * sn, o2 = x2 * cs + x1 * sn;
#pragma unroll
                      for (int e = 0; e < 4; ++e) { v[0][0][e] = rot ? o1[e] : x1[e]; v[0][1][e] = rot ? o2[e] : x2[e]; } }
                    typedef unsigned u32x2e __attribute__((ext_vector_type(2)));
                    bf16_t* orow = base + row * PQ + 64 * g;
                    *(u32x2e*)(orow + d00) = (u32x2e){cvt_pk_bf16(v[0][0][0], v[0][0][1]), cvt_pk_bf16(v[0][0][2], v[0][0][3])};
                    *(u32x2e*)(orow + d01) = (u32x2e){cvt_pk_bf16(v[0][1][0], v[0][1][1]), cvt_pk_bf16(v[0][1][2], v[0][1][3])};
                    *(u32x4*)(orow + 32 + 8 * fq) = (u32x4){cvt_pk_bf16(v[1][0][0], v[1][0][1]), cvt_pk_bf16(v[1][0][2], v[1][0][3]), cvt_pk_bf16(v[1][1][0], v[1][1][1]), cvt_pk_bf16(v[1][1][2], v[1][1][3])};
                }
        }
    }
};
template <class Epi, class Sched, bool ALIGN_EPI = false, bool SP2 = false>
__device__ __forceinline__ void gemm_phase(PG8_LAS unsigned char* lds, const Gemm g, const Sched& S, const Epi& E) {
    const int tid = threadIdx.x, wid = __builtin_amdgcn_readfirstlane(tid >> 6), lane = tid & 63, wr = wid >> 2, wc = wid & 3, fr = lane & 15, fq = lane >> 4;
    const int K = g.K, nt = K / BK;
    unsigned voffA[2], voffB[2];
#pragma unroll
    for (int i = 0; i < 2; ++i) { int R, C; stage_rc(tid * 16 + i * 8192, R, C); const int Rb = Epi::PERM ? ((R & ~31) + perm32(R & 31)) : R;
        voffA[i] = (unsigned)(R * K + C) * 2u; voffB[i] = (unsigned)(Rb * K + C) * 2u; }
    const size_t kstep = (size_t)(BK * 2);
    const size_t hstep = (size_t)HALF * K * 2;
    const size_t tstep = 2 * hstep;
    const unsigned ldsw = (unsigned)wid * 1024u;
    const int aoff = lds_byte(wr * 64 + fr, fq * 8), boff = lds_byte(wc * 32 + fr, fq * 8);
#define PG8_SA(b, h) (((b) * 2 + (h)) * HTB)
#define PG8_SB(b, h) ((4 + (b) * 2 + (h)) * HTB)
#define PG8_STAGE(bufoff, gbase, voff) do { _Pragma("unroll") for (int _i = 0; _i < 2; ++_i) \
        __builtin_amdgcn_global_load_lds((const unsigned*)((const char*)(gbase) + (voff)[_i]), (PG8_LAS unsigned*)(lds + (bufoff) + ldsw + _i * 8192), 16, 0, 0); } while (0)
#define PG8_LDA(dst, b, h) do { _Pragma("unroll") for (int m = 0; m < 4; ++m) _Pragma("unroll") for (int k = 0; k < 2; ++k) dst[m][k] = *(const PG8_LAS bf16x8*)(lds + PG8_SA(b, h) + aoff + m * 2048 + k * 1024); } while (0)
#define PG8_LDB(dst, b, h) do { _Pragma("unroll") for (int n = 0; n < 2; ++n) _Pragma("unroll") for (int k = 0; k < 2; ++k) dst[n][k] = *(const PG8_LAS bf16x8*)(lds + PG8_SB(b, h) + boff + n * 2048 + k * 1024); } while (0)
#define PG8_MMA(ai, bj, At, Bt) do { __builtin_amdgcn_s_setprio(1); _Pragma("unroll") for (int m = 0; m < 4; ++m) _Pragma("unroll") for (int n = 0; n < 2; ++n) _Pragma("unroll") for (int k = 0; k < 2; ++k) \
        acc[ai][bj][m][n] = __builtin_amdgcn_mfma_f32_16x16x32_bf16(Bt[n][k], At[m][k], acc[ai][bj][m][n], 0, 0, 0); __builtin_amdgcn_s_setprio(0); } while (0)
#define PG8_WAIT_V(n) asm volatile("s_waitcnt vmcnt(" #n ")" ::: "memory")
#define PG8_WAIT_L(n) asm volatile("s_waitcnt lgkmcnt(" #n ")" ::: "memory")
#define PG8_BAR __builtin_amdgcn_s_barrier()
#define PG8_SCHED __builtin_amdgcn_sched_barrier(0)
    Unit cur, nxt; int ui = 0;
    if (!S.next(0, cur)) return;
    f32x4 acc[2][2][4][2];
#pragma unroll
    for (int a = 0; a < 2; ++a)
#pragma unroll
        for (int b = 0; b < 2; ++b)
#pragma unroll
            for (int m = 0; m < 4; ++m)
#pragma unroll
                for (int n = 0; n < 2; ++n) acc[a][b][m][n] = (f32x4){0.f, 0.f, 0.f, 0.f};
    bf16x8 At[4][2], B0[2][2], B1[2][2];
    const char* cA = (const char*)g.A + (size_t)cur.pm * tstep; const char* cB = (const char*)g.Bt + (size_t)cur.pn * tstep;
    S.a_ready(cur);
    if constexpr (SP2) {
        PG8_STAGE(PG8_SB(0, 0), cB, voffB); PG8_STAGE(PG8_SB(0, 1), cB + hstep, voffB); PG8_STAGE(PG8_SA(0, 0), cA, voffA); PG8_STAGE(PG8_SA(0, 1), cA + hstep, voffA);
        if (wr == 1) PG8_BAR;
        PG8_WAIT_V(2); PG8_BAR;
        PG8_STAGE(PG8_SB(1, 0), cB + kstep, voffB); PG8_STAGE(PG8_SA(1, 0), cA + kstep, voffA); PG8_STAGE(PG8_SB(1, 1), cB + hstep + kstep, voffB);
        PG8_WAIT_V(6); PG8_BAR;
    } else {
        PG8_STAGE(PG8_SB(0, 0), cB, voffB); PG8_STAGE(PG8_SA(0, 0), cA, voffA); PG8_STAGE(PG8_SB(0, 1), cB + hstep, voffB); PG8_STAGE(PG8_SA(0, 1), cA + hstep, voffA);
        if (wr == 1) PG8_BAR;
        PG8_WAIT_V(4); PG8_BAR;
        PG8_STAGE(PG8_SB(1, 0), cB + kstep, voffB); PG8_STAGE(PG8_SA(1, 0), cA + kstep, voffA); PG8_STAGE(PG8_SB(1, 1), cB + hstep + kstep, voffB);
        PG8_WAIT_V(6); PG8_BAR;
    }
    for (;;) {
        const bool has_next = S.next(ui + 1, nxt);
        const char* nA = has_next ? (const char*)g.A + (size_t)nxt.pm * tstep : cA; const char* nB = has_next ? (const char*)g.Bt + (size_t)nxt.pn * tstep : cB;
        for (int t = 0; t < nt; t += 2) {
            const bool last = (t == nt - 2);
            const char* a1 = cA + (size_t)(t + 1) * kstep;
            const char* a2 = last ? nA : cA + (size_t)(t + 2) * kstep; const char* b2 = last ? nB : cB + (size_t)(t + 2) * kstep;
            const char* a3 = a2 + kstep; const char* b3 = b2 + kstep;
            if (last && has_next) S.a_ready(nxt);
            if constexpr (SP2) {
            PG8_LDB(B0, 0, 0); PG8_LDB(B1, 0, 1); PG8_SCHED; PG8_LDA(At, 0, 0); PG8_STAGE(PG8_SA(1, 1), a1 + hstep, voffA);
            PG8_WAIT_V(8); PG8_WAIT_L(0); PG8_BAR; PG8_MMA(0, 0, At, B0); PG8_MMA(0, 1, At, B1); PG8_BAR; PG8_SCHED;
            PG8_LDA(At, 0, 1); PG8_STAGE(PG8_SB(0, 0), b2, voffB); PG8_STAGE(PG8_SB(0, 1), b2 + hstep, voffB); PG8_STAGE(PG8_SA(0, 0), a2, voffA);
            PG8_WAIT_V(8); PG8_WAIT_L(0); PG8_BAR; PG8_MMA(1, 0, At, B0); PG8_MMA(1, 1, At, B1); PG8_BAR; PG8_SCHED;
            PG8_LDB(B0, 1, 0); PG8_LDB(B1, 1, 1); PG8_SCHED; PG8_LDA(At, 1, 0); PG8_STAGE(PG8_SA(0, 1), a2 + hstep, voffA);
            PG8_WAIT_V(8); PG8_WAIT_L(0); PG8_BAR; PG8_MMA(0, 0, At, B0); PG8_MMA(0, 1, At, B1); PG8_BAR; PG8_SCHED;
            PG8_LDA(At, 1, 1); PG8_STAGE(PG8_SB(1, 0), b3, voffB); PG8_STAGE(PG8_SB(1, 1), b3 + hstep, voffB); PG8_STAGE(PG8_SA(1, 0), a3, voffA);
            PG8_WAIT_V(8); PG8_WAIT_L(0); PG8_BAR; PG8_MMA(1, 0, At, B0); PG8_MMA(1, 1, At, B1); PG8_BAR; PG8_SCHED;
            } else {
            PG8_LDB(B0, 0, 0); PG8_SCHED; PG8_LDA(At, 0, 0); PG8_STAGE(PG8_SA(1, 1), a1 + hstep, voffA);
            PG8_WAIT_L(8); PG8_BAR; PG8_WAIT_L(0); PG8_MMA(0, 0, At, B0); PG8_BAR; PG8_SCHED;
            PG8_LDB(B1, 0, 1); PG8_STAGE(PG8_SB(0, 0), b2, voffB);
            PG8_BAR; PG8_WAIT_L(0); PG8_MMA(0, 1, At, B1); PG8_BAR;
            PG8_LDA(At, 0, 1); PG8_STAGE(PG8_SA(0, 0), a2, voffA);
            PG8_BAR; PG8_WAIT_L(0); PG8_MMA(1, 0, At, B0); PG8_BAR; PG8_SCHED;
            PG8_STAGE(PG8_SB(0, 1), b2 + hstep, voffB);
            PG8_WAIT_V(6); PG8_BAR; PG8_MMA(1, 1, At, B1); PG8_BAR;
            PG8_LDB(B0, 1, 0); PG8_SCHED; PG8_LDA(At, 1, 0); PG8_STAGE(PG8_SA(0, 1), a2 + hstep, voffA);
            PG8_WAIT_L(8); PG8_BAR; PG8_WAIT_L(0); PG8_MMA(0, 0, At, B0); PG8_BAR; PG8_SCHED;
            PG8_LDB(B1, 1, 1); PG8_STAGE(PG8_SB(1, 0), b3, voffB);
            PG8_BAR; PG8_WAIT_L(0); PG8_MMA(0, 1, At, B1); PG8_BAR;
            PG8_LDA(At, 1, 1); PG8_STAGE(PG8_SA(1, 0), a3, voffA);
            PG8_BAR; PG8_WAIT_L(0); PG8_MMA(1, 0, At, B0); PG8_BAR; PG8_SCHED;
            PG8_STAGE(PG8_SB(1, 1), b3 + hstep, voffB);
            PG8_WAIT_V(6); PG8_BAR; PG8_MMA(1, 1, At, B1); PG8_BAR;
            }
        }
        if constexpr (ALIGN_EPI) { if (wr == 0) PG8_BAR; }
        if constexpr (!Epi::AFTER_DRAIN) { E(acc, cur, wr, wc, fr, fq); S.done(cur); }
        if (!has_next) break;
#pragma unroll
        for (int a = 0; a < 2; ++a)
#pragma unroll
            for (int b = 0; b < 2; ++b)
#pragma unroll
                for (int m = 0; m < 4; ++m)
#pragma unroll
                    for (int n = 0; n < 2; ++n) acc[a][b][m][n] = (f32x4){0.f, 0.f, 0.f, 0.f};
        cur = nxt; cA = nA; cB = nB; ++ui;
        if constexpr (ALIGN_EPI) { if (wr == 1) PG8_BAR; }
    }
    PG8_WAIT_V(0);
    if constexpr (!ALIGN_EPI) { if (wr == 0) PG8_BAR; }
    PG8_BAR;
    if constexpr (Epi::AFTER_DRAIN) { E.fused(acc, cur, wr, wc, fr, fq, lds, wid, lane); S.done(cur); }
#undef PG8_SA
#undef PG8_SB
#undef PG8_STAGE
#undef PG8_LDA
#undef PG8_LDB
#undef PG8_MMA
#undef PG8_WAIT_V
#undef PG8_WAIT_L
#undef PG8_BAR
#undef PG8_SCHED
}
}

#ifndef ATT_PROBE
#define ATT_PROBE 0
#endif
namespace attn {
using bf16x8 = __attribute__((ext_vector_type(8))) short;
using s16x4 = __attribute__((ext_vector_type(4))) short;
using f32x16 = __attribute__((ext_vector_type(16))) float;
using u32x4 = __attribute__((ext_vector_type(4))) unsigned;
typedef short v4i16_t __attribute__((ext_vector_type(4)));
typedef __attribute__((address_space(3))) const char* lds_cptr;
constexpr int SLOTB = 32768, NSLOT = 3, LDS_WS = NSLOT * SLOTB  , LDS_X = 0  , LDS_STG = 65536  ;
__device__ __forceinline__ int crow(int r, int hi) { return (r & 3) + 8 * (r >> 2) + 4 * hi; }
__device__ __forceinline__ void glds16(const void* gsrc, unsigned lds_dst) { unsigned keep;
    asm volatile("s_mov_b32 %0, m0\n\ts_mov_b32 m0, %2\n\ts_nop 0\n\tglobal_load_lds_dwordx4 %1, off\n\ts_mov_b32 m0, %0" : "=&s"(keep) : "v"(gsrc), "s"(lds_dst) : "memory"); }
typedef float f32x2_t __attribute__((ext_vector_type(2))); typedef __bf16 bf16x2_t __attribute__((ext_vector_type(2)));
__device__ __forceinline__ unsigned cvtpk(float lo, float hi) { f32x2_t v = {lo, hi}; bf16x2_t b = __builtin_convertvector(v, bf16x2_t); return __builtin_bit_cast(unsigned, b); }
__device__ __forceinline__ s16x4 vtr(lds_cptr p) { return __builtin_bit_cast(s16x4, __builtin_amdgcn_ds_read_tr16_b64_v4i16((__attribute__((address_space(3))) v4i16_t*)p)); }
#define ATT_WAIT_BAR(N) asm volatile("s_waitcnt vmcnt(" #N ") lgkmcnt(0)\n\ts_barrier" ::: "memory")

__device__ __forceinline__ void attn_unit(int b, int h, int cc, const bf16* Q, const bf16* __restrict__ K, const bf16* __restrict__ V, bf16* Y, float lam, float negm_s, const float* subln, LAS unsigned char* lds) {
    const int tid = threadIdx.x, lane = tid & 63, r32 = lane & 31, hi = lane >> 5; const int wid = __builtin_amdgcn_readfirstlane(tid >> 6);
    const int qg = wid & 3, map = wid >> 2;
    const size_t rowbase = (size_t)b * SEQ; const int q0 = 128 * cc;
    const bf16* Qw = Q + (rowbase + q0 + 32 * qg) * PQ + h * 128 + map * 64;
    const bf16* Kh = K + rowbase * PQ + h * 128; const bf16* Vh = V + rowbase * PQ + h * 128;
    const unsigned lds0 = (unsigned)(uintptr_t)lds;
    const lds_cptr lds3 = (lds_cptr)lds;
    LAS float* wsf = (LAS float*)(lds + LDS_WS) + wid * 64;
    const int NT = 2 * cc + 2, my_nt = 2 * cc + (qg >> 1) + 1;
    const bf16* ksrc0 = Kh + (size_t)lane * PQ + wid * 8; const bf16* ksrc1 = ksrc0 + 64;
    const bf16* vsrc0 = Vh + (size_t)(16 * (wid & 3) + (lane >> 2)) * PQ + (wid >> 2) * 32 + (lane & 3) * 8; const bf16* vsrc1 = vsrc0 + 64;
    const unsigned kdst = lds0 + wid * 1024, vdst = lds0 + 16384 + wid * 1024;
#define ATT_DMA(t, slot) do { const size_t to_ = (size_t)(t) * 64 * PQ; const unsigned sl_ = (unsigned)(slot); \
        glds16(ksrc0 + to_, (unsigned)__builtin_amdgcn_readfirstlane(kdst + sl_)); glds16(ksrc1 + to_, (unsigned)__builtin_amdgcn_readfirstlane(kdst + sl_ + 8192u)); \
        glds16(vsrc0 + to_, (unsigned)__builtin_amdgcn_readfirstlane(vdst + sl_)); glds16(vsrc1 + to_, (unsigned)__builtin_amdgcn_readfirstlane(vdst + sl_ + 8192u)); } while (0)
    ATT_DMA(0, 0); ATT_DMA(1, SLOTB);
    bf16x8 qr[4];
#pragma unroll
    for (int s = 0; s < 4; ++s) qr[s] = *reinterpret_cast<const bf16x8*>(&Qw[(size_t)r32 * PQ + s * 16 + hi * 8]);
    f32x16 o[4]; o[0] = f32x16{}; o[1] = f32x16{}; o[2] = f32x16{}; o[3] = f32x16{};
    f32x16 negm; float nm_ = negm_s; asm volatile("" : "+v"(nm_));
#pragma unroll
    for (int r = 0; r < 16; ++r) negm[r] = nm_;
    asm volatile("" : "+v"(negm));
    float l_reg = 0.f;
    const lds_cptr kp0 = lds3 + map * 8192 + hi * 1024 + r32 * 16;
    const lds_cptr vp0 = lds3 + 16384 + ((lane >> 4) & 1) * 32 + (lane & 3) * 8 + (4 * hi + ((lane & 15) >> 2)) * 64;
    int slot = 0;
    for (int t = 0; t < NT; ++t) {
        if (t + 1 < NT) { ATT_WAIT_BAR(4); } else { ATT_WAIT_BAR(0); }
        int s2 = slot + 2 * SLOTB; if (s2 >= NSLOT * SLOTB) s2 -= NSLOT * SLOTB;
        if (t < my_nt) {
            const lds_cptr kp = kp0 + slot; const lds_cptr vp = vp0 + slot;
            bf16x8 kf[8];
#pragma unroll
            for (int s = 0; s < 4; ++s) { kf[2 * s] = *(const __attribute__((address_space(3))) bf16x8*)(kp + s * 2048); kf[2 * s + 1] = *(const __attribute__((address_space(3))) bf16x8*)(kp + s * 2048 + 512); }
            f32x16 p0 = __builtin_amdgcn_mfma_f32_32x32x16_bf16(kf[0], qr[0], negm, 0, 0, 0), p1 = __builtin_amdgcn_mfma_f32_32x32x16_bf16(kf[1], qr[0], negm, 0, 0, 0);
#pragma unroll
            for (int s = 1; s < 4; ++s) { p0 = __builtin_amdgcn_mfma_f32_32x32x16_bf16(kf[2 * s], qr[s], p0, 0, 0, 0); p1 = __builtin_amdgcn_mfma_f32_32x32x16_bf16(kf[2 * s + 1], qr[s], p1, 0, 0, 0); }
#define ATT_VLOAD(VF, KS) do { _Pragma("unroll") for (int db = 0; db < 4; ++db) { const s16x4 vlo = vtr(vp + db * 4096 + (KS) * 1024), vhi = vtr(vp + db * 4096 + (KS) * 1024 + 512); \
                VF[db] = (bf16x8){vlo[0], vlo[1], vlo[2], vlo[3], vhi[0], vhi[1], vhi[2], vhi[3]}; } } while (0)
#define ATT_EXPK(P, B, W) do { _Pragma("unroll") for (int r = 0; r < 8; ++r) { P[(B) + r] = __builtin_amdgcn_exp2f(P[(B) + r]); sacc += P[(B) + r]; } \
                W = (u32x4){cvtpk(P[(B)], P[(B) + 1]), cvtpk(P[(B) + 2], P[(B) + 3]), cvtpk(P[(B) + 4], P[(B) + 5]), cvtpk(P[(B) + 6], P[(B) + 7])}; } while (0)
#define ATT_PVK(VF, W) do { _Pragma("unroll") for (int db = 0; db < 4; ++db) o[db] = __builtin_amdgcn_mfma_f32_32x32x16_bf16(__builtin_bit_cast(bf16x8, W), VF[db], o[db], 0, 0, 0); } while (0)
            bf16x8 vfa[4], vfb[4]; u32x4 pwa, pwb; float sacc = 0.f;
            __builtin_amdgcn_sched_barrier(0);
            ATT_VLOAD(vfa, 0);
            if (t + 2 < NT) ATT_DMA(t + 2, s2);
            __builtin_amdgcn_sched_barrier(0);
            ATT_EXPK(p0, 0, pwa);
            ATT_VLOAD(vfb, 1); __builtin_amdgcn_sched_barrier(0);
            ATT_PVK(vfa, pwa); ATT_EXPK(p0, 8, pwb); __builtin_amdgcn_sched_barrier(0);
            ATT_VLOAD(vfa, 2); __builtin_amdgcn_sched_barrier(0);
            ATT_PVK(vfb, pwb); ATT_EXPK(p1, 0, pwa); __builtin_amdgcn_sched_barrier(0);
            ATT_VLOAD(vfb, 3); __builtin_amdgcn_sched_barrier(0);
            ATT_PVK(vfa, pwa); ATT_EXPK(p1, 8, pwb); __builtin_amdgcn_sched_barrier(0);
            ATT_PVK(vfb, pwb);
#undef ATT_VLOAD
#undef ATT_EXPK
#undef ATT_PVK
            l_reg += sacc;
        }
        else if (t + 2 < NT) ATT_DMA(t + 2, s2);
        slot += SLOTB; if (slot == NSLOT * SLOTB) slot = 0;
    }
    int lane_e = lane; asm volatile("" : "+v"(lane_e));
    const int r32e = lane_e & 31, hie = lane_e >> 5;
    l_reg += __shfl_xor(l_reg, 32);
    const float scl = (map == 0 ? 1.0f : lam) / l_reg;
    if (hie == 0) wsf[r32e] = scl;
    asm volatile("s_waitcnt lgkmcnt(0)" ::: "memory");
    float sc[16];
#pragma unroll
    for (int r = 0; r < 16; ++r) sc[r] = wsf[crow(r, hie)];
#pragma unroll
    for (int db = 0; db < 4; ++db)
#pragma unroll
        for (int r = 0; r < 16; ++r) o[db][r] *= sc[r];
    ATT_WAIT_BAR(0);
    LAS float* xb = (LAS float*)(lds + LDS_X) + qg * 4096;
    if (map == 1) {
#pragma unroll
        for (int db = 0; db < 4; ++db)
#pragma unroll
            for (int r = 0; r < 16; ++r) xb[(db * 16 + r) * 64 + lane_e] = o[db][r];
    }
    ATT_WAIT_BAR(0);
    if (map == 0) {
        float ss[16];
#pragma unroll
        for (int r = 0; r < 16; ++r) ss[r] = 0.f;
#pragma unroll
        for (int db = 0; db < 4; ++db)
#pragma unroll
            for (int r = 0; r < 16; ++r) { o[db][r] -= xb[(db * 16 + r) * 64 + lane_e]; ss[r] += o[db][r] * o[db][r]; }
#pragma unroll
        for (int r = 0; r < 16; ++r) {
#pragma unroll
            for (int m = 1; m < 32; m <<= 1) ss[r] += __shfl_xor(ss[r], m);
            ss[r] = (1.0f - LAMBDA_INIT) / sqrtf(ss[r] * (1.0f / 128.0f) + EPS); }
        LAS bf16* stg = (LAS bf16*)(lds + LDS_STG) + qg * 4096;
#pragma unroll
        for (int db = 0; db < 4; ++db) { const float gsub = subln[32 * db + r32e];
#pragma unroll
            for (int r = 0; r < 16; ++r) stg[crow(r, hie) * 128 + 32 * db + r32e] = (bf16)f2bf(o[db][r] * ss[r] * gsub); }
        asm volatile("s_waitcnt lgkmcnt(0)" ::: "memory");
        bf16* Yw = Y + (rowbase + q0 + 32 * qg) * DM + h * 128;
#pragma unroll
        for (int i = 0; i < 8; ++i) { const int id = i * 64 + lane_e, row = id >> 4, ch = id & 15;
            const u32x4 v = *(const LAS u32x4*)(stg + row * 128 + ch * 8); *(u32x4*)(Yw + (size_t)row * DM + ch * 8) = v; }
    }
    ATT_WAIT_BAR(0);
#undef ATT_DMA
}
#undef ATT_WAIT_BAR
}

namespace rnn {
using bf16x8 = __attribute__((ext_vector_type(8))) short;
using f32x16 = __attribute__((ext_vector_type(16))) float;
typedef float f32x2_t __attribute__((ext_vector_type(2))); typedef __bf16 bf16x2_t __attribute__((ext_vector_type(2)));
typedef unsigned u32x2 __attribute__((ext_vector_type(2)));
__device__ __forceinline__ unsigned cvtpk(float lo, float hi) { f32x2_t v = {lo, hi}; bf16x2_t b = __builtin_convertvector(v, bf16x2_t); return __builtin_bit_cast(unsigned, b); }
__device__ __forceinline__ float sigm(float x) { return __builtin_amdgcn_rcpf(1.0f + __builtin_amdgcn_exp2f(-1.4426950408889634f * x)); }
constexpr int LDS_CW = 0  , LDS_CH = 1536  , LDS_COMP = 2048  , LDS_CIN = 6144  , LDS_W = 8192  ,
              LDS_XS = 16384  , XS_BYTES = 264 * 128;
__device__ __forceinline__ void glds16(const void* gsrc, unsigned lds_dst) { unsigned keep;
    asm volatile("s_mov_b32 %0, m0\n\ts_mov_b32 m0, %2\n\ts_nop 0\n\tglobal_load_lds_dwordx4 %1, off\n\ts_mov_b32 m0, %0" : "=&s"(keep) : "v"(gsrc), "s"(lds_dst) : "memory"); }

__device__ __forceinline__ void rnn_consts(int n, int dh, const float* conv_w, const float* conv_b, const float* w_a, const float* b_a, const float* w_x, const float* b_x, const float* a_param, LAS unsigned char* lds) {
    const int tid = threadIdx.x, lane = tid & 63, r32 = lane & 31, hi = lane >> 5; const int wid = __builtin_amdgcn_readfirstlane(tid >> 6);
    LAS float* cwl = (LAS float*)(lds + LDS_CW); LAS float* chl = (LAS float*)(lds + LDS_CH);
    if (tid < 256) cwl[tid] = conv_w[(tid >> 6) * DRNN + n * 64 + (tid & 63)]; else if (tid < 320) cwl[tid] = conv_b[n * 64 + tid - 256];
    else if (tid < 352) { const int ch = n * 64 + 32 * dh + tid - 320; chl[tid - 320] = b_a[ch]; chl[32 + tid - 320] = b_x[ch]; chl[64 + tid - 320] = -8.0f * 1.4426950408889634f * log1pf(expf(-a_param[ch])); }
    { const int mat = wid >> 2, s = wid & 3; const float* wsrc = mat ? w_x : w_a; bf16x8 f;
#pragma unroll
        for (int j = 0; j < 8; ++j) { const int c = 16 * s + 8 * (j >> 2) + 4 * hi + (j & 3); f[j] = (short)f2bf(wsrc[(size_t)(n * 64 + c) * 64 + 32 * dh + r32]); }
        *(LAS bf16x8*)(lds + LDS_W + (wid * 64 + lane) * 16) = f; }
}

template <bool PREP> __device__ __forceinline__ void rnn_unit(int b, int n, int dh, const bf16* __restrict__ XR, const bf16* __restrict__ GATE, bf16* __restrict__ Y, const float* conv_w, const float* conv_b,
                                         const float* w_a, const float* b_a, const float* w_x, const float* b_x, const float* a_param, LAS unsigned char* lds) {
    const int tid = threadIdx.x, lane = tid & 63, r32 = lane & 31, hi = lane >> 5; const int wid = __builtin_amdgcn_readfirstlane(tid >> 6);
    LAS float* cwl = (LAS float*)(lds + LDS_CW); LAS float* chl = (LAS float*)(lds + LDS_CH); LAS float* comp = (LAS float*)(lds + LDS_COMP);
    __syncthreads();
    const size_t seq0 = (size_t)b * SEQ;
    const unsigned lds0 = (unsigned)(uintptr_t)lds;
    const bf16* xsrc = XR + ((long)seq0 - 8 + (lane >> 3)) * PQ + n * 64;
#define RNN_DMA(rd_, buf_) do { const bf16* xs_ = xsrc + (size_t)(rd_) * 256 * PQ; const unsigned db_ = lds0 + LDS_XS + (unsigned)(buf_) * XS_BYTES; \
        _Pragma("unroll") for (int j_ = 0; j_ < 4; ++j_) { const int i_ = wid + 8 * j_; const int rw_ = 8 * i_ + (lane >> 3); \
            glds16(xs_ + (size_t)(8 * i_) * PQ + 8 * ((lane & 7) ^ ((rw_ >> 1) & 7)), (unsigned)__builtin_amdgcn_readfirstlane(db_ + 1024u * i_)); } \
        if (wid == 0) { const int rw_ = 256 + (lane >> 3); glds16(xs_ + (size_t)256 * PQ + 8 * ((lane & 7) ^ ((rw_ >> 1) & 7)), (unsigned)__builtin_amdgcn_readfirstlane(db_ + 32768u)); } } while (0)
    RNN_DMA(0, 0);
    if (!PREP) rnn_consts(n, dh, conv_w, conv_b, w_a, b_a, w_x, b_x, a_param, lds);
    const LAS bf16x8* wfr = (const LAS bf16x8*)(lds + LDS_W) + lane;
    float carry1 = 0.f;
    asm volatile("s_waitcnt vmcnt(0) lgkmcnt(0)\n\ts_barrier" ::: "memory");
    for (int rd = 0; rd < SEQ / 256; ++rd) {
        const int t = 32 * (8 * rd + wid) + r32; const size_t row = seq0 + t;
        if (rd + 1 < SEQ / 256) RNN_DMA(rd + 1, (rd + 1) & 1);
        bf16x8 xf[4]; float xsel[16];
        const bool z0 = t < 3, z1 = t < 2, z2 = t < 1;
        u32x2 gv[4];
#pragma unroll
        for (int g = 0; g < 4; ++g) gv[g] = *(const u32x2*)(GATE + row * PQ + n * 64 + 32 * dh + 8 * g + 4 * hi);
        const LAS unsigned char* xsb = lds + LDS_XS + (rd & 1) * XS_BYTES + 8 * hi;
        const int rl0 = 5 + 32 * wid + r32;
#pragma unroll
        for (int s = 0; s < 4; ++s) {
            float xc[8];
#pragma unroll
            for (int hf = 0; hf < 2; ++hf) { const int c0 = 16 * s + 8 * hf + 4 * hi;
                const v4f cb = *(const LAS v4f*)(cwl + 256 + c0); float acc4[4] = {cb[0], cb[1], cb[2], cb[3]};
#pragma unroll
                for (int k = 0; k < 4; ++k) { const int rl = rl0 + k;
                    u32x2 x2 = *(const LAS u32x2*)(xsb + (rl * 8 + ((2 * s + hf) ^ ((rl >> 1) & 7))) * 16);
                    const bool z = (k == 0) ? z0 : (k == 1) ? z1 : (k == 2) ? z2 : false;
                    x2[0] = z ? 0u : x2[0]; x2[1] = z ? 0u : x2[1];
                    const v4f cw = *(const LAS v4f*)(cwl + k * 64 + c0);
                    acc4[0] += cw[0] * __builtin_bit_cast(float, x2[0] << 16); acc4[1] += cw[1] * __builtin_bit_cast(float, x2[0] & 0xffff0000u);
                    acc4[2] += cw[2] * __builtin_bit_cast(float, x2[1] << 16); acc4[3] += cw[3] * __builtin_bit_cast(float, x2[1] & 0xffff0000u); }
#pragma unroll
                for (int e = 0; e < 4; ++e) xc[4 * hf + e] = acc4[e]; }
            const unsigned w0 = cvtpk(xc[0], xc[1]), w1 = cvtpk(xc[2], xc[3]), w2 = cvtpk(xc[4], xc[5]), w3 = cvtpk(xc[6], xc[7]);
            xf[s] = __builtin_bit_cast(bf16x8, (v4u){w0, w1, w2, w3});
            if (s < 2) {
#pragma unroll
                for (int j = 0; j < 8; ++j) xsel[8 * s + j] = xc[j];
            } else {
#pragma unroll
                for (int j = 0; j < 8; ++j) xsel[8 * (s - 2) + j] = dh ? xc[j] : xsel[8 * (s - 2) + j];
            }
        }
        f32x16 ga, gx; float sp[16];
#pragma unroll
        for (int g = 0; g < 4; ++g) { const v4f a4 = *(const LAS v4f*)(chl + 8 * g + 4 * hi), x4 = *(const LAS v4f*)(chl + 32 + 8 * g + 4 * hi), s4 = *(const LAS v4f*)(chl + 64 + 8 * g + 4 * hi);
#pragma unroll
            for (int e = 0; e < 4; ++e) { ga[4 * g + e] = a4[e]; gx[4 * g + e] = x4[e]; sp[4 * g + e] = s4[e]; } }
#pragma unroll
        for (int s = 0; s < 4; ++s) { ga = __builtin_amdgcn_mfma_f32_32x32x16_bf16(wfr[s * 64], xf[s], ga, 0, 0, 0); gx = __builtin_amdgcn_mfma_f32_32x32x16_bf16(wfr[(4 + s) * 64], xf[s], gx, 0, 0, 0); }
        float av[16], bv[16];
#pragma unroll
        for (int r = 0; r < 16; ++r) { const float rg = sigm(ga[r]), ig = sigm(gx[r]);
            const float aa = __builtin_amdgcn_exp2f(sp[r] * rg); av[r] = aa; bv[r] = __builtin_amdgcn_sqrtf(fmaxf(1.0f - aa * aa, 0.f)) * ig * xsel[r]; }
#define RNN_DPP_STEP(CTRL, RMASK) do { _Pragma("unroll") for (int r = 0; r < 16; ++r) { \
            const float ap = __builtin_bit_cast(float, __builtin_amdgcn_update_dpp(0x3f800000, __builtin_bit_cast(int, av[r]), CTRL, RMASK, 0xf, false)); \
            const float bp = __builtin_bit_cast(float, __builtin_amdgcn_update_dpp(0, __builtin_bit_cast(int, bv[r]), CTRL, RMASK, 0xf, false)); \
            bv[r] = av[r] * bp + bv[r]; av[r] = av[r] * ap; } } while (0)
        RNN_DPP_STEP(0x111, 0xf); RNN_DPP_STEP(0x112, 0xf); RNN_DPP_STEP(0x114, 0xf); RNN_DPP_STEP(0x118, 0xf); RNN_DPP_STEP(0x142, 0xa);
#undef RNN_DPP_STEP
        LAS float* cp = comp + (rd & 1) * 512;
        if (r32 == 31) {
#pragma unroll
            for (int g = 0; g < 4; ++g) { *(LAS v4f*)(cp + (wid * 2 + 0) * 32 + 8 * g + 4 * hi) = (v4f){av[4 * g], av[4 * g + 1], av[4 * g + 2], av[4 * g + 3]};
                *(LAS v4f*)(cp + (wid * 2 + 1) * 32 + 8 * g + 4 * hi) = (v4f){bv[4 * g], bv[4 * g + 1], bv[4 * g + 2], bv[4 * g + 3]}; }
        }
        asm volatile("s_waitcnt vmcnt(0) lgkmcnt(0)\n\ts_barrier" ::: "memory");
        float cin1 = carry1;
#pragma unroll
        for (int w = 0; w < 8; ++w) { const float A1 = cp[(w * 2 + 0) * 32 + r32], B1 = cp[(w * 2 + 1) * 32 + r32];
            cin1 = (w == wid) ? carry1 : cin1; carry1 = A1 * carry1 + B1; }
        LAS float* cib = (LAS float*)(lds + LDS_CIN) + wid * 32;
        if (hi == 0) cib[r32] = cin1;
        asm volatile("s_waitcnt lgkmcnt(0)" ::: "memory");
        float cin[16];
#pragma unroll
        for (int g = 0; g < 4; ++g) { const v4f c4 = *(const LAS v4f*)(cib + 8 * g + 4 * hi);
#pragma unroll
            for (int e = 0; e < 4; ++e) cin[4 * g + e] = c4[e]; }
#pragma unroll
        for (int g = 0; g < 4; ++g) { const int c0 = n * 64 + 32 * dh + 8 * g + 4 * hi;
            const float gt[4] = {__builtin_bit_cast(float, gv[g][0] << 16), __builtin_bit_cast(float, gv[g][0] & 0xffff0000u), __builtin_bit_cast(float, gv[g][1] << 16), __builtin_bit_cast(float, gv[g][1] & 0xffff0000u)};
            float y[4];
#pragma unroll
            for (int e = 0; e < 4; ++e) { const int r = 4 * g + e; const float h = av[r] * cin[r] + bv[r]; const float x = gt[e];
                y[e] = h * x * sigm(1.5957691216057308f * (x + 0.044715f * x * x * x)); }
            *(u32x2*)(Y + row * DM + DATTN + c0) = (u32x2){cvtpk(y[0], y[1]), cvtpk(y[2], y[3])}; }
    }
#undef RNN_DMA
    __syncthreads();
}
}

typedef __attribute__((address_space(1))) unsigned gu32;
#define RLX_AGENT __ATOMIC_RELAXED, __HIP_MEMORY_SCOPE_AGENT
#define XB_TMO      128
#define XB_XCNT(j)  (256  + 64 * (j))
#define XB_XSUB(j)  (1280 + 64 * (j))
#define XB_XGEN(j)  (2304 + 64 * (j))
#define XB_TOP      3328
#define XB_TOPGEN   3392
#define XCD_BAR_WORDS 3456
#define XB_SPIN_CAP (1u << 18)

__device__ __forceinline__ unsigned xb_ld(unsigned* p)              { return __hip_atomic_load(p, __ATOMIC_RELAXED, __HIP_MEMORY_SCOPE_AGENT); }
__device__ __forceinline__ unsigned xb_add(unsigned* p, unsigned v) { return __hip_atomic_fetch_add(p, v, __ATOMIC_RELAXED, __HIP_MEMORY_SCOPE_AGENT); }
__device__ __forceinline__ unsigned xb_xcc_id() { return (unsigned)__builtin_amdgcn_s_getreg((3 << 11) | 20) & 0xFu; }
#define XB_SPIN(cond, bar) do { unsigned _sp = 0; while (cond) { __builtin_amdgcn_s_sleep(1); \
    if ((++_sp & 255u) == 0u) { if (xb_ld(&(bar)[XB_TMO])) break; if (_sp > XB_SPIN_CAP) { atomicAdd(&(bar)[XB_TMO], 1u); break; } } } } while (0)

struct XcdBarrier {
    unsigned* bar; unsigned x;
    volatile LAS unsigned* st;
};

__device__ __forceinline__ XcdBarrier xcd_barrier_post(unsigned* bar, volatile LAS unsigned* st) {
    XcdBarrier b; b.bar = bar; b.x = xb_xcc_id(); b.st = st;
    if (threadIdx.x == 0) (void)xb_add(&bar[XB_XCNT(b.x)], 1u);
    return b;
}
__device__ __forceinline__ void xcd_barrier_complete(unsigned* bar, unsigned x, unsigned& nloc, unsigned& nx) {
    const unsigned G = gridDim.x * gridDim.y * gridDim.z;
    unsigned sum, cnt, mine, sp = 0u;
    for (;;) {
        sum = 0u; cnt = 0u; mine = 0u;
#pragma unroll
        for (unsigned j = 0; j < 16; ++j) { const unsigned c = xb_ld(&bar[XB_XCNT(j)]); sum += c; cnt += (c > 0u) ? 1u : 0u; mine = (j == x) ? c : mine; }
        if (sum == G) break;
        __builtin_amdgcn_s_sleep(1);
        if ((++sp & 255u) == 0u) { if (xb_ld(&bar[XB_TMO])) break; if (sp > XB_SPIN_CAP) { atomicAdd(&bar[XB_TMO], 1u); break; } }
    }
    nloc = mine > 0u ? mine : 1u; nx = cnt > 0u ? cnt : 1u;
}

__device__ __forceinline__ void xcd_barrier(const XcdBarrier& b) {
    asm volatile("s_waitcnt vmcnt(0)" ::: "memory");
    __syncthreads();
    if (threadIdx.x == 0) {
        unsigned* bar = b.bar;
        __builtin_amdgcn_s_waitcnt(0);
        unsigned nloc = b.st[0], nx = b.st[1];
        if (nloc == 0u) { xcd_barrier_complete(bar, b.x, nloc, nx); b.st[0] = nloc; b.st[1] = nx; }
        const unsigned old = xb_add(&bar[XB_XSUB(b.x)], 1u);
        const unsigned gen = old / nloc;
        if (old + 1u == (gen + 1u) * nloc) {
            __builtin_amdgcn_fence(__ATOMIC_RELEASE, "agent");
            asm volatile("s_waitcnt vmcnt(0)" ::: "memory");
            const unsigned og = xb_add(&bar[XB_TOP], 1u);
            const unsigned tg = og / nx;
            if (og + 1u == (tg + 1u) * nx) xb_add(&bar[XB_TOPGEN], 1u);
            else XB_SPIN(xb_ld(&bar[XB_TOPGEN]) == tg, bar);
            __builtin_amdgcn_fence(__ATOMIC_ACQUIRE, "agent");
            xb_add(&bar[XB_XGEN(b.x)], 1u);
            asm volatile("s_waitcnt vmcnt(0)" ::: "memory");
        } else {
            XB_SPIN(xb_ld(&bar[XB_XGEN(b.x)]) == gen, bar);
            __builtin_amdgcn_fence(__ATOMIC_ACQUIRE, "agent");
            asm volatile("s_waitcnt vmcnt(0)" ::: "memory");
        }
    }
    __syncthreads();
}

#define XL_SUB(j)   (3520 + 64 * (j))
#define XL_GEN(j)   (4544 + 64 * (j))
#define XL_TABLE    6144
__device__ __forceinline__ void xcd_local_barrier(const XcdBarrier& b) {
    asm volatile("s_waitcnt vmcnt(0)" ::: "memory");
    __syncthreads();
    if (threadIdx.x == 0) {
        unsigned* bar = b.bar;
        __builtin_amdgcn_s_waitcnt(0);
        const unsigned nloc = b.st[0];
        const unsigned old = xb_add(&bar[XL_SUB(b.x)], 1u);
        const unsigned gen = old / nloc;
        if (old + 1u == (gen + 1u) * nloc) xb_add(&bar[XL_GEN(b.x)], 1u);
        else XB_SPIN(xb_ld(&bar[XL_GEN(b.x)]) == gen, bar);
        __builtin_amdgcn_fence(__ATOMIC_ACQUIRE, "agent");
        asm volatile("s_waitcnt vmcnt(0)" ::: "memory");
    }
    __syncthreads();
}

#define XG_SUB(g)   (6400 + 16 * (g))
#define XG_GEN(g)   (7424 + 16 * (g))
__device__ __forceinline__ void panel_group_barrier(const XcdBarrier& b, unsigned grp) {
    asm volatile("s_waitcnt vmcnt(0)" ::: "memory");
    __syncthreads();
    if (threadIdx.x == 0) {
        unsigned* bar = b.bar;
        __builtin_amdgcn_s_waitcnt(0);
        const unsigned old = xb_add(&bar[XG_SUB(grp)], 1u);
        const unsigned gen = old >> 2;
        if ((old & 3u) == 3u) xb_add(&bar[XG_GEN(grp)], 1u);
        else XB_SPIN(xb_ld(&bar[XG_GEN(grp)]) == gen, bar);
        __builtin_amdgcn_fence(__ATOMIC_ACQUIRE, "agent");
        asm volatile("s_waitcnt vmcnt(0)" ::: "memory");
    }
    __syncthreads();
}

#define XS_SUB(s, j) (8704 + 1024 * (s) + 64 * (j))
#define XS_TOP(s)    (10752 + 128 * (s))
#define XS_FLAG(s)   (10752 + 128 * (s) + 64)
__device__ __forceinline__ void xcd_split_arrive(const XcdBarrier& b, int set) {
    asm volatile("s_waitcnt vmcnt(0)" ::: "memory");
    __syncthreads();
    if (threadIdx.x == 0) {
        unsigned* bar = b.bar;
        __builtin_amdgcn_s_waitcnt(0);
        unsigned nloc = b.st[0], nx = b.st[1];
        if (nloc == 0u) { xcd_barrier_complete(bar, b.x, nloc, nx); b.st[0] = nloc; b.st[1] = nx; }
        const unsigned old = xb_add(&bar[XS_SUB(set, b.x)], 1u);
        if (old + 1u == nloc) {
            __builtin_amdgcn_fence(__ATOMIC_RELEASE, "agent");
            asm volatile("s_waitcnt vmcnt(0)" ::: "memory");
            const unsigned og = xb_add(&bar[XS_TOP(set)], 1u);
            if (og + 1u == nx) xb_add(&bar[XS_FLAG(set)], 1u);
        }
    }
    __syncthreads();
}
__device__ __forceinline__ void xcd_split_wait(const XcdBarrier& b, int set, int who) {
    if ((int)threadIdx.x == who) {
        unsigned* bar = b.bar;
        XB_SPIN(xb_ld(&bar[XS_FLAG(set)]) == 0u, bar);
        __builtin_amdgcn_fence(__ATOMIC_ACQUIRE, "agent");
        asm volatile("s_waitcnt vmcnt(0)" ::: "memory");
    }
}

__device__ __forceinline__ int srcblk(int mode, int nb) {
    if (mode == 1) { const int t = nb >> 3, bj = (nb >> 2) & 1, jb = nb & 3; return bj * 88 + 4 * t + jb; }
    if (mode == 2) { if (nb < 32) { const int t = nb >> 3, bj = (nb >> 2) & 1, wc = nb & 3; return 8 * t + 2 * wc + bj; } return nb; }
    return nb;
}
__device__ __forceinline__ void transpose_item(const float* W, int K, int N, const float* gain, bf16* WT, int mode, LAS float* scr, int item, int lane) {
    const int nblk = N / 32, kb = item / nblk, nb = item % nblk, k0 = 64 * kb, n0d = 32 * nb, n0s = 32 * srcblk(mode, nb);
    const int k0d = (mode == 3) ? (21 - (kb >> 1)) * 128 + 64 * (kb & 1) : k0;
#pragma unroll
    for (int i = 0; i < 8; ++i) { const int kk = 8 * i + (lane >> 3), cc = 4 * (lane & 7);
        const v4f w = __builtin_nontemporal_load((const v4f*)(W + (size_t)(k0 + kk) * N + n0s + cc)); const float gk = gain ? gain[k0 + kk] : 1.0f;
        scr[kk * 33 + cc] = w.x * gk; scr[kk * 33 + cc + 1] = w.y * gk; scr[kk * 33 + cc + 2] = w.z * gk; scr[kk * 33 + cc + 3] = w.w * gk; }
    asm volatile("s_waitcnt lgkmcnt(0)" ::: "memory");
    const int c = lane & 7;
    const bool qkmap = (mode == 2) && nb < 32 && ((nb >> 2) & 1) == 0;
#pragma unroll
    for (int j = 0; j < 4; ++j) { const int n = (lane >> 3) + 8 * j; const int ncol = (qkmap && n < 16) ? 4 * (n >> 3) + 8 * ((n >> 2) & 1) + (n & 3) : n; const LAS float* s = scr + (8 * c) * 33 + ncol;
        v4u o; o.x = pk2(s[0 * 33], s[1 * 33]); o.y = pk2(s[2 * 33], s[3 * 33]); o.z = pk2(s[4 * 33], s[5 * 33]); o.w = pk2(s[6 * 33], s[7 * 33]);
        *(v4u*)(WT + (size_t)(n0d + n) * K + k0d + 8 * c) = o; }
    asm volatile("s_waitcnt lgkmcnt(0)" ::: "memory");
}
__device__ __forceinline__ void xprep_row(const float* xrow, bf16* orow, float* ssrow, int lane) {
    const v4f* xr = (const v4f*)xrow + lane;
    v4f v[4]; float s = 0.f;
#pragma unroll
    for (int j = 0; j < 4; ++j) { v[j] = __builtin_nontemporal_load(xr + 64 * j); s += (v[j].x * v[j].x + v[j].y * v[j].y) + (v[j].z * v[j].z + v[j].w * v[j].w); }
    s = wave_sum(s);
    unsigned long long* o8 = (unsigned long long*)orow + lane;
#pragma unroll
    for (int j = 0; j < 4; ++j) o8[64 * j] = (unsigned long long)pk2(v[j].x, v[j].y) | ((unsigned long long)pk2(v[j].z, v[j].w) << 32);
    if (lane < 16) ssrow[lane] = lane == 0 ? s : 0.f;
}

struct Args {
    const float* in[25]; float* out; unsigned char* ws; float invf[8]; int ph_lo, ph_hi;
};
constexpr int NWAVES = 8, NTHREADS = 512;
constexpr int RING_BYTES = 131072, MISC_OFF = RING_BYTES + 256, LDS_BYTES = 147456;
constexpr int CW_BAR = 4096;
constexpr size_t CTL_ZERO_BYTES = 65536;

__device__ __forceinline__ void p0_rows_all(const Args& a, int tid);
__device__ __forceinline__ void p0_prologue(const Args& a, LAS unsigned char* lds, int tid, int r_lo, int r_hi, bool rows_too) {
    const int lane = tid & 63, wave = tid >> 6;
    LAS float* scr = (LAS float*)(lds + wave * 16384);
    const int gw = blockIdx.x * NWAVES + wave, NGW = gridDim.x * NWAVES;
    unsigned char* ws = a.ws;
    constexpr int I1 = (DM / 64) * (NFF / 32), I2 = (DFF / 64) * (DM / 32), I3 = (DM / 64) * (NPROJ / 32), I4 = (DM / 64) * (DM / 32);
    constexpr int NIT = 2 * I1 + 2 * I2 + I3 + I4;
    for (int it = gw + r_lo * NGW, rd = r_lo; it < NIT && rd < r_hi; it += NGW, ++rd) {
        int r = it;
        if (r < I1) { transpose_item(a.in[3], DM, NFF, a.in[2], (bf16*)(ws + WS_W1T), 1, scr, r, lane); continue; } r -= I1;
        if (r < I1) { transpose_item(a.in[23], DM, NFF, a.in[22], (bf16*)(ws + WS_W5T), 1, scr, r, lane); continue; } r -= I1;
        if (r < I2) { transpose_item(a.in[4], DFF, DM, nullptr, (bf16*)(ws + WS_W2T), 3, scr, r, lane); continue; } r -= I2;
        if (r < I2) { transpose_item(a.in[24], DFF, DM, nullptr, (bf16*)(ws + WS_W6T), 3, scr, r, lane); continue; } r -= I2;
        if (r < I3) { transpose_item(a.in[6], DM, NPROJ, a.in[5], (bf16*)(ws + WS_W3T), 2, scr, r, lane); continue; } r -= I3;
        transpose_item(a.in[21], DM, DM, nullptr, (bf16*)(ws + WS_W4T), 0, scr, r, lane);
    }
    if (rows_too) p0_rows_all(a, tid);
}
__device__ __forceinline__ void p0_rows_all(const Args& a, int tid) {
    const int lane = tid & 63, wave = tid >> 6; const int gw = blockIdx.x * NWAVES + wave, NGW = gridDim.x * NWAVES; unsigned char* ws = a.ws;
    const float* x = a.in[0];
    for (int m = gw; m < MTOK; m += NGW) xprep_row(x + (size_t)m * DM, (bf16*)(ws + WS_XB) + (size_t)m * DM, (float*)(ws + WS_SS) + (size_t)m * 16, lane);
    float* tab = (float*)(ws + WS_ROPE); const int* pos = (const int*)a.in[1];
    for (int i = blockIdx.x * NTHREADS + tid; i < MTOK * 8; i += gridDim.x * NTHREADS) {
        const int row = i >> 3, j = i & 7;
        const float ang = (float)pos[row] * a.invf[j];
        tab[row * 16 + j] = (float)cos((double)ang); tab[row * 16 + 8 + j] = (float)sin((double)ang);
    }
}
__device__ __forceinline__ void p0_rows_own(const Args& a, int tid) {
    const int lane = tid & 63, wave = tid >> 6; unsigned char* ws = a.ws;
    const int xl = (int)blockIdx.x & 7, jg = ((int)blockIdx.x >> 3) & 7, m4 = (int)blockIdx.x >> 6, pA = 16 * xl + jg, pB = pA + 8;
    const float* x = a.in[0];
    for (int i = 0; i < 16; ++i) { const int r = m4 * 8 + wave + 32 * i, m = (r < 256 ? pA : pB) * 256 + (r & 255);
        xprep_row(x + (size_t)m * DM, (bf16*)(ws + WS_XB) + (size_t)m * DM, (float*)(ws + WS_SS) + (size_t)m * 16, lane); }
    float* tab = (float*)(ws + WS_ROPE); const int* pos = (const int*)a.in[1];
    for (int e = m4 * NTHREADS + tid; e < 512 * 8; e += 4 * NTHREADS) {
        const int r = e >> 3, j = e & 7, row = (r < 256 ? pA : pB) * 256 + (r & 255);
        const float ang = (float)pos[row] * a.invf[j];
        tab[row * 16 + j] = (float)cos((double)ang); tab[row * 16 + 8 + j] = (float)sin((double)ang);
    }
}

constexpr int RTAB_OFF = RING_BYTES + 1024;
__device__ __forceinline__ int rinv_prepass(const float* ss, const pg8::StaticOrder& S, LAS unsigned char* lds, int tid) {
    pg8::Unit u; int n = 0; while (S.next(n, u)) ++n;
    if (n == 0) return 0;
    S.next(0, u); const int pmA = u.pm; S.next(n - 1, u); const int pmB = u.pm;
    LAS float* rtab = (LAS float*)(lds + RTAB_OFF);
    const size_t row = (size_t)((tid >> 8) ? pmB : pmA) * 256 + (tid & 255);
    rtab[tid] = rinv_of(ss, row);
    __syncthreads();
    return pmA;
}
struct RevOrder : pg8::StaticOrder {
    int n;
    __device__ void init_rev(int M, int N, int G_, int c_) { init(M, N, G_, c_); pg8::Unit u; n = 0; while (pg8::StaticOrder::next(n, u)) ++n; }
    __device__ bool next(int i, pg8::Unit& u) const { return i < n ? pg8::StaticOrder::next(n - 1 - i, u) : false; }
};
#ifndef PG8_ALIGN
#define PG8_ALIGN true
#endif
#ifndef PG8_SP2
#define PG8_SP2 true
#endif
__global__ void __launch_bounds__(NTHREADS, 2) mk_fwd(Args a) {
    extern __shared__ __attribute__((aligned(16))) unsigned char lds_raw[];
    cg::grid_group grid = cg::this_grid();
    LAS unsigned char* lds = (LAS unsigned char*)lds_raw;
    const int tid = threadIdx.x;
    unsigned char* ws = a.ws;
    const int lo = a.ph_lo, hi = a.ph_hi, G = gridDim.x;
    bf16 *W1T = (bf16*)(ws + WS_W1T), *W2T = (bf16*)(ws + WS_W2T), *W3T = (bf16*)(ws + WS_W3T), *W4T = (bf16*)(ws + WS_W4T), *W5T = (bf16*)(ws + WS_W5T), *W6T = (bf16*)(ws + WS_W6T);
    float* tab = (float*)(ws + WS_ROPE); float* ss0 = (float*)(ws + WS_SS); float* ss1 = ss0 + (size_t)MTOK * 16; float* ss2 = ss1 + (size_t)MTOK * 16;
    bf16 *XB = (bf16*)(ws + WS_XB), *Y = (bf16*)(ws + WS_Y), *ACT = (bf16*)(ws + WS_ACT);
    bf16 *Qb = ACT, *Kb = ACT + 512, *Vb = ACT + 1024, *XR = ACT + 1536, *GATE = ACT + 2048;
    float* out = a.out;
#ifndef PROBE_DUP
#define PROBE_DUP -1
#endif
#define REP(k) for (int rep_ = 0; rep_ < ((PROBE_DUP) == (k) ? 2 : 1); ++rep_)
#define REPSYNC() do { if (rep_) xcd_barrier(bar); } while (0)
#define IN(k) (lo <= (k) && (k) < hi)
    volatile LAS unsigned* MISC = (volatile LAS unsigned*)(lds + MISC_OFF);
    if (tid < 16) MISC[tid] = 0u;
    __syncthreads();
    XcdBarrier bar = xcd_barrier_post((unsigned*)(ws + WS_CTL) + CW_BAR, MISC + 8);
    if (tid == 0) __hip_atomic_store((unsigned*)(ws + WS_CTL) + CW_BAR + XL_TABLE + blockIdx.x, bar.x + 1u, __ATOMIC_RELAXED, __HIP_MEMORY_SCOPE_AGENT);
    const unsigned pgrp = ((unsigned)blockIdx.x & 7u) * 8u + (((unsigned)blockIdx.x >> 3) & 7u);
    bool split_b = false;
    bool local_ok = false;
#ifndef MK_LOCAL_SEAMS
#define MK_LOCAL_SEAMS 1
#endif
#ifndef MK_GROUP_SEAMS
#define MK_GROUP_SEAMS 1
#endif
#ifndef MK_CG_SEAM0
#define MK_CG_SEAM0 0
#endif
#define SEAM(k) do { if (IN(k) && IN((k) + 1)) { if (MK_CG_SEAM0 && (k) == 0) grid.sync(); else if (MK_LOCAL_SEAMS && local_ok && MK_GROUP_SEAMS && ((k) == 1 || (k) == 2 || (k) == 5 || (k) == 6)) panel_group_barrier(bar, pgrp); else if (MK_LOCAL_SEAMS && local_ok && (k) >= 1) xcd_local_barrier(bar); else xcd_barrier(bar); } } while (0)

    if (G == 256 && lo == 0 && hi > 2 && !MK_CG_SEAM0) {
        p0_prologue(a, lds, tid, 0, 2, false);
        xcd_split_arrive(bar, 0);
        p0_rows_own(a, tid);
        p0_prologue(a, lds, tid, 2, 1 << 20, false);
        xcd_split_arrive(bar, 1);
        xcd_split_wait(bar, 0, 0);
        __syncthreads();
        if (MK_LOCAL_SEAMS) {
            const unsigned* tblx = (const unsigned*)(ws + WS_CTL) + CW_BAR + XL_TABLE;
            bool okt = true;
            if (tid < 256) { const unsigned mine = __hip_atomic_load(tblx + tid, __ATOMIC_RELAXED, __HIP_MEMORY_SCOPE_AGENT), lead = __hip_atomic_load(tblx + (tid & 7), __ATOMIC_RELAXED, __HIP_MEMORY_SCOPE_AGENT); okt = (mine == lead) && mine != 0u;
                if (tid < 8) { for (int j = 0; j < 8; ++j) if (j != tid && __hip_atomic_load(tblx + j, __ATOMIC_RELAXED, __HIP_MEMORY_SCOPE_AGENT) == mine) okt = false; } }
            local_ok = __syncthreads_and(okt ? 1 : 0) != 0;
        }
        if (MK_LOCAL_SEAMS && local_ok && MK_GROUP_SEAMS) panel_group_barrier(bar, pgrp); else xcd_barrier(bar);
        split_b = true;
    } else {
        if (IN(0)) { p0_prologue(a, lds, tid, 0, 1 << 20, true); }
        SEAM(0);
    }
#ifdef PROBE_SYNCS
    for (int i_ = 0; i_ < PROBE_SYNCS; ++i_) xcd_barrier(bar);
#endif
    if (IN(1)) REP(1) { REPSYNC(); pg8::Gemm g{XB, W1T, MTOK, NFF, DM}; pg8::StaticOrder S; S.init(MTOK, NFF, G, (int)blockIdx.x);
        const int pmA = rinv_prepass(ss0, S, lds, tid); pg8::EpiSwiglu E{ACT, (const LAS float*)(lds + RTAB_OFF), pmA}; pg8::gemm_phase<pg8::EpiSwiglu, pg8::StaticOrder, PG8_ALIGN, PG8_SP2>(lds, g, S, E); }
    if (split_b) xcd_split_wait(bar, 1, 64);
    SEAM(1);
    if (IN(2)) REP(2) { REPSYNC(); pg8::Gemm g{ACT, W2T, MTOK, DM, DFF}; RevOrder S; S.init_rev(MTOK, DM, G, (int)blockIdx.x);
        pg8::EpiResid<true, true> E{nullptr, XB, nullptr, ss1, 0.5f}; pg8::gemm_phase<pg8::EpiResid<true, true>, RevOrder, PG8_ALIGN, PG8_SP2>(lds, g, S, E); }
    SEAM(2);
    if (IN(3)) REP(3) { REPSYNC(); pg8::Gemm g{XB, W3T, MTOK, NPROJ, DM}; pg8::StaticOrder S; S.init(MTOK, NPROJ, G, (int)blockIdx.x);
        const int pmA = rinv_prepass(ss1, S, lds, tid); pg8::EpiProj E{(const LAS float*)(lds + RTAB_OFF), pmA, tab, a.in[7], a.in[8], Qb, 0.125f * 1.4426950408889634f}; pg8::gemm_phase<pg8::EpiProj, pg8::StaticOrder, PG8_ALIGN, PG8_SP2>(lds, g, S, E); }
    if (IN(3) && IN(4)) {
        const int vcu0 = (G % 8 == 0) ? ((int)blockIdx.x % 8) * (G / 8) + (int)blockIdx.x / 8 : (int)blockIdx.x;
        if (vcu0 < BATCH * 16) rnn::rnn_consts((vcu0 >> 1) & 7, vcu0 & 1, a.in[14], a.in[15], a.in[16], a.in[17], a.in[18], a.in[19], a.in[20], lds);
        const int l64 = tid & 63;
        float d1 = a.in[9][l64] * a.in[10][l64], d2 = a.in[11][l64] * a.in[12][l64], gq = fabsf(a.in[7][l64]), gk = fabsf(a.in[8][l64]);
        d1 = wave_sum(d1); d2 = wave_sum(d2);
#pragma unroll
        for (int o_ = 1; o_ < 64; o_ <<= 1) { gq = fmaxf(gq, __shfl_xor(gq, o_)); gk = fmaxf(gk, __shfl_xor(gk, o_)); }
        if (tid == 0) { MISC[4] = __float_as_uint(expf(d1) - expf(d2) + LAMBDA_INIT); MISC[5] = __float_as_uint(-8.0f * gq * gk * 1.4426950408889634f); }
    }
    SEAM(3);
    if (IN(4)) {
        const int vcu = (G % 8 == 0) ? ((int)blockIdx.x % 8) * (G / 8) + (int)blockIdx.x / 8 : (int)blockIdx.x;
        if (lo > 3) { for (int u = vcu; u < BATCH * 16; u += G) rnn::rnn_unit<false>(u >> 4, (u >> 1) & 7, u & 1, XR, GATE, Y, a.in[14], a.in[15], a.in[16], a.in[17], a.in[18], a.in[19], a.in[20], lds);
            if (tid == 0) { MISC[4] = 0x7fc00000u; MISC[5] = 0x7fc00000u; } __syncthreads(); }
        else { if (vcu < BATCH * 16) rnn::rnn_unit<true>(vcu >> 4, (vcu >> 1) & 7, vcu & 1, XR, GATE, Y, a.in[14], a.in[15], a.in[16], a.in[17], a.in[18], a.in[19], a.in[20], lds);
            for (int u = vcu + G; u < BATCH * 16; u += G) rnn::rnn_unit<false>(u >> 4, (u >> 1) & 7, u & 1, XR, GATE, Y, a.in[14], a.in[15], a.in[16], a.in[17], a.in[18], a.in[19], a.in[20], lds); }
        const float lam = __uint_as_float(MISC[4]), negm_s = __uint_as_float(MISC[5]);
        REP(42) for (int v = vcu; v < 256; v += G) {
            const int bh = v >> 2, s = v & 3;
            for (int i = 0; i < 4; ++i) { const int cc = (i == 0) ? s : (i == 1) ? 7 - s : (i == 2) ? 8 + s : 15 - s;
                attn::attn_unit(bh >> 2, bh & 3, cc, Qb, Kb, Vb, Y, lam, negm_s, a.in[13], lds); }
        }
        __syncthreads();
    }
    SEAM(4);
    if (IN(5)) { pg8::Gemm g{Y, W4T, MTOK, DM, DM}; pg8::StaticOrder S; S.init(MTOK, DM, G, (int)blockIdx.x);
        pg8::EpiResid<true, true> E{nullptr, XB, nullptr, ss2, 1.0f}; pg8::gemm_phase<pg8::EpiResid<true, true>, pg8::StaticOrder, PG8_ALIGN, PG8_SP2>(lds, g, S, E); }
    SEAM(5);
    if (IN(6)) REP(6) { REPSYNC(); pg8::Gemm g{XB, W5T, MTOK, NFF, DM}; pg8::StaticOrder S; S.init(MTOK, NFF, G, (int)blockIdx.x);
        const int pmA = rinv_prepass(ss2, S, lds, tid); pg8::EpiSwiglu E{ACT, (const LAS float*)(lds + RTAB_OFF), pmA}; pg8::gemm_phase<pg8::EpiSwiglu, pg8::StaticOrder, PG8_ALIGN, PG8_SP2>(lds, g, S, E); }
    SEAM(6);
    if (IN(7)) { pg8::Gemm g{ACT, W6T, MTOK, DM, DFF}; RevOrder S; S.init_rev(MTOK, DM, G, (int)blockIdx.x);
        pg8::EpiResid<true, false> E{nullptr, XB, out, nullptr, 0.5f}; pg8::gemm_phase<pg8::EpiResid<true, false>, RevOrder, PG8_ALIGN, PG8_SP2>(lds, g, S, E); }
#undef IN
#undef SEAM
}

extern "C" void kernel_launch(void* const* d_in, const int* in_sizes, int n_in, void* d_out, int out_size, void* d_ws, size_t ws_size, hipStream_t stream) {
    static int grid_blocks = 0;
    if (grid_blocks == 0) {
        if (n_in != 25 || in_sizes[0] != MTOK * DM || out_size != MTOK * DM || ws_size < WS_END) { fprintf(stderr, "kernel_launch: unexpected shapes (n_in %d, ws %zu)\n", n_in, ws_size); grid_blocks = -1; return; }
        int dev = 0, cus = 0, per_cu = 0;
        if (hipGetDevice(&dev) != hipSuccess || hipDeviceGetAttribute(&cus, hipDeviceAttributeMultiprocessorCount, dev) != hipSuccess) { grid_blocks = -1; return; }
        if (hipFuncSetAttribute((const void*)mk_fwd, hipFuncAttributeMaxDynamicSharedMemorySize, LDS_BYTES) != hipSuccess) { fprintf(stderr, "kernel_launch: hipFuncSetAttribute failed\n"); grid_blocks = -1; return; }
        if (hipOccupancyMaxActiveBlocksPerMultiprocessor(&per_cu, (const void*)mk_fwd, NTHREADS, LDS_BYTES) != hipSuccess || per_cu < 1) { fprintf(stderr, "kernel_launch: occupancy query says %d blocks/CU\n", per_cu); grid_blocks = -1; return; }
        if (cus != 256) { fprintf(stderr, "kernel_launch: built for a 256-CU device (MI355X), found %d CUs; nothing launched\n", cus); grid_blocks = -1; return; }
        grid_blocks = 256;
    }
    if (grid_blocks < 0) return;
    if (hipMemsetAsync((char*)d_ws + WS_CTL, 0, CTL_ZERO_BYTES, stream) != hipSuccess) { fprintf(stderr, "kernel_launch: hipMemsetAsync failed\n"); return; }
    Args a{};
    for (int i = 0; i < 25; ++i) a.in[i] = (const float*)d_in[i];
    a.out = (float*)d_out; a.ws = (unsigned char*)d_ws;
    for (int j = 0; j < 8; ++j) a.invf[j] = (float)pow(500000.0, -(double)j / 8.0);
    a.ph_lo = 0; a.ph_hi = 8;
    void* args[] = {&a};
    hipError_t e = hipLaunchCooperativeKernel((const void*)mk_fwd, dim3(grid_blocks), dim3(NTHREADS), args, LDS_BYTES, stream);
    if (e != hipSuccess) fprintf(stderr, "cooperative launch failed: %s (grid %d)\n", hipGetErrorString(e), grid_blocks);
}
```

```cpp
#include <hip/hip_runtime.h>
#include <hip/hip_cooperative_groups.h>
#include <cstdio>
#include <cstdint>
#include <cmath>
namespace cg = cooperative_groups;

constexpr int DM = 1024, BATCH = 16, SEQ = 2048, MTOK = BATCH * SEQ;
constexpr int DFF = 2816, NFF = 2 * DFF, DATTN = 512, DRNN = 512, NPROJ = 2560;
constexpr int PQ = DFF;
constexpr float EPS = 1e-6f;
constexpr float LAMBDA_INIT = 0.2f;

typedef unsigned short bf16;
#define LAS __attribute__((address_space(3)))
typedef unsigned v4u __attribute__((ext_vector_type(4)));
typedef float v4f __attribute__((ext_vector_type(4)));

__device__ __forceinline__ unsigned f2bf(float f) { unsigned u = __builtin_bit_cast(unsigned, f); return (u + 0x7fffu + ((u >> 16) & 1u)) >> 16; }
typedef float f32x2_h __attribute__((ext_vector_type(2))); typedef __bf16 bf16x2_h __attribute__((ext_vector_type(2)));
__device__ __forceinline__ unsigned pk2(float lo, float hi) { const f32x2_h v = {lo, hi}; return __builtin_bit_cast(unsigned, __builtin_convertvector(v, bf16x2_h)); }
__device__ __forceinline__ float bf2f(bf16 h) { return __builtin_bit_cast(float, (unsigned)h << 16); }
__device__ __forceinline__ float wave_sum(float v) {
#pragma unroll
    for (int o = 1; o < 64; o <<= 1) v += __shfl_xor(v, o);
    return v;
}
__device__ __forceinline__ float rinv_of(const float* ss, size_t row) {
    const v4f* p = (const v4f*)(ss + row * 16); const v4f a = p[0], b = p[1], c = p[2], d = p[3];
    const float s = ((a.x + a.y) + (a.z + a.w)) + ((b.x + b.y) + (b.z + b.w)) + ((c.x + c.y) + (c.z + c.w)) + ((d.x + d.y) + (d.z + d.w));
    return 1.0f / sqrtf(s * (1.0f / DM) + EPS);
}

__device__ __forceinline__ float rinv_fq(const float* ss, size_t row, int fq) {
    const v4f a = *(const v4f*)(ss + row * 16 + 4 * fq); float s = (a.x + a.y) + (a.z + a.w);
    s += __shfl_xor(s, 16); s += __shfl_xor(s, 32);
    return 1.0f / sqrtf(s * (1.0f / DM) + EPS);
}

constexpr size_t MiB = 1u << 20;
constexpr size_t WS_CTL = 0;
constexpr size_t WS_W1T = 1 * MiB;
constexpr size_t WS_W2T = 12 * MiB;
constexpr size_t WS_W3T = 18 * MiB;
constexpr size_t WS_W4T = 23 * MiB;
constexpr size_t WS_W5T = 25 * MiB;
constexpr size_t WS_W6T = 36 * MiB;
constexpr size_t WS_ROPE = 42 * MiB;
constexpr size_t WS_SS = 44 * MiB;
constexpr size_t WS_XB = 50 * MiB;
constexpr size_t WS_Y = 114 * MiB;
constexpr size_t WS_ACT = 178 * MiB;
constexpr size_t WS_END = 354 * MiB;

namespace pg8 {
#define PG8_LAS __attribute__((address_space(3)))
typedef unsigned short bf16_t;
typedef short bf16x8 __attribute__((ext_vector_type(8)));
typedef float f32x4 __attribute__((ext_vector_type(4)));
typedef unsigned u32x4 __attribute__((ext_vector_type(4)));
constexpr int BM = 256, BK = 64, HALF = 128, HTB = HALF * BK * 2  , STAGE_BYTES = 8 * HTB, NXCD = 8, WGM = 8;

__host__ __device__ __forceinline__ int lds_byte(int r, int c) { const int st = (r >> 4) * 2 + (c >> 5), rr = r & 15, cc = c & 31, ob = rr * 64 + cc * 2; return st * 1024 + (ob ^ (((ob >> 9) & 1) << 5)); }
__host__ __device__ __forceinline__ void stage_rc(int b, int& R, int& C) { const int st = b / 1024, sb = b % 1024, swz = sb ^ (((sb >> 9) & 1) << 5); R = (st >> 1) * 16 + swz / 64; C = (st & 1) * 32 + (swz % 64) / 2; }
__host__ __device__ __forceinline__ int perm32(int rho) { const int n = rho >> 4, i = rho & 15; return 8 * (i >> 2) + 4 * n + (i & 3); }

struct Unit { int pm, pn; };
struct Gemm { const bf16_t* A; const bf16_t* Bt; int M, N, K; };

struct StaticOrder {
    int nM, nN, nwg, G, c;
    __host__ __device__ void init(int M, int N, int G_, int c_) { nM = M / BM; nN = N / BM; nwg = nM * nN; G = G_; c = c_; }
    __host__ __device__ bool next(int i, Unit& u) const {
        const long L = (long)i * G + c; if (L >= nwg) return false;
        int wgid = (int)L; { const int q = nwg / NXCD, r = nwg % NXCD, xcd = wgid % NXCD, off = wgid / NXCD; wgid = (xcd < r ? xcd * (q + 1) : r * (q + 1) + (xcd - r) * q) + off; }
        const int nig = WGM * nN, gid = wgid / nig, fm = gid * WGM, gsz = (nM - fm) < WGM ? (nM - fm) : WGM;
        u.pm = fm + ((wgid % nig) % gsz); u.pn = (wgid % nig) / gsz; return true;
    }
    __device__ __forceinline__ void a_ready(const Unit&) const {}
    __device__ __forceinline__ void done(const Unit&) const {}
};
__device__ __forceinline__ unsigned cvt_pk_bf16(float lo, float hi) { unsigned r; asm volatile("v_cvt_pk_bf16_f32 %0, %1, %2" : "=v"(r) : "v"(lo), "v"(hi)); return r; }
struct EpiSwiglu {
    static constexpr bool PERM = true, AFTER_DRAIN = false;
    bf16_t* act; const PG8_LAS float* rtab; int pmA;
    __device__ __forceinline__ void operator()(const f32x4 (&acc)[2][2][4][2], const Unit& u, int wr, int wc, int fr, int fq) const {
        const int row0 = u.pm * BM + wr * 64 + fr, col0 = (21 - u.pn) * 128 + wc * 32 + 8 * fq;
        const PG8_LAS float* rt = rtab + (u.pm == pmA ? 0 : 256) + wr * 64 + fr;
#pragma unroll
        for (int ai = 0; ai < 2; ++ai)
#pragma unroll
            for (int m = 0; m < 4; ++m) {
                const size_t row = (size_t)(row0 + ai * HALF + m * 16); const float r = rt[ai * HALF + m * 16];
                const float nr = -1.4426950408889634f * r, r2 = r * r;
                unsigned w[4];
#pragma unroll
                for (int n = 0; n < 2; ++n) {
                    typedef float f2 __attribute__((ext_vector_type(2)));
                    const f32x4 g = acc[ai][0][m][n], uu = acc[ai][1][m][n];
                    const f2 ga = {g[0], g[1]}, gb = {g[2], g[3]}, ua = {uu[0], uu[1]}, ub = {uu[2], uu[3]};
                    const f2 ta = ga * nr, tb = gb * nr;
                    f2 ea, eb; ea.x = __builtin_amdgcn_exp2f(ta.x); ea.y = __builtin_amdgcn_exp2f(ta.y); eb.x = __builtin_amdgcn_exp2f(tb.x); eb.y = __builtin_amdgcn_exp2f(tb.y);
                    const f2 da = ea + 1.0f, db = eb + 1.0f;
                    f2 ia, ib; ia.x = __builtin_amdgcn_rcpf(da.x); ia.y = __builtin_amdgcn_rcpf(da.y); ib.x = __builtin_amdgcn_rcpf(db.x); ib.y = __builtin_amdgcn_rcpf(db.y);
                    const f2 ha = (ga * ua) * (ia * r2), hb = (gb * ub) * (ib * r2);
                    w[2 * n] = cvt_pk_bf16(ha.x, ha.y); w[2 * n + 1] = cvt_pk_bf16(hb.x, hb.y); }
                *(u32x4*)(act + row * DFF + col0) = (u32x4){w[0], w[1], w[2], w[3]};
            }
    }
};
template <bool IN_BF16, bool OUT_BF16> struct EpiResid {
    static constexpr bool PERM = true, AFTER_DRAIN = false;
    const float* xin; bf16_t* xb; float* out; float* ssout; float alpha;
    __device__ __forceinline__ void operator()(const f32x4 (&acc)[2][2][4][2], const Unit& u, int wr, int wc, int fr, int fq) const {
        const int row0 = u.pm * BM + wr * 64 + fr, col0 = u.pn * BM + wc * 32 + 8 * fq;
        u32x4 w[2][4][2];
        if (IN_BF16) {
#pragma unroll
            for (int ai = 0; ai < 2; ++ai)
#pragma unroll
                for (int m = 0; m < 4; ++m)
#pragma unroll
                    for (int bj = 0; bj < 2; ++bj) w[ai][m][bj] = *(const u32x4*)(xb + (size_t)(row0 + ai * HALF + m * 16) * DM + col0 + bj * HALF);
        }
#pragma unroll
        for (int ai = 0; ai < 2; ++ai)
#pragma unroll
            for (int m = 0; m < 4; ++m) {
                const size_t row = (size_t)(row0 + ai * HALF + m * 16); float s = 0.f;
#pragma unroll
                for (int bj = 0; bj < 2; ++bj) { const size_t p = row * DM + col0 + bj * HALF;
                    f32x4 x0, x1;
                    if (IN_BF16) { const u32x4 wv = w[ai][m][bj];
                        x0 = (f32x4){__builtin_bit_cast(float, wv[0] << 16), __builtin_bit_cast(float, wv[0] & 0xffff0000u), __builtin_bit_cast(float, wv[1] << 16), __builtin_bit_cast(float, wv[1] & 0xffff0000u)};
                        x1 = (f32x4){__builtin_bit_cast(float, wv[2] << 16), __builtin_bit_cast(float, wv[2] & 0xffff0000u), __builtin_bit_cast(float, wv[3] << 16), __builtin_bit_cast(float, wv[3] & 0xffff0000u)}; }
                    else { x0 = __builtin_nontemporal_load((const f32x4*)(xin + p)); x1 = __builtin_nontemporal_load((const f32x4*)(xin + p + 4)); }
                    const f32x4 v0 = x0 + alpha * acc[ai][bj][m][0], v1 = x1 + alpha * acc[ai][bj][m][1];
                    if (OUT_BF16) { *(u32x4*)(xb + p) = (u32x4){cvt_pk_bf16(v0[0], v0[1]), cvt_pk_bf16(v0[2], v0[3]), cvt_pk_bf16(v1[0], v1[1]), cvt_pk_bf16(v1[2], v1[3])};
                        s += ((v0[0] * v0[0] + v0[1] * v0[1]) + (v0[2] * v0[2] + v0[3] * v0[3])) + ((v1[0] * v1[0] + v1[1] * v1[1]) + (v1[2] * v1[2] + v1[3] * v1[3])); }
                    else { __builtin_nontemporal_store(v0, (f32x4*)(out + p)); __builtin_nontemporal_store(v1, (f32x4*)(out + p + 4)); } }
                if (OUT_BF16) { s += __shfl_xor(s, 16); s += __shfl_xor(s, 32); if (fq == 0) ssout[row * 16 + 4 * u.pn + wc] = s; }
            }
    }
};
struct EpiProj {
    static constexpr bool PERM = true, AFTER_DRAIN = false;
    const PG8_LAS float* rtab; int pmA; const float* tab; const float* qn; const float* kn; bf16_t* qkv; float qscale;
    __device__ __forceinline__ void operator()(const f32x4 (&acc)[2][2][4][2], const Unit& u, int wr, int wc, int fr, int fq) const {
        const int row0 = u.pm * BM + wr * 64 + fr, kind = u.pn >> 1, half = u.pn & 1;
        const PG8_LAS float* rt = rtab + (u.pm == pmA ? 0 : 256) + wr * 64 + fr;
        bf16_t* base = qkv + kind * 512;
        if (kind >= 2) {
            const int col0 = half * 256 + wc * 32 + 8 * fq;
#pragma unroll
            for (int ai = 0; ai < 2; ++ai)
#pragma unroll
                for (int m = 0; m < 4; ++m) { const size_t row = (size_t)(row0 + ai * HALF + m * 16); const float r = rt[ai * HALF + m * 16];
#pragma unroll
                    for (int bj = 0; bj < 2; ++bj) { const f32x4 v0 = acc[ai][bj][m][0] * r, v1 = acc[ai][bj][m][1] * r;
                        *(u32x4*)(base + row * PQ + col0 + bj * HALF) = (u32x4){cvt_pk_bf16(v0[0], v0[1]), cvt_pk_bf16(v0[2], v0[3]), cvt_pk_bf16(v1[0], v1[1]), cvt_pk_bf16(v1[2], v1[3])}; } }
        } else {
            const int g = 4 * half + wc; const float* gp = kind == 0 ? qn : kn; const float sc = kind == 0 ? qscale : 1.0f;
            const bool rot = fq < 2; const int d00 = rot ? 4 * fq : 8 * fq, d01 = rot ? 8 + 4 * fq : 8 * fq + 4;
            f32x4 gn[2][2];
            gn[0][0] = *(const f32x4*)(gp + d00); gn[0][1] = *(const f32x4*)(gp + d01); gn[1][0] = *(const f32x4*)(gp + 32 + 8 * fq); gn[1][1] = *(const f32x4*)(gp + 36 + 8 * fq);
#pragma unroll
            for (int ai = 0; ai < 2; ++ai)
#pragma unroll
                for (int m = 0; m < 4; ++m) { const size_t row = (size_t)(row0 + ai * HALF + m * 16); const float r = rt[ai * HALF + m * 16];
                    const f32x4 cs = *(const f32x4*)(tab + row * 16 + 4 * (fq & 1)), sn = *(const f32x4*)(tab + row * 16 + 8 + 4 * (fq & 1));
                    f32x4 v[2][2]; float s = 0.f;
#pragma unroll
                    for (int bj = 0; bj < 2; ++bj)
#pragma unroll
                        for (int n = 0; n < 2; ++n) { v[bj][n] = acc[ai][bj][m][n] * r; s += (v[bj][n][0] * v[bj][n][0] + v[bj][n][1] * v[bj][n][1]) + (v[bj][n][2] * v[bj][n][2] + v[bj][n][3] * v[bj][n][3]); }
                    s += __shfl_xor(s, 16); s += __shfl_xor(s, 32);
                    const float nrm = sc * __builtin_amdgcn_rsqf(s * (1.0f / 64.0f) + EPS);
#pragma unroll
                    for (int bj = 0; bj < 2; ++bj)
#pragma unroll
                        for (int n = 0; n < 2; ++n) v[bj][n] = v[bj][n] * nrm * gn[bj][n];
                    { const f32x4 x1 = v[0][0], x2 = v[0][1], o1 = x1 * cs - x2 * sn, o2 = x2 * cs + x1 * sn;
#pragma unroll
                      for (int e = 0; e < 4; ++e) { v[0][0][e] = rot ? o1[e] : x1[e]; v[0][1][e] = rot ? o2[e] : x2[e]; } }
                    typedef unsigned u32x2e __attribute__((ext_vector_type(2)));
                    bf16_t* orow = base + row * PQ + 64 * g;
                    *(u32x2e*)(orow + d00) = (u32x2e){cvt_pk_bf16(v[0][0][0], v[0][0][1]), cvt_pk_bf16(v[0][0][2], v[0][0][3])};
                    *(u32x2e*)(orow + d01) = (u32x2e){cvt_pk_bf16(v[0][1][0], v[0][1][1]), cvt_pk_bf16(v[0][1][2], v[0][1][3])};
                    *(u32x4*)(orow + 32 + 8 * fq) = (u32x4){cvt_pk_bf16(v[1][0][0], v[1][0][1]), cvt_pk_bf16(v[1][0][2], v[1][0][3]), cvt_pk_bf16(v[1][1][0], v[1][1][1]), cvt_pk_bf16(v[1][1][2], v[1][1][3])};
                }
        }
    }
};
struct NoPre { __device__ __forceinline__ void operator()() const {} };
template <class Epi, class Sched, bool ALIGN_EPI = false, bool SP2 = false, class Pre = NoPre>
__device__ __forceinline__ void gemm_phase(PG8_LAS unsigned char* lds, const Gemm g, const Sched& S, const Epi& E, const Pre& pre = Pre()) {
    const int tid = threadIdx.x, wid = __builtin_amdgcn_readfirstlane(tid >> 6), lane = tid & 63, wr = wid >> 2, wc = wid & 3, fr = lane & 15, fq = lane >> 4;
    const int K = g.K, nt = K / BK;
    unsigned voffA[2], voffB[2];
#pragma unroll
    for (int i = 0; i < 2; ++i) { int R, C; stage_rc(tid * 16 + i * 8192, R, C); const int Rb = Epi::PERM ? ((R & ~31) + perm32(R & 31)) : R;
        voffA[i] = (unsigned)(R * K + C) * 2u; voffB[i] = (unsigned)(Rb * K + C) * 2u; }
    const size_t kstep = (size_t)(BK * 2);
    const size_t hstep = (size_t)HALF * K * 2;
    const size_t tstep = 2 * hstep;
    const unsigned ldsw = (unsigned)wid * 1024u;
    const int aoff = lds_byte(wr * 64 + fr, fq * 8), boff = lds_byte(wc * 32 + fr, fq * 8);
#define PG8_SA(b, h) (((b) * 2 + (h)) * HTB)
#define PG8_SB(b, h) ((4 + (b) * 2 + (h)) * HTB)
#define PG8_STAGE(bufoff, gbase, voff) do { _Pragma("unroll") for (int _i = 0; _i < 2; ++_i) \
        __builtin_amdgcn_global_load_lds((const unsigned*)((const char*)(gbase) + (voff)[_i]), (PG8_LAS unsigned*)(lds + (bufoff) + ldsw + _i * 8192), 16, 0, 0); } while (0)
#define PG8_LDA(dst, b, h) do { _Pragma("unroll") for (int m = 0; m < 4; ++m) _Pragma("unroll") for (int k = 0; k < 2; ++k) dst[m][k] = *(const PG8_LAS bf16x8*)(lds + PG8_SA(b, h) + aoff + m * 2048 + k * 1024); } while (0)
#define PG8_LDB(dst, b, h) do { _Pragma("unroll") for (int n = 0; n < 2; ++n) _Pragma("unroll") for (int k = 0; k < 2; ++k) dst[n][k] = *(const PG8_LAS bf16x8*)(lds + PG8_SB(b, h) + boff + n * 2048 + k * 1024); } while (0)
#define PG8_MMA(ai, bj, At, Bt) do { __builtin_amdgcn_s_setprio(1); _Pragma("unroll") for (int m = 0; m < 4; ++m) _Pragma("unroll") for (int n = 0; n < 2; ++n) _Pragma("unroll") for (int k = 0; k < 2; ++k) \
        acc[ai][bj][m][n] = __builtin_amdgcn_mfma_f32_16x16x32_bf16(Bt[n][k], At[m][k], acc[ai][bj][m][n], 0, 0, 0); __builtin_amdgcn_s_setprio(0); } while (0)
#define PG8_WAIT_V(n) asm volatile("s_waitcnt vmcnt(" #n ")" ::: "memory")
#define PG8_WAIT_L(n) asm volatile("s_waitcnt lgkmcnt(" #n ")" ::: "memory")
#define PG8_BAR __builtin_amdgcn_s_barrier()
#define PG8_SCHED __builtin_amdgcn_sched_barrier(0)
    Unit cur, nxt; int ui = 0;
    if (!S.next(0, cur)) return;
    f32x4 acc[2][2][4][2];
#pragma unroll
    for (int a = 0; a < 2; ++a)
#pragma unroll
        for (int b = 0; b < 2; ++b)
#pragma unroll
            for (int m = 0; m < 4; ++m)
#pragma unroll
                for (int n = 0; n < 2; ++n) acc[a][b][m][n] = (f32x4){0.f, 0.f, 0.f, 0.f};
    bf16x8 At[4][2], B0[2][2], B1[2][2];
    const char* cA = (const char*)g.A + (size_t)cur.pm * tstep; const char* cB = (const char*)g.Bt + (size_t)cur.pn * tstep;
    S.a_ready(cur);
    if constexpr (SP2) {
        PG8_STAGE(PG8_SB(0, 0), cB, voffB); PG8_STAGE(PG8_SB(0, 1), cB + hstep, voffB); PG8_STAGE(PG8_SA(0, 0), cA, voffA); PG8_STAGE(PG8_SA(0, 1), cA + hstep, voffA);
        pre();
        if (wr == 1) PG8_BAR;
        PG8_WAIT_V(2); PG8_BAR;
        PG8_STAGE(PG8_SB(1, 0), cB + kstep, voffB); PG8_STAGE(PG8_SA(1, 0), cA + kstep, voffA); PG8_STAGE(PG8_SB(1, 1), cB + hstep + kstep, voffB);
        PG8_WAIT_V(6); PG8_BAR;
    } else {
        PG8_STAGE(PG8_SB(0, 0), cB, voffB); PG8_STAGE(PG8_SA(0, 0), cA, voffA); PG8_STAGE(PG8_SB(0, 1), cB + hstep, voffB); PG8_STAGE(PG8_SA(0, 1), cA + hstep, voffA);
        if (wr == 1) PG8_BAR;
        PG8_WAIT_V(4); PG8_BAR;
        PG8_STAGE(PG8_SB(1, 0), cB + kstep, voffB); PG8_STAGE(PG8_SA(1, 0), cA + kstep, voffA); PG8_STAGE(PG8_SB(1, 1), cB + hstep + kstep, voffB);
        PG8_WAIT_V(6); PG8_BAR;
    }
    for (;;) {
        const bool has_next = S.next(ui + 1, nxt);
        const char* nA = has_next ? (const char*)g.A + (size_t)nxt.pm * tstep : cA; const char* nB = has_next ? (const char*)g.Bt + (size_t)nxt.pn * tstep : cB;
        for (int t = 0; t < nt; t += 2) {
            const bool last = (t == nt - 2);
            const char* a1 = cA + (size_t)(t + 1) * kstep;
            const char* a2 = last ? nA : cA + (size_t)(t + 2) * kstep; const char* b2 = last ? nB : cB + (size_t)(t + 2) * kstep;
            const char* a3 = a2 + kstep; const char* b3 = b2 + kstep;
            if (last && has_next) S.a_ready(nxt);
            if constexpr (SP2) {
            PG8_LDB(B0, 0, 0); PG8_LDB(B1, 0, 1); PG8_SCHED; PG8_LDA(At, 0, 0); PG8_STAGE(PG8_SA(1, 1), a1 + hstep, voffA);
            PG8_WAIT_V(8); PG8_WAIT_L(0); PG8_BAR; PG8_MMA(0, 0, At, B0); PG8_MMA(0, 1, At, B1); PG8_BAR; PG8_SCHED;
            PG8_LDA(At, 0, 1); PG8_STAGE(PG8_SB(0, 0), b2, voffB); PG8_STAGE(PG8_SB(0, 1), b2 + hstep, voffB); PG8_STAGE(PG8_SA(0, 0), a2, voffA);
            PG8_WAIT_V(8); PG8_WAIT_L(0); PG8_BAR; PG8_MMA(1, 0, At, B0); PG8_MMA(1, 1, At, B1); PG8_BAR; PG8_SCHED;
            PG8_LDB(B0, 1, 0); PG8_LDB(B1, 1, 1); PG8_SCHED; PG8_LDA(At, 1, 0); PG8_STAGE(PG8_SA(0, 1), a2 + hstep, voffA);
            PG8_WAIT_V(8); PG8_WAIT_L(0); PG8_BAR; PG8_MMA(0, 0, At, B0); PG8_MMA(0, 1, At, B1); PG8_BAR; PG8_SCHED;
            PG8_LDA(At, 1, 1); PG8_STAGE(PG8_SB(1, 0), b3, voffB); PG8_STAGE(PG8_SB(1, 1), b3 + hstep, voffB); PG8_STAGE(PG8_SA(1, 0), a3, voffA);
            PG8_WAIT_V(8); PG8_WAIT_L(0); PG8_BAR; PG8_MMA(1, 0, At, B0); PG8_MMA(1, 1, At, B1); PG8_BAR; PG8_SCHED;
            } else {
            PG8_LDB(B0, 0, 0); PG8_SCHED; PG8_LDA(At, 0, 0); PG8_STAGE(PG8_SA(1, 1), a1 + hstep, voffA);
            PG8_WAIT_L(8); PG8_BAR; PG8_WAIT_L(0); PG8_MMA(0, 0, At, B0); PG8_BAR; PG8_SCHED;
            PG8_LDB(B1, 0, 1); PG8_STAGE(PG8_SB(0, 0), b2, voffB);
            PG8_BAR; PG8_WAIT_L(0); PG8_MMA(0, 1, At, B1); PG8_BAR;
            PG8_LDA(At, 0, 1); PG8_STAGE(PG8_SA(0, 0), a2, voffA);
            PG8_BAR; PG8_WAIT_L(0); PG8_MMA(1, 0, At, B0); PG8_BAR; PG8_SCHED;
            PG8_STAGE(PG8_SB(0, 1), b2 + hstep, voffB);
            PG8_WAIT_V(6); PG8_BAR; PG8_MMA(1, 1, At, B1); PG8_BAR;
            PG8_LDB(B0, 1, 0); PG8_SCHED; PG8_LDA(At, 1, 0); PG8_STAGE(PG8_SA(0, 1), a2 + hstep, voffA);
            PG8_WAIT_L(8); PG8_BAR; PG8_WAIT_L(0); PG8_MMA(0, 0, At, B0); PG8_BAR; PG8_SCHED;
            PG8_LDB(B1, 1, 1); PG8_STAGE(PG8_SB(1, 0), b3, voffB);
            PG8_BAR; PG8_WAIT_L(0); PG8_MMA(0, 1, At, B1); PG8_BAR;
            PG8_LDA(At, 1, 1); PG8_STAGE(PG8_SA(1, 0), a3, voffA);
            PG8_BAR; PG8_WAIT_L(0); PG8_MMA(1, 0, At, B0); PG8_BAR; PG8_SCHED;
            PG8_STAGE(PG8_SB(1, 1), b3 + hstep, voffB);
            PG8_WAIT_V(6); PG8_BAR; PG8_MMA(1, 1, At, B1); PG8_BAR;
            }
        }
        if constexpr (ALIGN_EPI) { if (wr == 0) PG8_BAR; }
        if constexpr (!Epi::AFTER_DRAIN) { E(acc, cur, wr, wc, fr, fq); S.done(cur); }
        if (!has_next) break;
#pragma unroll
        for (int a = 0; a < 2; ++a)
#pragma unroll
            for (int b = 0; b < 2; ++b)
#pragma unroll
                for (int m = 0; m < 4; ++m)
#pragma unroll
                    for (int n = 0; n < 2; ++n) acc[a][b][m][n] = (f32x4){0.f, 0.f, 0.f, 0.f};
        cur = nxt; cA = nA; cB = nB; ++ui;
        if constexpr (ALIGN_EPI) { if (wr == 1) PG8_BAR; }
    }
    PG8_WAIT_V(0);
    if constexpr (!ALIGN_EPI) { if (wr == 0) PG8_BAR; }
    PG8_BAR;
    if constexpr (Epi::AFTER_DRAIN) { E.fused(acc, cur, wr, wc, fr, fq, lds, wid, lane); S.done(cur); }
#undef PG8_SA
#undef PG8_SB
#undef PG8_STAGE
#undef PG8_LDA
#undef PG8_LDB
#undef PG8_MMA
#undef PG8_WAIT_V
#undef PG8_WAIT_L
#undef PG8_BAR
#undef PG8_SCHED
}
}

#ifndef ATT_PROBE
#define ATT_PROBE 0
#endif
namespace attn {
using bf16x8 = __attribute__((ext_vector_type(8))) short;
using s16x4 = __attribute__((ext_vector_type(4))) short;
using f32x16 = __attribute__((ext_vector_type(16))) float;
using u32x4 = __attribute__((ext_vector_type(4))) unsigned;
typedef short v4i16_t __attribute__((ext_vector_type(4)));
typedef __attribute__((address_space(3))) const char* lds_cptr;
constexpr int SLOTB = 32768, NSLOT = 3, LDS_WS = NSLOT * SLOTB  , LDS_X = 0  , LDS_STG = 65536  ;
__device__ __forceinline__ int crow(int r, int hi) { return (r & 3) + 8 * (r >> 2) + 4 * hi; }
__device__ __forceinline__ void glds16(const void* gsrc, unsigned lds_dst) { unsigned keep;
    asm volatile("s_mov_b32 %0, m0\n\ts_mov_b32 m0, %2\n\ts_nop 0\n\tglobal_load_lds_dwordx4 %1, off\n\ts_mov_b32 m0, %0" : "=&s"(keep) : "v"(gsrc), "s"(lds_dst) : "memory"); }
typedef float f32x2_t __attribute__((ext_vector_type(2))); typedef __bf16 bf16x2_t __attribute__((ext_vector_type(2)));
__device__ __forceinline__ unsigned cvtpk(float lo, float hi) { f32x2_t v = {lo, hi}; bf16x2_t b = __builtin_convertvector(v, bf16x2_t); return __builtin_bit_cast(unsigned, b); }
__device__ __forceinline__ s16x4 vtr(lds_cptr p) { return __builtin_bit_cast(s16x4, __builtin_amdgcn_ds_read_tr16_b64_v4i16((__attribute__((address_space(3))) v4i16_t*)p)); }
#define ATT_WAIT_BAR(N) asm volatile("s_waitcnt vmcnt(" #N ") lgkmcnt(0)\n\ts_barrier" ::: "memory")

__device__ __forceinline__ void attn_unit(int b, int h, int cc, const bf16* Q, const bf16* __restrict__ K, const bf16* __restrict__ V, bf16* Y, float lam, float negm_s, const float* subln, LAS unsigned char* lds) {
    const int tid = threadIdx.x, lane = tid & 63, r32 = lane & 31, hi = lane >> 5; const int wid = __builtin_amdgcn_readfirstlane(tid >> 6);
    const int qg = wid & 3, map = wid >> 2;
    const size_t rowbase = (size_t)b * SEQ; const int q0 = 128 * cc;
    const bf16* Qw = Q + (rowbase + q0 + 32 * qg) * PQ + h * 128 + map * 64;
    const bf16* Kh = K + rowbase * PQ + h * 128; const bf16* Vh = V + rowbase * PQ + h * 128;
    const unsigned lds0 = (unsigned)(uintptr_t)lds;
    const lds_cptr lds3 = (lds_cptr)lds;
    LAS float* wsf = (LAS float*)(lds + LDS_WS) + wid * 64;
    const int NT = 2 * cc + 2, my_nt = 2 * cc + (qg >> 1) + 1;
    const bf16* ksrc0 = Kh + (size_t)lane * PQ + wid * 8; const bf16* ksrc1 = ksrc0 + 64;
    const bf16* vsrc0 = Vh + (size_t)(16 * (wid & 3) + (lane >> 2)) * PQ + (wid >> 2) * 32 + (lane & 3) * 8; const bf16* vsrc1 = vsrc0 + 64;
    const unsigned kdst = lds0 + wid * 1024, vdst = lds0 + 16384 + wid * 1024;
#define ATT_DMA(t, slot) do { const size_t to_ = (size_t)(t) * 64 * PQ; const unsigned sl_ = (unsigned)(slot); \
        glds16(ksrc0 + to_, (unsigned)__builtin_amdgcn_readfirstlane(kdst + sl_)); glds16(ksrc1 + to_, (unsigned)__builtin_amdgcn_readfirstlane(kdst + sl_ + 8192u)); \
        glds16(vsrc0 + to_, (unsigned)__builtin_amdgcn_readfirstlane(vdst + sl_)); glds16(vsrc1 + to_, (unsigned)__builtin_amdgcn_readfirstlane(vdst + sl_ + 8192u)); } while (0)
    ATT_DMA(0, 0); ATT_DMA(1, SLOTB);
    bf16x8 qr[4];
#pragma unroll
    for (int s = 0; s < 4; ++s) qr[s] = *reinterpret_cast<const bf16x8*>(&Qw[(size_t)r32 * PQ + s * 16 + hi * 8]);
    f32x16 o[4]; o[0] = f32x16{}; o[1] = f32x16{}; o[2] = f32x16{}; o[3] = f32x16{};
    f32x16 negm; float nm_ = negm_s; asm volatile("" : "+v"(nm_));
#pragma unroll
    for (int r = 0; r < 16; ++r) negm[r] = nm_;
    asm volatile("" : "+v"(negm));
    float l_reg = 0.f;
    const lds_cptr kp0 = lds3 + map * 8192 + hi * 1024 + r32 * 16;
    const lds_cptr vp0 = lds3 + 16384 + ((lane >> 4) & 1) * 32 + (lane & 3) * 8 + (4 * hi + ((lane & 15) >> 2)) * 64;
    int slot = 0;
    for (int t = 0; t < NT; ++t) {
        if (t + 1 < NT) { ATT_WAIT_BAR(4); } else { ATT_WAIT_BAR(0); }
        int s2 = slot + 2 * SLOTB; if (s2 >= NSLOT * SLOTB) s2 -= NSLOT * SLOTB;
        if (t < my_nt) {
            const lds_cptr kp = kp0 + slot; const lds_cptr vp = vp0 + slot;
            bf16x8 kf[8];
#pragma unroll
            for (int s = 0; s < 4; ++s) { kf[2 * s] = *(const __attribute__((address_space(3))) bf16x8*)(kp + s * 2048); kf[2 * s + 1] = *(const __attribute__((address_space(3))) bf16x8*)(kp + s * 2048 + 512); }
            f32x16 p0 = __builtin_amdgcn_mfma_f32_32x32x16_bf16(kf[0], qr[0], negm, 0, 0, 0), p1 = __builtin_amdgcn_mfma_f32_32x32x16_bf16(kf[1], qr[0], negm, 0, 0, 0);
#pragma unroll
            for (int s = 1; s < 4; ++s) { p0 = __builtin_amdgcn_mfma_f32_32x32x16_bf16(kf[2 * s], qr[s], p0, 0, 0, 0); p1 = __builtin_amdgcn_mfma_f32_32x32x16_bf16(kf[2 * s + 1], qr[s], p1, 0, 0, 0); }
#define ATT_VLOAD(VF, KS) do { _Pragma("unroll") for (int db = 0; db < 4; ++db) { const s16x4 vlo = vtr(vp + db * 4096 + (KS) * 1024), vhi = vtr(vp + db * 4096 + (KS) * 1024 + 512); \
                VF[db] = (bf16x8){vlo[0], vlo[1], vlo[2], vlo[3], vhi[0], vhi[1], vhi[2], vhi[3]}; } } while (0)
#define ATT_EXPK(P, B, W) do { _Pragma("unroll") for (int r = 0; r < 8; ++r) { P[(B) + r] = __builtin_amdgcn_exp2f(P[(B) + r]); sacc += P[(B) + r]; } \
                W = (u32x4){cvtpk(P[(B)], P[(B) + 1]), cvtpk(P[(B) + 2], P[(B) + 3]), cvtpk(P[(B) + 4], P[(B) + 5]), cvtpk(P[(B) + 6], P[(B) + 7])}; } while (0)
#define ATT_PVK(VF, W) do { _Pragma("unroll") for (int db = 0; db < 4; ++db) o[db] = __builtin_amdgcn_mfma_f32_32x32x16_bf16(__builtin_bit_cast(bf16x8, W), VF[db], o[db], 0, 0, 0); } while (0)
            bf16x8 vfa[4], vfb[4]; u32x4 pwa, pwb; float sacc = 0.f;
            __builtin_amdgcn_sched_barrier(0);
            ATT_VLOAD(vfa, 0);
            if (t + 2 < NT) ATT_DMA(t + 2, s2);
            __builtin_amdgcn_sched_barrier(0);
            ATT_EXPK(p0, 0, pwa);
            ATT_VLOAD(vfb, 1); __builtin_amdgcn_sched_barrier(0);
            ATT_PVK(vfa, pwa); ATT_EXPK(p0, 8, pwb); __builtin_amdgcn_sched_barrier(0);
            ATT_VLOAD(vfa, 2); __builtin_amdgcn_sched_barrier(0);
            ATT_PVK(vfb, pwb); ATT_EXPK(p1, 0, pwa); __builtin_amdgcn_sched_barrier(0);
            ATT_VLOAD(vfb, 3); __builtin_amdgcn_sched_barrier(0);
            ATT_PVK(vfa, pwa); ATT_EXPK(p1, 8, pwb); __builtin_amdgcn_sched_barrier(0);
            ATT_PVK(vfb, pwb);
#undef ATT_VLOAD
#undef ATT_EXPK
#undef ATT_PVK
            l_reg += sacc;
        }
        else if (t + 2 < NT) ATT_DMA(t + 2, s2);
        slot += SLOTB; if (slot == NSLOT * SLOTB) slot = 0;
    }
    int lane_e = lane; asm volatile("" : "+v"(lane_e));
    const int r32e = lane_e & 31, hie = lane_e >> 5;
    l_reg += __shfl_xor(l_reg, 32);
    const float scl = (map == 0 ? 1.0f : lam) / l_reg;
    if (hie == 0) wsf[r32e] = scl;
    asm volatile("s_waitcnt lgkmcnt(0)" ::: "memory");
    float sc[16];
#pragma unroll
    for (int r = 0; r < 16; ++r) sc[r] = wsf[crow(r, hie)];
#pragma unroll
    for (int db = 0; db < 4; ++db)
#pragma unroll
        for (int r = 0; r < 16; ++r) o[db][r] *= sc[r];
    ATT_WAIT_BAR(0);
    LAS float* xb = (LAS float*)(lds + LDS_X) + qg * 4096;
    if (map == 1) {
#pragma unroll
        for (int db = 0; db < 4; ++db)
#pragma unroll
            for (int r = 0; r < 16; ++r) xb[(db * 16 + r) * 64 + lane_e] = o[db][r];
    }
    ATT_WAIT_BAR(0);
    if (map == 0) {
        float ss[16];
#pragma unroll
        for (int r = 0; r < 16; ++r) ss[r] = 0.f;
#pragma unroll
        for (int db = 0; db < 4; ++db)
#pragma unroll
            for (int r = 0; r < 16; ++r) { o[db][r] -= xb[(db * 16 + r) * 64 + lane_e]; ss[r] += o[db][r] * o[db][r]; }
#pragma unroll
        for (int r = 0; r < 16; ++r) {
#pragma unroll
            for (int m = 1; m < 32; m <<= 1) ss[r] += __shfl_xor(ss[r], m);
            ss[r] = (1.0f - LAMBDA_INIT) / sqrtf(ss[r] * (1.0f / 128.0f) + EPS); }
        LAS bf16* stg = (LAS bf16*)(lds + LDS_STG) + qg * 4096;
#pragma unroll
        for (int db = 0; db < 4; ++db) { const float gsub = subln[32 * db + r32e];
#pragma unroll
            for (int r = 0; r < 16; ++r) stg[crow(r, hie) * 128 + 32 * db + r32e] = (bf16)f2bf(o[db][r] * ss[r] * gsub); }
        asm volatile("s_waitcnt lgkmcnt(0)" ::: "memory");
        bf16* Yw = Y + (rowbase + q0 + 32 * qg) * DM + h * 128;
#pragma unroll
        for (int i = 0; i < 8; ++i) { const int id = i * 64 + lane_e, row = id >> 4, ch = id & 15;
            const u32x4 v = *(const LAS u32x4*)(stg + row * 128 + ch * 8); *(u32x4*)(Yw + (size_t)row * DM + ch * 8) = v; }
    }
    ATT_WAIT_BAR(0);
#undef ATT_DMA
}
#undef ATT_WAIT_BAR
}

namespace rnn {
using bf16x8 = __attribute__((ext_vector_type(8))) short;
using f32x16 = __attribute__((ext_vector_type(16))) float;
typedef float f32x2_t __attribute__((ext_vector_type(2))); typedef __bf16 bf16x2_t __attribute__((ext_vector_type(2)));
typedef unsigned u32x2 __attribute__((ext_vector_type(2)));
__device__ __forceinline__ unsigned cvtpk(float lo, float hi) { f32x2_t v = {lo, hi}; bf16x2_t b = __builtin_convertvector(v, bf16x2_t); return __builtin_bit_cast(unsigned, b); }
__device__ __forceinline__ float sigm2(float z) { return __builtin_amdgcn_rcpf(1.0f + __builtin_amdgcn_exp2f(z)); }
constexpr int LDS_CW = 0  , LDS_CH = 1536  , LDS_COMP = 2048  , LDS_CIN = 6144  , LDS_W = 8192  ,
              LDS_XS = 16384  , XS_BYTES = 264 * 128;
__device__ __forceinline__ void glds16(const void* gsrc, unsigned lds_dst) { unsigned keep;
    asm volatile("s_mov_b32 %0, m0\n\ts_mov_b32 m0, %2\n\ts_nop 0\n\tglobal_load_lds_dwordx4 %1, off\n\ts_mov_b32 m0, %0" : "=&s"(keep) : "v"(gsrc), "s"(lds_dst) : "memory"); }

__device__ __forceinline__ void rnn_consts(int n, int dh, const float* conv_w, const float* conv_b, const float* w_a, const float* b_a, const float* w_x, const float* b_x, const float* a_param, LAS unsigned char* lds) {
    const int tid = threadIdx.x, lane = tid & 63, r32 = lane & 31, hi = lane >> 5; const int wid = __builtin_amdgcn_readfirstlane(tid >> 6);
    LAS float* cwl = (LAS float*)(lds + LDS_CW); LAS float* chl = (LAS float*)(lds + LDS_CH);
    if (tid < 256) cwl[tid] = conv_w[(tid >> 6) * DRNN + n * 64 + (tid & 63)]; else if (tid < 320) cwl[tid] = conv_b[n * 64 + tid - 256];
    else if (tid < 352) { const int ch = n * 64 + 32 * dh + tid - 320; chl[tid - 320] = -1.4426950408889634f * b_a[ch]; chl[32 + tid - 320] = -1.4426950408889634f * b_x[ch]; chl[64 + tid - 320] = -8.0f * 1.4426950408889634f * log1pf(expf(-a_param[ch])); }
    { const int mat = wid >> 2, s = wid & 3; const float* wsrc = mat ? w_x : w_a; bf16x8 f;
#pragma unroll
        for (int j = 0; j < 8; ++j) { const int c = 16 * s + 8 * (j >> 2) + 4 * hi + (j & 3); f[j] = (short)f2bf(-1.4426950408889634f * wsrc[(size_t)(n * 64 + c) * 64 + 32 * dh + r32]); }
        *(LAS bf16x8*)(lds + LDS_W + (wid * 64 + lane) * 16) = f; }
}

template <bool PREP> __device__ __forceinline__ void rnn_unit(int b, int n, int dh, const bf16* __restrict__ XR, const bf16* __restrict__ GATE, bf16* __restrict__ Y, const float* conv_w, const float* conv_b,
                                         const float* w_a, const float* b_a, const float* w_x, const float* b_x, const float* a_param, LAS unsigned char* lds) {
    const int tid = threadIdx.x, lane = tid & 63, r32 = lane & 31, hi = lane >> 5; const int wid = __builtin_amdgcn_readfirstlane(tid >> 6);
    LAS float* cwl = (LAS float*)(lds + LDS_CW); LAS float* chl = (LAS float*)(lds + LDS_CH); LAS float* comp = (LAS float*)(lds + LDS_COMP);
    __syncthreads();
    const size_t seq0 = (size_t)b * SEQ;
    const unsigned lds0 = (unsigned)(uintptr_t)lds;
    const bf16* xsrc = XR + ((long)seq0 - 8 + (lane >> 3)) * PQ + n * 64;
#define RNN_DMA(rd_, buf_) do { const bf16* xs_ = xsrc + (size_t)(rd_) * 256 * PQ; const unsigned db_ = lds0 + LDS_XS + (unsigned)(buf_) * XS_BYTES; \
        _Pragma("unroll") for (int j_ = 0; j_ < 4; ++j_) { const int i_ = wid + 8 * j_; const int rw_ = 8 * i_ + (lane >> 3); \
            glds16(xs_ + (size_t)(8 * i_) * PQ + 8 * ((lane & 7) ^ ((rw_ >> 1) & 7)), (unsigned)__builtin_amdgcn_readfirstlane(db_ + 1024u * i_)); } \
        if (wid == 0) { const int rw_ = 256 + (lane >> 3); glds16(xs_ + (size_t)256 * PQ + 8 * ((lane & 7) ^ ((rw_ >> 1) & 7)), (unsigned)__builtin_amdgcn_readfirstlane(db_ + 32768u)); } } while (0)
    RNN_DMA(0, 0);
    if (!PREP) rnn_consts(n, dh, conv_w, conv_b, w_a, b_a, w_x, b_x, a_param, lds);
    const LAS bf16x8* wfr = (const LAS bf16x8*)(lds + LDS_W) + lane;
    float carry1 = 0.f;
    asm volatile("s_waitcnt vmcnt(0) lgkmcnt(0)\n\ts_barrier" ::: "memory");
    if (wid == 0) *(LAS v4u*)(lds + LDS_XS + lane * 16) = (v4u){0u, 0u, 0u, 0u};
    asm volatile("s_waitcnt lgkmcnt(0)\n\ts_barrier" ::: "memory");
    for (int rd = 0; rd < SEQ / 256; ++rd) {
        const int t = 32 * (8 * rd + wid) + r32; const size_t row = seq0 + t;
        if (rd + 1 < SEQ / 256) RNN_DMA(rd + 1, (rd + 1) & 1);
        bf16x8 xf[4]; float xsel[16];
        u32x2 gv[4];
#pragma unroll
        for (int g = 0; g < 4; ++g) gv[g] = *(const u32x2*)(GATE + row * PQ + n * 64 + 32 * dh + 8 * g + 4 * hi);
        const LAS unsigned char* xsb = lds + LDS_XS + (rd & 1) * XS_BYTES + 8 * hi;
        const int rl0 = 5 + 32 * wid + r32;
#pragma unroll
        for (int s = 0; s < 4; ++s) {
            float xc[8];
#pragma unroll
            for (int hf = 0; hf < 2; ++hf) { const int c0 = 16 * s + 8 * hf + 4 * hi;
                const v4f cb = *(const LAS v4f*)(cwl + 256 + c0); float acc4[4] = {cb[0], cb[1], cb[2], cb[3]};
#pragma unroll
                for (int k = 0; k < 4; ++k) { const int rl = rl0 + k;
                    const u32x2 x2 = *(const LAS u32x2*)(xsb + (rl * 8 + ((2 * s + hf) ^ ((rl >> 1) & 7))) * 16);
                    const v4f cw = *(const LAS v4f*)(cwl + k * 64 + c0);
                    acc4[0] += cw[0] * __builtin_bit_cast(float, x2[0] << 16); acc4[1] += cw[1] * __builtin_bit_cast(float, x2[0] & 0xffff0000u);
                    acc4[2] += cw[2] * __builtin_bit_cast(float, x2[1] << 16); acc4[3] += cw[3] * __builtin_bit_cast(float, x2[1] & 0xffff0000u); }
#pragma unroll
                for (int e = 0; e < 4; ++e) xc[4 * hf + e] = acc4[e]; }
            const unsigned w0 = cvtpk(xc[0], xc[1]), w1 = cvtpk(xc[2], xc[3]), w2 = cvtpk(xc[4], xc[5]), w3 = cvtpk(xc[6], xc[7]);
            xf[s] = __builtin_bit_cast(bf16x8, (v4u){w0, w1, w2, w3});
            if (s < 2) {
#pragma unroll
                for (int j = 0; j < 8; ++j) xsel[8 * s + j] = xc[j];
            } else {
#pragma unroll
                for (int j = 0; j < 8; ++j) xsel[8 * (s - 2) + j] = dh ? xc[j] : xsel[8 * (s - 2) + j];
            }
        }
        f32x16 ga, gx; float sp[16];
#pragma unroll
        for (int g = 0; g < 4; ++g) { const v4f a4 = *(const LAS v4f*)(chl + 8 * g + 4 * hi), x4 = *(const LAS v4f*)(chl + 32 + 8 * g + 4 * hi), s4 = *(const LAS v4f*)(chl + 64 + 8 * g + 4 * hi);
#pragma unroll
            for (int e = 0; e < 4; ++e) { ga[4 * g + e] = a4[e]; gx[4 * g + e] = x4[e]; sp[4 * g + e] = s4[e]; } }
#pragma unroll
        for (int s = 0; s < 4; ++s) { ga = __builtin_amdgcn_mfma_f32_32x32x16_bf16(wfr[s * 64], xf[s], ga, 0, 0, 0); gx = __builtin_amdgcn_mfma_f32_32x32x16_bf16(wfr[(4 + s) * 64], xf[s], gx, 0, 0, 0); }
        float av[16], bv[16];
#pragma unroll
        for (int r = 0; r < 16; ++r) { const float rg = sigm2(ga[r]), ig = sigm2(gx[r]);
            const float aa = __builtin_amdgcn_exp2f(sp[r] * rg); av[r] = aa; bv[r] = __builtin_amdgcn_sqrtf(fmaxf(1.0f - aa * aa, 0.f)) * ig * xsel[r]; }
#define RNN_STEPS(CTRL) \
        "v_fmac_f32_dpp %8, %8, %0 " CTRL "\n\tv_fmac_f32_dpp %9, %9, %1 " CTRL "\n\tv_fmac_f32_dpp %10, %10, %2 " CTRL "\n\tv_fmac_f32_dpp %11, %11, %3 " CTRL "\n\t" \
        "v_fmac_f32_dpp %12, %12, %4 " CTRL "\n\tv_fmac_f32_dpp %13, %13, %5 " CTRL "\n\tv_fmac_f32_dpp %14, %14, %6 " CTRL "\n\tv_fmac_f32_dpp %15, %15, %7 " CTRL "\n\t" \
        "v_mul_f32_dpp %0, %0, %0 " CTRL "\n\tv_mul_f32_dpp %1, %1, %1 " CTRL "\n\tv_mul_f32_dpp %2, %2, %2 " CTRL "\n\tv_mul_f32_dpp %3, %3, %3 " CTRL "\n\t" \
        "v_mul_f32_dpp %4, %4, %4 " CTRL "\n\tv_mul_f32_dpp %5, %5, %5 " CTRL "\n\tv_mul_f32_dpp %6, %6, %6 " CTRL "\n\tv_mul_f32_dpp %7, %7, %7 " CTRL "\n\t"
#define RNN_SCAN8(o) asm volatile("s_nop 1\n\t" RNN_STEPS("row_shr:1 row_mask:0xf bank_mask:0xf") RNN_STEPS("row_shr:2 row_mask:0xf bank_mask:0xf") RNN_STEPS("row_shr:4 row_mask:0xf bank_mask:0xf") \
            RNN_STEPS("row_shr:8 row_mask:0xf bank_mask:0xf") RNN_STEPS("row_bcast:15 row_mask:0xa bank_mask:0xf") \
            : "+v"(av[o]), "+v"(av[o + 1]), "+v"(av[o + 2]), "+v"(av[o + 3]), "+v"(av[o + 4]), "+v"(av[o + 5]), "+v"(av[o + 6]), "+v"(av[o + 7]), \
              "+v"(bv[o]), "+v"(bv[o + 1]), "+v"(bv[o + 2]), "+v"(bv[o + 3]), "+v"(bv[o + 4]), "+v"(bv[o + 5]), "+v"(bv[o + 6]), "+v"(bv[o + 7]))
        RNN_SCAN8(0); RNN_SCAN8(8);
#undef RNN_SCAN8
#undef RNN_STEPS
        LAS float* cp = comp + (rd & 1) * 512;
        if (r32 == 31) {
#pragma unroll
            for (int g = 0; g < 4; ++g) { *(LAS v4f*)(cp + (wid * 2 + 0) * 32 + 8 * g + 4 * hi) = (v4f){av[4 * g], av[4 * g + 1], av[4 * g + 2], av[4 * g + 3]};
                *(LAS v4f*)(cp + (wid * 2 + 1) * 32 + 8 * g + 4 * hi) = (v4f){bv[4 * g], bv[4 * g + 1], bv[4 * g + 2], bv[4 * g + 3]}; }
        }
        asm volatile("s_waitcnt vmcnt(0) lgkmcnt(0)\n\ts_barrier" ::: "memory");
        float cin1 = carry1;
#pragma unroll
        for (int w = 0; w < 8; ++w) { const float A1 = cp[(w * 2 + 0) * 32 + r32], B1 = cp[(w * 2 + 1) * 32 + r32];
            cin1 = (w == wid) ? carry1 : cin1; carry1 = A1 * carry1 + B1; }
        LAS float* cib = (LAS float*)(lds + LDS_CIN) + wid * 32;
        if (hi == 0) cib[r32] = cin1;
        asm volatile("s_waitcnt lgkmcnt(0)" ::: "memory");
        float cin[16];
#pragma unroll
        for (int g = 0; g < 4; ++g) { const v4f c4 = *(const LAS v4f*)(cib + 8 * g + 4 * hi);
#pragma unroll
            for (int e = 0; e < 4; ++e) cin[4 * g + e] = c4[e]; }
#pragma unroll
        for (int g = 0; g < 4; ++g) { const int c0 = n * 64 + 32 * dh + 8 * g + 4 * hi;
            const float gt[4] = {__builtin_bit_cast(float, gv[g][0] << 16), __builtin_bit_cast(float, gv[g][0] & 0xffff0000u), __builtin_bit_cast(float, gv[g][1] << 16), __builtin_bit_cast(float, gv[g][1] & 0xffff0000u)};
            float y[4];
#pragma unroll
            for (int e = 0; e < 4; ++e) { const int r = 4 * g + e; const float h = av[r] * cin[r] + bv[r]; const float x = gt[e];
                y[e] = h * x * sigm2(x * (-2.3022081981531984f + -0.10294323958041973f * (x * x))); }
            *(u32x2*)(Y + row * DM + DATTN + c0) = (u32x2){cvtpk(y[0], y[1]), cvtpk(y[2], y[3])}; }
    }
#undef RNN_DMA
    __syncthreads();
}
}

typedef __attribute__((address_space(1))) unsigned gu32;
#define RLX_AGENT __ATOMIC_RELAXED, __HIP_MEMORY_SCOPE_AGENT
#define XB_TMO      128
#define XB_XCNT(j)  (256  + 64 * (j))
#define XB_XSUB(j)  (1280 + 64 * (j))
#define XB_XGEN(j)  (2304 + 64 * (j))
#define XB_TOP      3328
#define XB_TOPGEN   3392
#define XCD_BAR_WORDS 3456
#define XB_SPIN_CAP (1u << 18)

__device__ __forceinline__ unsigned xb_ld(unsigned* p)              { return __hip_atomic_load(p, __ATOMIC_RELAXED, __HIP_MEMORY_SCOPE_AGENT); }
__device__ __forceinline__ unsigned xb_add(unsigned* p, unsigned v) { return __hip_atomic_fetch_add(p, v, __ATOMIC_RELAXED, __HIP_MEMORY_SCOPE_AGENT); }
__device__ __forceinline__ unsigned xb_xcc_id() { return (unsigned)__builtin_amdgcn_s_getreg((3 << 11) | 20) & 0xFu; }
#define XB_SPIN(cond, bar) do { unsigned _sp = 0; while (cond) { __builtin_amdgcn_s_sleep(1); \
    if ((++_sp & 255u) == 0u) { if (xb_ld(&(bar)[XB_TMO])) break; if (_sp > XB_SPIN_CAP) { atomicAdd(&(bar)[XB_TMO], 1u); break; } } } } while (0)

struct XcdBarrier {
    unsigned* bar; unsigned x;
    volatile LAS unsigned* st;
};

__device__ __forceinline__ XcdBarrier xcd_barrier_post(unsigned* bar, volatile LAS unsigned* st) {
    XcdBarrier b; b.bar = bar; b.x = xb_xcc_id(); b.st = st;
    if (threadIdx.x == 0) (void)xb_add(&bar[XB_XCNT(b.x)], 1u);
    return b;
}
__device__ __forceinline__ void xcd_barrier_complete(unsigned* bar, unsigned x, unsigned& nloc, unsigned& nx) {
    const unsigned G = gridDim.x * gridDim.y * gridDim.z;
    unsigned sum, cnt, mine, sp = 0u;
    for (;;) {
        sum = 0u; cnt = 0u; mine = 0u;
#pragma unroll
        for (unsigned j = 0; j < 16; ++j) { const unsigned c = xb_ld(&bar[XB_XCNT(j)]); sum += c; cnt += (c > 0u) ? 1u : 0u; mine = (j == x) ? c : mine; }
        if (sum == G) break;
        __builtin_amdgcn_s_sleep(1);
        if ((++sp & 255u) == 0u) { if (xb_ld(&bar[XB_TMO])) break; if (sp > XB_SPIN_CAP) { atomicAdd(&bar[XB_TMO], 1u); break; } }
    }
    nloc = mine > 0u ? mine : 1u; nx = cnt > 0u ? cnt : 1u;
}

__device__ __forceinline__ void xcd_barrier(const XcdBarrier& b) {
    asm volatile("s_waitcnt vmcnt(0)" ::: "memory");
    __syncthreads();
    if (threadIdx.x == 0) {
        unsigned* bar = b.bar;
        __builtin_amdgcn_s_waitcnt(0);
        unsigned nloc = b.st[0], nx = b.st[1];
        if (nloc == 0u) { xcd_barrier_complete(bar, b.x, nloc, nx); b.st[0] = nloc; b.st[1] = nx; }
        const unsigned old = xb_add(&bar[XB_XSUB(b.x)], 1u);
        const unsigned gen = old / nloc;
        if (old + 1u == (gen + 1u) * nloc) {
            __builtin_amdgcn_fence(__ATOMIC_RELEASE, "agent");
            asm volatile("s_waitcnt vmcnt(0)" ::: "memory");
            const unsigned og = xb_add(&bar[XB_TOP], 1u);
            const unsigned tg = og / nx;
            if (og + 1u == (tg + 1u) * nx) xb_add(&bar[XB_TOPGEN], 1u);
            else XB_SPIN(xb_ld(&bar[XB_TOPGEN]) == tg, bar);
            __builtin_amdgcn_fence(__ATOMIC_ACQUIRE, "agent");
            xb_add(&bar[XB_XGEN(b.x)], 1u);
            asm volatile("s_waitcnt vmcnt(0)" ::: "memory");
        } else {
            XB_SPIN(xb_ld(&bar[XB_XGEN(b.x)]) == gen, bar);
            __builtin_amdgcn_fence(__ATOMIC_ACQUIRE, "agent");
            asm volatile("s_waitcnt vmcnt(0)" ::: "memory");
        }
    }
    __syncthreads();
}

#define XL_SUB(j)   (3520 + 64 * (j))
#define XL_GEN(j)   (4544 + 64 * (j))
#define XL_TABLE    6144
__device__ __forceinline__ void xcd_local_barrier(const XcdBarrier& b) {
    asm volatile("s_waitcnt vmcnt(0)" ::: "memory");
    __syncthreads();
    if (threadIdx.x == 0) {
        unsigned* bar = b.bar;
        __builtin_amdgcn_s_waitcnt(0);
        const unsigned nloc = b.st[0];
        const unsigned old = xb_add(&bar[XL_SUB(b.x)], 1u);
        const unsigned gen = old / nloc;
        if (old + 1u == (gen + 1u) * nloc) xb_add(&bar[XL_GEN(b.x)], 1u);
        else XB_SPIN(xb_ld(&bar[XL_GEN(b.x)]) == gen, bar);
        __builtin_amdgcn_fence(__ATOMIC_ACQUIRE, "agent");
        asm volatile("s_waitcnt vmcnt(0)" ::: "memory");
    }
    __syncthreads();
}

#define XG_SUB(g)   (6400 + 16 * (g))
#define XG_GEN(g)   (7424 + 16 * (g))
__device__ __forceinline__ void panel_group_barrier(const XcdBarrier& b, unsigned grp) {
    asm volatile("s_waitcnt vmcnt(0)" ::: "memory");
    __syncthreads();
    if (threadIdx.x == 0) {
        unsigned* bar = b.bar;
        __builtin_amdgcn_s_waitcnt(0);
        const unsigned old = xb_add(&bar[XG_SUB(grp)], 1u);
        const unsigned gen = old >> 2;
        if ((old & 3u) == 3u) xb_add(&bar[XG_GEN(grp)], 1u);
        else XB_SPIN(xb_ld(&bar[XG_GEN(grp)]) == gen, bar);
        __builtin_amdgcn_fence(__ATOMIC_ACQUIRE, "agent");
        asm volatile("s_waitcnt vmcnt(0)" ::: "memory");
    }
    __syncthreads();
}

#define XS_SUB(s, j) (8704 + 1024 * (s) + 64 * (j))
#define XS_TOP(s)    (10752 + 128 * (s))
#define XS_FLAG(s)   (10752 + 128 * (s) + 64)
__device__ __forceinline__ void xcd_split_arrive(const XcdBarrier& b, int set) {
    asm volatile("s_waitcnt vmcnt(0)" ::: "memory");
    __syncthreads();
    if (threadIdx.x == 0) {
        unsigned* bar = b.bar;
        __builtin_amdgcn_s_waitcnt(0);
        unsigned nloc = b.st[0], nx = b.st[1];
        if (nloc == 0u) { xcd_barrier_complete(bar, b.x, nloc, nx); b.st[0] = nloc; b.st[1] = nx; }
        const unsigned old = xb_add(&bar[XS_SUB(set, b.x)], 1u);
        if (old + 1u == nloc) {
            __builtin_amdgcn_fence(__ATOMIC_RELEASE, "agent");
            asm volatile("s_waitcnt vmcnt(0)" ::: "memory");
            const unsigned og = xb_add(&bar[XS_TOP(set)], 1u);
            if (og + 1u == nx) xb_add(&bar[XS_FLAG(set)], 1u);
        }
    }
    __syncthreads();
}
__device__ __forceinline__ void xcd_split_wait(const XcdBarrier& b, int set, int who) {
    if ((int)threadIdx.x == who) {
        unsigned* bar = b.bar;
        XB_SPIN(xb_ld(&bar[XS_FLAG(set)]) == 0u, bar);
        __builtin_amdgcn_fence(__ATOMIC_ACQUIRE, "agent");
        asm volatile("s_waitcnt vmcnt(0)" ::: "memory");
    }
}

__device__ __forceinline__ int srcblk(int mode, int nb) {
    if (mode == 1) { const int t = nb >> 3, bj = (nb >> 2) & 1, jb = nb & 3; return bj * 88 + 4 * t + jb; }
    if (mode == 2) { if (nb < 32) { const int t = nb >> 3, bj = (nb >> 2) & 1, wc = nb & 3; return 8 * t + 2 * wc + bj; } return nb; }
    return nb;
}
__device__ __forceinline__ void transpose_item(const float* W, int K, int N, const float* gain, bf16* WT, int mode, LAS float* scr, int item, int lane) {
    const int nblk = N / 32, kb = item / nblk, nb = item % nblk, k0 = 64 * kb, n0d = 32 * nb, n0s = 32 * srcblk(mode, nb);
    const int k0d = (mode == 3) ? (21 - (kb >> 1)) * 128 + 64 * (kb & 1) : k0;
#pragma unroll
    for (int i = 0; i < 8; ++i) { const int kk = 8 * i + (lane >> 3), cc = 4 * (lane & 7);
        const v4f w = __builtin_nontemporal_load((const v4f*)(W + (size_t)(k0 + kk) * N + n0s + cc)); const float gk = gain ? gain[k0 + kk] : 1.0f;
        scr[kk * 33 + cc] = w.x * gk; scr[kk * 33 + cc + 1] = w.y * gk; scr[kk * 33 + cc + 2] = w.z * gk; scr[kk * 33 + cc + 3] = w.w * gk; }
    asm volatile("s_waitcnt lgkmcnt(0)" ::: "memory");
    const int c = lane & 7;
    const bool qkmap = (mode == 2) && nb < 32 && ((nb >> 2) & 1) == 0;
#pragma unroll
    for (int j = 0; j < 4; ++j) { const int n = (lane >> 3) + 8 * j; const int ncol = (qkmap && n < 16) ? 4 * (n >> 3) + 8 * ((n >> 2) & 1) + (n & 3) : n; const LAS float* s = scr + (8 * c) * 33 + ncol;
        v4u o; o.x = pk2(s[0 * 33], s[1 * 33]); o.y = pk2(s[2 * 33], s[3 * 33]); o.z = pk2(s[4 * 33], s[5 * 33]); o.w = pk2(s[6 * 33], s[7 * 33]);
        *(v4u*)(WT + (size_t)(n0d + n) * K + k0d + 8 * c) = o; }
    asm volatile("s_waitcnt lgkmcnt(0)" ::: "memory");
}
__device__ __forceinline__ void xprep_row(const float* xrow, bf16* orow, float* ssrow, int lane) {
    const v4f* xr = (const v4f*)xrow + lane;
    v4f v[4]; float s = 0.f;
#pragma unroll
    for (int j = 0; j < 4; ++j) { v[j] = __builtin_nontemporal_load(xr + 64 * j); s += (v[j].x * v[j].x + v[j].y * v[j].y) + (v[j].z * v[j].z + v[j].w * v[j].w); }
    s = wave_sum(s);
    unsigned long long* o8 = (unsigned long long*)orow + lane;
#pragma unroll
    for (int j = 0; j < 4; ++j) o8[64 * j] = (unsigned long long)pk2(v[j].x, v[j].y) | ((unsigned long long)pk2(v[j].z, v[j].w) << 32);
    if (lane < 16) ssrow[lane] = lane == 0 ? s : 0.f;
}

struct Args {
    const float* in[25]; float* out; unsigned char* ws; float invf[8]; int ph_lo, ph_hi;
};
constexpr int NWAVES = 8, NTHREADS = 512;
constexpr int RING_BYTES = 131072, MISC_OFF = RING_BYTES + 256, LDS_BYTES = 147456;
constexpr int CW_BAR = 4096;
constexpr size_t CTL_ZERO_BYTES = 65536;

__device__ __forceinline__ void p0_rows_all(const Args& a, int tid);
__device__ __forceinline__ void p0_prologue(const Args& a, LAS unsigned char* lds, int tid, int r_lo, int r_hi, bool rows_too) {
    const int lane = tid & 63, wave = tid >> 6;
    LAS float* scr = (LAS float*)(lds + wave * 16384);
    const int gw = blockIdx.x * NWAVES + wave, NGW = gridDim.x * NWAVES;
    unsigned char* ws = a.ws;
    constexpr int I1 = (DM / 64) * (NFF / 32), I2 = (DFF / 64) * (DM / 32), I3 = (DM / 64) * (NPROJ / 32), I4 = (DM / 64) * (DM / 32);
    constexpr int NIT = 2 * I1 + 2 * I2 + I3 + I4;
    for (int it = gw + r_lo * NGW, rd = r_lo; it < NIT && rd < r_hi; it += NGW, ++rd) {
        int r = it;
        if (r < I1) { transpose_item(a.in[3], DM, NFF, a.in[2], (bf16*)(ws + WS_W1T), 1, scr, r, lane); continue; } r -= I1;
        if (r < I1) { transpose_item(a.in[23], DM, NFF, a.in[22], (bf16*)(ws + WS_W5T), 1, scr, r, lane); continue; } r -= I1;
        if (r < I2) { transpose_item(a.in[4], DFF, DM, nullptr, (bf16*)(ws + WS_W2T), 3, scr, r, lane); continue; } r -= I2;
        if (r < I2) { transpose_item(a.in[24], DFF, DM, nullptr, (bf16*)(ws + WS_W6T), 3, scr, r, lane); continue; } r -= I2;
        if (r < I3) { transpose_item(a.in[6], DM, NPROJ, a.in[5], (bf16*)(ws + WS_W3T), 2, scr, r, lane); continue; } r -= I3;
        transpose_item(a.in[21], DM, DM, nullptr, (bf16*)(ws + WS_W4T), 0, scr, r, lane);
    }
    if (rows_too) p0_rows_all(a, tid);
}
__device__ __forceinline__ void p0_rows_all(const Args& a, int tid) {
    const int lane = tid & 63, wave = tid >> 6; const int gw = blockIdx.x * NWAVES + wave, NGW = gridDim.x * NWAVES; unsigned char* ws = a.ws;
    const float* x = a.in[0];
    for (int m = gw; m < MTOK; m += NGW) xprep_row(x + (size_t)m * DM, (bf16*)(ws + WS_XB) + (size_t)m * DM, (float*)(ws + WS_SS) + (size_t)m * 16, lane);
    float* tab = (float*)(ws + WS_ROPE); const int* pos = (const int*)a.in[1];
    for (int i = blockIdx.x * NTHREADS + tid; i < MTOK * 8; i += gridDim.x * NTHREADS) {
        const int row = i >> 3, j = i & 7;
        const float ang = (float)pos[row] * a.invf[j];
        tab[row * 16 + j] = (float)cos((double)ang); tab[row * 16 + 8 + j] = (float)sin((double)ang);
    }
}
__device__ __forceinline__ void p0_rows_own(const Args& a, int tid) {
    const int lane = tid & 63, wave = tid >> 6; unsigned char* ws = a.ws;
    const int xl = (int)blockIdx.x & 7, jg = ((int)blockIdx.x >> 3) & 7, m4 = (int)blockIdx.x >> 6, pA = 16 * xl + jg, pB = pA + 8;
    const float* x = a.in[0];
    for (int i = 0; i < 16; ++i) { const int r = m4 * 8 + wave + 32 * i, m = (r < 256 ? pA : pB) * 256 + (r & 255);
        xprep_row(x + (size_t)m * DM, (bf16*)(ws + WS_XB) + (size_t)m * DM, (float*)(ws + WS_SS) + (size_t)m * 16, lane); }
    float* tab = (float*)(ws + WS_ROPE); const int* pos = (const int*)a.in[1];
    for (int e = m4 * NTHREADS + tid; e < 512 * 8; e += 4 * NTHREADS) {
        const int r = e >> 3, j = e & 7, row = (r < 256 ? pA : pB) * 256 + (r & 255);
        const float ang = (float)pos[row] * a.invf[j];
        tab[row * 16 + j] = (float)cos((double)ang); tab[row * 16 + 8 + j] = (float)sin((double)ang);
    }
}

constexpr int RTAB_OFF = RING_BYTES + 1024;
struct RinvPre {
    const float* ss; int pmA, pmB; LAS float* rtab;
    __device__ __forceinline__ void operator()() const { const int tid = threadIdx.x; const size_t row = (size_t)((tid >> 8) ? pmB : pmA) * 256 + (tid & 255); rtab[tid] = rinv_of(ss, row); }
};
__device__ __forceinline__ RinvPre rinv_prepass(const float* ss, const pg8::StaticOrder& S, LAS unsigned char* lds) {
    pg8::Unit u; int n = 0; while (S.next(n, u)) ++n;
    RinvPre p{ss, 0, 0, (LAS float*)(lds + RTAB_OFF)};
    if (n == 0) return p;
    S.next(0, u); p.pmA = u.pm; S.next(n - 1, u); p.pmB = u.pm;
    return p;
}
struct RevOrder : pg8::StaticOrder {
    int n;
    __device__ void init_rev(int M, int N, int G_, int c_) { init(M, N, G_, c_); pg8::Unit u; n = 0; while (pg8::StaticOrder::next(n, u)) ++n; }
    __device__ bool next(int i, pg8::Unit& u) const { return i < n ? pg8::StaticOrder::next(n - 1 - i, u) : false; }
};
#ifndef PG8_ALIGN
#define PG8_ALIGN true
#endif
#ifndef PG8_SP2
#define PG8_SP2 true
#endif
__global__ void __launch_bounds__(NTHREADS, 2) mk_fwd(Args a) {
    extern __shared__ __attribute__((aligned(16))) unsigned char lds_raw[];
    cg::grid_group grid = cg::this_grid();
    LAS unsigned char* lds = (LAS unsigned char*)lds_raw;
    const int tid = threadIdx.x;
    unsigned char* ws = a.ws;
    const int lo = a.ph_lo, hi = a.ph_hi, G = gridDim.x;
    bf16 *W1T = (bf16*)(ws + WS_W1T), *W2T = (bf16*)(ws + WS_W2T), *W3T = (bf16*)(ws + WS_W3T), *W4T = (bf16*)(ws + WS_W4T), *W5T = (bf16*)(ws + WS_W5T), *W6T = (bf16*)(ws + WS_W6T);
    float* tab = (float*)(ws + WS_ROPE); float* ss0 = (float*)(ws + WS_SS); float* ss1 = ss0 + (size_t)MTOK * 16; float* ss2 = ss1 + (size_t)MTOK * 16;
    bf16 *XB = (bf16*)(ws + WS_XB), *Y = (bf16*)(ws + WS_Y), *ACT = (bf16*)(ws + WS_ACT);
    bf16 *Qb = ACT, *Kb = ACT + 512, *Vb = ACT + 1024, *XR = ACT + 1536, *GATE = ACT + 2048;
    float* out = a.out;
#ifndef PROBE_DUP
#define PROBE_DUP -1
#endif
#define REP(k) for (int rep_ = 0; rep_ < ((PROBE_DUP) == (k) ? 2 : 1); ++rep_)
#define REPSYNC() do { if (rep_) xcd_barrier(bar); } while (0)
#define IN(k) (lo <= (k) && (k) < hi)
    volatile LAS unsigned* MISC = (volatile LAS unsigned*)(lds + MISC_OFF);
    if (tid < 16) MISC[tid] = 0u;
    __syncthreads();
    XcdBarrier bar = xcd_barrier_post((unsigned*)(ws + WS_CTL) + CW_BAR, MISC + 8);
    if (tid == 0) __hip_atomic_store((unsigned*)(ws + WS_CTL) + CW_BAR + XL_TABLE + blockIdx.x, bar.x + 1u, __ATOMIC_RELAXED, __HIP_MEMORY_SCOPE_AGENT);
    const unsigned pgrp = ((unsigned)blockIdx.x & 7u) * 8u + (((unsigned)blockIdx.x >> 3) & 7u);
    bool split_b = false;
    bool local_ok = false;
#ifndef MK_LOCAL_SEAMS
#define MK_LOCAL_SEAMS 1
#endif
#ifndef MK_GROUP_SEAMS
#define MK_GROUP_SEAMS 1
#endif
#ifndef MK_CG_SEAM0
#define MK_CG_SEAM0 0
#endif
#define SEAM(k) do { if (IN(k) && IN((k) + 1)) { if (MK_CG_SEAM0 && (k) == 0) grid.sync(); else if (MK_LOCAL_SEAMS && local_ok && MK_GROUP_SEAMS && ((k) == 1 || (k) == 2 || (k) == 5 || (k) == 6)) panel_group_barrier(bar, pgrp); else if (MK_LOCAL_SEAMS && local_ok && (k) >= 1) xcd_local_barrier(bar); else xcd_barrier(bar); } } while (0)

    if (G == 256 && lo == 0 && hi > 2 && !MK_CG_SEAM0) {
        p0_prologue(a, lds, tid, 0, 2, false);
        xcd_split_arrive(bar, 0);
        p0_rows_own(a, tid);
        p0_prologue(a, lds, tid, 2, 1 << 20, false);
        xcd_split_arrive(bar, 1);
        xcd_split_wait(bar, 0, 0);
        __syncthreads();
        if (MK_LOCAL_SEAMS) {
            const unsigned* tblx = (const unsigned*)(ws + WS_CTL) + CW_BAR + XL_TABLE;
            bool okt = true;
            if (tid < 256) { const unsigned mine = __hip_atomic_load(tblx + tid, __ATOMIC_RELAXED, __HIP_MEMORY_SCOPE_AGENT), lead = __hip_atomic_load(tblx + (tid & 7), __ATOMIC_RELAXED, __HIP_MEMORY_SCOPE_AGENT); okt = (mine == lead) && mine != 0u;
                if (tid < 8) { for (int j = 0; j < 8; ++j) if (j != tid && __hip_atomic_load(tblx + j, __ATOMIC_RELAXED, __HIP_MEMORY_SCOPE_AGENT) == mine) okt = false; } }
            local_ok = __syncthreads_and(okt ? 1 : 0) != 0;
        }
        if (MK_LOCAL_SEAMS && local_ok && MK_GROUP_SEAMS) panel_group_barrier(bar, pgrp); else xcd_barrier(bar);
        split_b = true;
    } else {
        if (IN(0)) { p0_prologue(a, lds, tid, 0, 1 << 20, true); }
        SEAM(0);
    }
#ifdef PROBE_SYNCS
    for (int i_ = 0; i_ < PROBE_SYNCS; ++i_) xcd_barrier(bar);
#endif
    if (IN(1)) REP(1) { REPSYNC(); pg8::Gemm g{XB, W1T, MTOK, NFF, DM}; pg8::StaticOrder S; S.init(MTOK, NFF, G, (int)blockIdx.x);
        const RinvPre rp = rinv_prepass(ss0, S, lds); pg8::EpiSwiglu E{ACT, (const LAS float*)(lds + RTAB_OFF), rp.pmA}; pg8::gemm_phase<pg8::EpiSwiglu, pg8::StaticOrder, PG8_ALIGN, PG8_SP2, RinvPre>(lds, g, S, E, rp); }
    if (split_b) xcd_split_wait(bar, 1, 64);
    SEAM(1);
    if (IN(2)) REP(2) { REPSYNC(); pg8::Gemm g{ACT, W2T, MTOK, DM, DFF}; RevOrder S; S.init_rev(MTOK, DM, G, (int)blockIdx.x);
        pg8::EpiResid<true, true> E{nullptr, XB, nullptr, ss1, 0.5f}; pg8::gemm_phase<pg8::EpiResid<true, true>, RevOrder, PG8_ALIGN, PG8_SP2>(lds, g, S, E); }
    SEAM(2);
    if (IN(3)) REP(3) { REPSYNC(); pg8::Gemm g{XB, W3T, MTOK, NPROJ, DM}; pg8::StaticOrder S; S.init(MTOK, NPROJ, G, (int)blockIdx.x);
        const RinvPre rp = rinv_prepass(ss1, S, lds); pg8::EpiProj E{(const LAS float*)(lds + RTAB_OFF), rp.pmA, tab, a.in[7], a.in[8], Qb, 0.125f * 1.4426950408889634f}; pg8::gemm_phase<pg8::EpiProj, pg8::StaticOrder, PG8_ALIGN, PG8_SP2, RinvPre>(lds, g, S, E, rp); }
    if (IN(3) && IN(4)) {
        const int vcu0 = (G % 8 == 0) ? ((int)blockIdx.x % 8) * (G / 8) + (int)blockIdx.x / 8 : (int)blockIdx.x;
        if (vcu0 < BATCH * 16) rnn::rnn_consts((vcu0 >> 1) & 7, vcu0 & 1, a.in[14], a.in[15], a.in[16], a.in[17], a.in[18], a.in[19], a.in[20], lds);
        const int l64 = tid & 63;
        float d1 = a.in[9][l64] * a.in[10][l64], d2 = a.in[11][l64] * a.in[12][l64], gq = fabsf(a.in[7][l64]), gk = fabsf(a.in[8][l64]);
        d1 = wave_sum(d1); d2 = wave_sum(d2);
#pragma unroll
        for (int o_ = 1; o_ < 64; o_ <<= 1) { gq = fmaxf(gq, __shfl_xor(gq, o_)); gk = fmaxf(gk, __shfl_xor(gk, o_)); }
        if (tid == 0) { MISC[4] = __float_as_uint(expf(d1) - expf(d2) + LAMBDA_INIT); MISC[5] = __float_as_uint(-8.0f * gq * gk * 1.4426950408889634f); }
    }
    SEAM(3);
    if (IN(4)) {
        const int vcu = (G % 8 == 0) ? ((int)blockIdx.x % 8) * (G / 8) + (int)blockIdx.x / 8 : (int)blockIdx.x;
        if (lo > 3) { for (int u = vcu; u < BATCH * 16; u += G) rnn::rnn_unit<false>(u >> 4, (u >> 1) & 7, u & 1, XR, GATE, Y, a.in[14], a.in[15], a.in[16], a.in[17], a.in[18], a.in[19], a.in[20], lds);
            if (tid == 0) { MISC[4] = 0x7fc00000u; MISC[5] = 0x7fc00000u; } __syncthreads(); }
        else { if (vcu < BATCH * 16) rnn::rnn_unit<true>(vcu >> 4, (vcu >> 1) & 7, vcu & 1, XR, GATE, Y, a.in[14], a.in[15], a.in[16], a.in[17], a.in[18], a.in[19], a.in[20], lds);
            for (int u = vcu + G; u < BATCH * 16; u += G) rnn::rnn_unit<false>(u >> 4, (u >> 1) & 7, u & 1, XR, GATE, Y, a.in[14], a.in[15], a.in[16], a.in[17], a.in[18], a.in[19], a.in[20], lds); }
        const float lam = __uint_as_float(MISC[4]), negm_s = __uint_as_float(MISC[5]);
        REP(42) for (int v = vcu; v < 256; v += G) {
            const int bh = v >> 2, s = v & 3;
            for (int i = 0; i < 4; ++i) { const int cc = (i == 0) ? s : (i == 1) ? 7 - s : (i == 2) ? 8 + s : 15 - s;
                attn::attn_unit(bh >> 2, bh & 3, cc, Qb, Kb, Vb, Y, lam, negm_s, a.in[13], lds); }
        }
        __syncthreads();
    }
    SEAM(4);
    if (IN(5)) { pg8::Gemm g{Y, W4T, MTOK, DM, DM}; pg8::StaticOrder S; S.init(MTOK, DM, G, (int)blockIdx.x);
        pg8::EpiResid<true, true> E{nullptr, XB, nullptr, ss2, 1.0f}; pg8::gemm_phase<pg8::EpiResid<true, true>, pg8::StaticOrder, PG8_ALIGN, PG8_SP2>(lds, g, S, E); }
    SEAM(5);
    if (IN(6)) REP(6) { REPSYNC(); pg8::Gemm g{XB, W5T, MTOK, NFF, DM}; pg8::StaticOrder S; S.init(MTOK, NFF, G, (int)blockIdx.x);
        const RinvPre rp = rinv_prepass(ss2, S, lds); pg8::EpiSwiglu E{ACT, (const LAS float*)(lds + RTAB_OFF), rp.pmA}; pg8::gemm_phase<pg8::EpiSwiglu, pg8::StaticOrder, PG8_ALIGN, PG8_SP2, RinvPre>(lds, g, S, E, rp); }
    SEAM(6);
    if (IN(7)) { pg8::Gemm g{ACT, W6T, MTOK, DM, DFF}; RevOrder S; S.init_rev(MTOK, DM, G, (int)blockIdx.x);
        pg8::EpiResid<true, false> E{nullptr, XB, out, nullptr, 0.5f}; pg8::gemm_phase<pg8::EpiResid<true, false>, RevOrder, PG8_ALIGN, PG8_SP2>(lds, g, S, E); }
#undef IN
#undef SEAM
}

extern "C" void kernel_launch(void* const* d_in, const int* in_sizes, int n_in, void* d_out, int out_size, void* d_ws, size_t ws_size, hipStream_t stream) {
    static int grid_blocks = 0;
    if (grid_blocks == 0) {
        if (n_in != 25 || in_sizes[0] != MTOK * DM || out_size != MTOK * DM || ws_size < WS_END) { fprintf(stderr, "kernel_launch: unexpected shapes (n_in %d, ws %zu)\n", n_in, ws_size); grid_blocks = -1; return; }
        int dev = 0, cus = 0, per_cu = 0;
        if (hipGetDevice(&dev) != hipSuccess || hipDeviceGetAttribute(&cus, hipDeviceAttributeMultiprocessorCount, dev) != hipSuccess) { grid_blocks = -1; return; }
        if (hipFuncSetAttribute((const void*)mk_fwd, hipFuncAttributeMaxDynamicSharedMemorySize, LDS_BYTES) != hipSuccess) { fprintf(stderr, "kernel_launch: hipFuncSetAttribute failed\n"); grid_blocks = -1; return; }
        if (hipOccupancyMaxActiveBlocksPerMultiprocessor(&per_cu, (const void*)mk_fwd, NTHREADS, LDS_BYTES) != hipSuccess || per_cu < 1) { fprintf(stderr, "kernel_launch: occupancy query says %d blocks/CU\n", per_cu); grid_blocks = -1; return; }
        if (cus != 256) { fprintf(stderr, "kernel_launch: built for a 256-CU device (MI355X), found %d CUs; nothing launched\n", cus); grid_blocks = -1; return; }
        grid_blocks = 256;
    }
    if (grid_blocks < 0) return;
    if (hipMemsetAsync((char*)d_ws + WS_CTL, 0, CTL_ZERO_BYTES, stream) != hipSuccess) { fprintf(stderr, "kernel_launch: hipMemsetAsync failed\n"); return; }
    Args a{};
    for (int i = 0; i < 25; ++i) a.in[i] = (const float*)d_in[i];
    a.out = (float*)d_out; a.ws = (unsigned char*)d_ws;
    for (int j = 0; j < 8; ++j) a.invf[j] = (float)pow(500000.0, -(double)j / 8.0);
    a.ph_lo = 0; a.ph_hi = 8;
    void* args[] = {&a};
    hipError_t e = hipLaunchCooperativeKernel((const void*)mk_fwd, dim3(grid_blocks), dim3(NTHREADS), args, LDS_BYTES, stream);
    if (e != hipSuccess) fprintf(stderr, "cooperative launch failed: %s (grid %d)\n", hipGetErrorString(e), grid_blocks);
}
```

```cpp
#include <hip/hip_runtime.h>
#include <hip/hip_cooperative_groups.h>
#include <cstdio>
#include <cstdint>
#include <cmath>
namespace cg = cooperative_groups;

constexpr int DM = 1024, BATCH = 16, SEQ = 2048, MTOK = BATCH * SEQ;
constexpr int DFF = 2816, NFF = 2 * DFF, DATTN = 512, DRNN = 512, NPROJ = 2560;
constexpr int PQ = DFF;
constexpr float EPS = 1e-6f;
constexpr float LAMBDA_INIT = 0.2f;

typedef unsigned short bf16;
#define LAS __attribute__((address_space(3)))
typedef unsigned v4u __attribute__((ext_vector_type(4)));
typedef float v4f __attribute__((ext_vector_type(4)));

__device__ __forceinline__ unsigned f2bf(float f) { unsigned u = __builtin_bit_cast(unsigned, f); return (u + 0x7fffu + ((u >> 16) & 1u)) >> 16; }
typedef float f32x2_h __attribute__((ext_vector_type(2))); typedef __bf16 bf16x2_h __attribute__((ext_vector_type(2)));
__device__ __forceinline__ unsigned pk2(float lo, float hi) { const f32x2_h v = {lo, hi}; return __builtin_bit_cast(unsigned, __builtin_convertvector(v, bf16x2_h)); }
__device__ __forceinline__ float bf2f(bf16 h) { return __builtin_bit_cast(float, (unsigned)h << 16); }
__device__ __forceinline__ float wave_sum(float v) {
#pragma unroll
    for (int o = 1; o < 64; o <<= 1) v += __shfl_xor(v, o);
    return v;
}
__device__ __forceinline__ float rinv_of(const float* ss, size_t row) {
    const v4f* p = (const v4f*)(ss + row * 16); const v4f a = p[0], b = p[1], c = p[2], d = p[3];
    const float s = ((a.x + a.y) + (a.z + a.w)) + ((b.x + b.y) + (b.z + b.w)) + ((c.x + c.y) + (c.z + c.w)) + ((d.x + d.y) + (d.z + d.w));
    return 1.0f / sqrtf(s * (1.0f / DM) + EPS);
}

__device__ __forceinline__ float rinv_fq(const float* ss, size_t row, int fq) {
    const v4f a = *(const v4f*)(ss + row * 16 + 4 * fq); float s = (a.x + a.y) + (a.z + a.w);
    s += __shfl_xor(s, 16); s += __shfl_xor(s, 32);
    return 1.0f / sqrtf(s * (1.0f / DM) + EPS);
}

constexpr size_t MiB = 1u << 20;
constexpr size_t WS_CTL = 0;
constexpr size_t WS_W1T = 1 * MiB;
constexpr size_t WS_W2T = 12 * MiB;
constexpr size_t WS_W3T = 18 * MiB;
constexpr size_t WS_W4T = 23 * MiB;
constexpr size_t WS_W5T = 25 * MiB;
constexpr size_t WS_W6T = 36 * MiB;
constexpr size_t WS_ROPE = 42 * MiB;
constexpr size_t WS_SS = 44 * MiB;
constexpr size_t WS_XB = 50 * MiB;
constexpr size_t WS_Y = 114 * MiB;
constexpr size_t WS_ACT = 178 * MiB;
constexpr size_t WS_END = 354 * MiB;

namespace pg8 {
#define PG8_LAS __attribute__((address_space(3)))
typedef unsigned short bf16_t;
typedef short bf16x8 __attribute__((ext_vector_type(8)));
typedef float f32x4 __attribute__((ext_vector_type(4)));
typedef unsigned u32x4 __attribute__((ext_vector_type(4)));
constexpr int BM = 256, BK = 64, HALF = 128, HTB = HALF * BK * 2  , STAGE_BYTES = 8 * HTB, NXCD = 8, WGM = 8;

__host__ __device__ __forceinline__ int lds_byte(int r, int c) { const int st = (r >> 4) * 2 + (c >> 5), rr = r & 15, cc = c & 31, ob = rr * 64 + cc * 2; return st * 1024 + (ob ^ (((ob >> 9) & 1) << 5)); }
__host__ __device__ __forceinline__ void stage_rc(int b, int& R, int& C) { const int st = b / 1024, sb = b % 1024, swz = sb ^ (((sb >> 9) & 1) << 5); R = (st >> 1) * 16 + swz / 64; C = (st & 1) * 32 + (swz % 64) / 2; }
__host__ __device__ __forceinline__ int perm32(int rho) { const int n = rho >> 4, i = rho & 15; return 8 * (i >> 2) + 4 * n + (i & 3); }

struct Unit { int pm, pn; };
struct Gemm { const bf16_t* A; const bf16_t* Bt; int M, N, K; };

struct StaticOrder {
    int nM, nN, nwg, G, c;
    __host__ __device__ void init(int M, int N, int G_, int c_) { nM = M / BM; nN = N / BM; nwg = nM * nN; G = G_; c = c_; }
    __host__ __device__ bool next(int i, Unit& u) const {
        const long L = (long)i * G + c; if (L >= nwg) return false;
        int wgid = (int)L; { const int q = nwg / NXCD, r = nwg % NXCD, xcd = wgid % NXCD, off = wgid / NXCD; wgid = (xcd < r ? xcd * (q + 1) : r * (q + 1) + (xcd - r) * q) + off; }
        const int nig = WGM * nN, gid = wgid / nig, fm = gid * WGM, gsz = (nM - fm) < WGM ? (nM - fm) : WGM;
        u.pm = fm + ((wgid % nig) % gsz); u.pn = (wgid % nig) / gsz; return true;
    }
    __device__ __forceinline__ void a_ready(const Unit&) const {}
    __device__ __forceinline__ void done(const Unit&) const {}
};
__device__ __forceinline__ unsigned cvt_pk_bf16(float lo, float hi) { unsigned r; asm volatile("v_cvt_pk_bf16_f32 %0, %1, %2" : "=v"(r) : "v"(lo), "v"(hi)); return r; }
struct EpiSwiglu {
    static constexpr bool PERM = true, AFTER_DRAIN = false;
    bf16_t* act; const PG8_LAS float* rtab; int pmA;
    __device__ __forceinline__ void operator()(const f32x4 (&acc)[2][2][4][2], const Unit& u, int wr, int wc, int fr, int fq) const {
        const int row0 = u.pm * BM + wr * 64 + fr, col0 = (21 - u.pn) * 128 + wc * 32 + 8 * fq;
        const PG8_LAS float* rt = rtab + (u.pm == pmA ? 0 : 256) + wr * 64 + fr;
#pragma unroll
        for (int ai = 0; ai < 2; ++ai)
#pragma unroll
            for (int m = 0; m < 4; ++m) {
                const size_t row = (size_t)(row0 + ai * HALF + m * 16); const float r = rt[ai * HALF + m * 16];
                const float nr = -1.4426950408889634f * r, r2 = r * r;
                unsigned w[4];
#pragma unroll
                for (int n = 0; n < 2; ++n) {
                    typedef float f2 __attribute__((ext_vector_type(2)));
                    const f32x4 g = acc[ai][0][m][n], uu = acc[ai][1][m][n];
                    const f2 ga = {g[0], g[1]}, gb = {g[2], g[3]}, ua = {uu[0], uu[1]}, ub = {uu[2], uu[3]};
                    const f2 ta = ga * nr, tb = gb * nr;
                    f2 ea, eb; ea.x = __builtin_amdgcn_exp2f(ta.x); ea.y = __builtin_amdgcn_exp2f(ta.y); eb.x = __builtin_amdgcn_exp2f(tb.x); eb.y = __builtin_amdgcn_exp2f(tb.y);
                    const f2 da = ea + 1.0f, db = eb + 1.0f;
                    f2 ia, ib; ia.x = __builtin_amdgcn_rcpf(da.x); ia.y = __builtin_amdgcn_rcpf(da.y); ib.x = __builtin_amdgcn_rcpf(db.x); ib.y = __builtin_amdgcn_rcpf(db.y);
                    const f2 ha = (ga * ua) * (ia * r2), hb = (gb * ub) * (ib * r2);
                    w[2 * n] = cvt_pk_bf16(ha.x, ha.y); w[2 * n + 1] = cvt_pk_bf16(hb.x, hb.y); }
                *(u32x4*)(act + row * DFF + col0) = (u32x4){w[0], w[1], w[2], w[3]};
            }
    }
};
template <bool IN_BF16, bool OUT_BF16> struct EpiResid {
    static constexpr bool PERM = true, AFTER_DRAIN = false;
    const float* xin; bf16_t* xb; float* out; float* ssout; float alpha;
    __device__ __forceinline__ void operator()(const f32x4 (&acc)[2][2][4][2], const Unit& u, int wr, int wc, int fr, int fq) const {
        const int row0 = u.pm * BM + wr * 64 + fr, col0 = u.pn * BM + wc * 32 + 8 * fq;
        u32x4 w[2][4][2];
        if (IN_BF16) {
#pragma unroll
            for (int ai = 0; ai < 2; ++ai)
#pragma unroll
                for (int m = 0; m < 4; ++m)
#pragma unroll
                    for (int bj = 0; bj < 2; ++bj) w[ai][m][bj] = *(const u32x4*)(xb + (size_t)(row0 + ai * HALF + m * 16) * DM + col0 + bj * HALF);
        }
#pragma unroll
        for (int ai = 0; ai < 2; ++ai)
#pragma unroll
            for (int m = 0; m < 4; ++m) {
                const size_t row = (size_t)(row0 + ai * HALF + m * 16); float s = 0.f;
#pragma unroll
                for (int bj = 0; bj < 2; ++bj) { const size_t p = row * DM + col0 + bj * HALF;
                    f32x4 x0, x1;
                    if (IN_BF16) { const u32x4 wv = w[ai][m][bj];
                        x0 = (f32x4){__builtin_bit_cast(float, wv[0] << 16), __builtin_bit_cast(float, wv[0] & 0xffff0000u), __builtin_bit_cast(float, wv[1] << 16), __builtin_bit_cast(float, wv[1] & 0xffff0000u)};
                        x1 = (f32x4){__builtin_bit_cast(float, wv[2] << 16), __builtin_bit_cast(float, wv[2] & 0xffff0000u), __builtin_bit_cast(float, wv[3] << 16), __builtin_bit_cast(float, wv[3] & 0xffff0000u)}; }
                    else { x0 = __builtin_nontemporal_load((const f32x4*)(xin + p)); x1 = __builtin_nontemporal_load((const f32x4*)(xin + p + 4)); }
                    const f32x4 v0 = x0 + alpha * acc[ai][bj][m][0], v1 = x1 + alpha * acc[ai][bj][m][1];
                    if (OUT_BF16) { *(u32x4*)(xb + p) = (u32x4){cvt_pk_bf16(v0[0], v0[1]), cvt_pk_bf16(v0[2], v0[3]), cvt_pk_bf16(v1[0], v1[1]), cvt_pk_bf16(v1[2], v1[3])};
                        s += ((v0[0] * v0[0] + v0[1] * v0[1]) + (v0[2] * v0[2] + v0[3] * v0[3])) + ((v1[0] * v1[0] + v1[1] * v1[1]) + (v1[2] * v1[2] + v1[3] * v1[3])); }
                    else { __builtin_nontemporal_store(v0, (f32x4*)(out + p)); __builtin_nontemporal_store(v1, (f32x4*)(out + p + 4)); } }
                if (OUT_BF16) { s += __shfl_xor(s, 16); s += __shfl_xor(s, 32); if (fq == 0) ssout[row * 16 + 4 * u.pn + wc] = s; }
            }
    }
};
struct EpiProj {
    static constexpr bool PERM = true, AFTER_DRAIN = false;
    const PG8_LAS float* rtab; int pmA; const float* tab; const float* qn; const float* kn; bf16_t* qkv; float qscale;
    __device__ __forceinline__ void operator()(const f32x4 (&acc)[2][2][4][2], const Unit& u, int wr, int wc, int fr, int fq) const {
        const int row0 = u.pm * BM + wr * 64 + fr, kind = u.pn >> 1, half = u.pn & 1;
        const PG8_LAS float* rt = rtab + (u.pm == pmA ? 0 : 256) + wr * 64 + fr;
        bf16_t* base = qkv + kind * 512;
        if (kind >= 2) {
            const int col0 = half * 256 + wc * 32 + 8 * fq;
#pragma unroll
            for (int ai = 0; ai < 2; ++ai)
#pragma unroll
                for (int m = 0; m < 4; ++m) { const size_t row = (size_t)(row0 + ai * HALF + m * 16); const float r = rt[ai * HALF + m * 16];
#pragma unroll
                    for (int bj = 0; bj < 2; ++bj) { const f32x4 v0 = acc[ai][bj][m][0] * r, v1 = acc[ai][bj][m][1] * r;
                        *(u32x4*)(base + row * PQ + col0 + bj * HALF) = (u32x4){cvt_pk_bf16(v0[0], v0[1]), cvt_pk_bf16(v0[2], v0[3]), cvt_pk_bf16(v1[0], v1[1]), cvt_pk_bf16(v1[2], v1[3])}; } }
        } else {
            const int g = 4 * half + wc; const float* gp = kind == 0 ? qn : kn; const float sc = kind == 0 ? qscale : 1.0f;
            const bool rot = fq < 2; const int d00 = rot ? 4 * fq : 8 * fq, d01 = rot ? 8 + 4 * fq : 8 * fq + 4;
            f32x4 gn[2][2];
            gn[0][0] = *(const f32x4*)(gp + d00); gn[0][1] = *(const f32x4*)(gp + d01); gn[1][0] = *(const f32x4*)(gp + 32 + 8 * fq); gn[1][1] = *(const f32x4*)(gp + 36 + 8 * fq);
#pragma unroll
            for (int ai = 0; ai < 2; ++ai)
#pragma unroll
                for (int m = 0; m < 4; ++m) { const size_t row = (size_t)(row0 + ai * HALF + m * 16); const float r = rt[ai * HALF + m * 16];
                    const f32x4 cs = *(const f32x4*)(tab + row * 16 + 4 * (fq & 1)), sn = *(const f32x4*)(tab + row * 16 + 8 + 4 * (fq & 1));
                    f32x4 v[2][2]; float s = 0.f;
#pragma unroll
                    for (int bj = 0; bj < 2; ++bj)
#pragma unroll
                        for (int n = 0; n < 2; ++n) { v[bj][n] = acc[ai][bj][m][n] * r; s += (v[bj][n][0] * v[bj][n][0] + v[bj][n][1] * v[bj][n][1]) + (v[bj][n][2] * v[bj][n][2] + v[bj][n][3] * v[bj][n][3]); }
                    s += __shfl_xor(s, 16); s += __shfl_xor(s, 32);
                    const float nrm = sc * __builtin_amdgcn_rsqf(s * (1.0f / 64.0f) + EPS);
#pragma unroll
                    for (int bj = 0; bj < 2; ++bj)
#pragma unroll
                        for (int n = 0; n < 2; ++n) v[bj][n] = v[bj][n] * nrm * gn[bj][n];
                    { const f32x4 x1 = v[0][0], x2 = v[0][1], o1 = x1 * cs - x2 * sn, o2 = x2 * cs + x1 * sn;
#pragma unroll
                      for (int e = 0; e < 4; ++e) { v[0][0][e] = rot ? o1[e] : x1[e]; v[0][1][e] = rot ? o2[e] : x2[e]; } }
                    typedef unsigned u32x2e __attribute__((ext_vector_type(2)));
                    bf16_t* orow = base + row * PQ + 64 * g;
                    *(u32x2e*)(orow + d00) = (u32x2e){cvt_pk_bf16(v[0][0][0], v[0][0][1]), cvt_pk_bf16(v[0][0][2], v[0][0][3])};
                    *(u32x2e*)(orow + d01) = (u32x2e){cvt_pk_bf16(v[0][1][0], v[0][1][1]), cvt_pk_bf16(v[0][1][2], v[0][1][3])};
                    *(u32x4*)(orow + 32 + 8 * fq) = (u32x4){cvt_pk_bf16(v[1][0][0], v[1][0][1]), cvt_pk_bf16(v[1][0][2], v[1][0][3]), cvt_pk_bf16(v[1][1][0], v[1][1][1]), cvt_pk_bf16(v[1][1][2], v[1][1][3])};
                }
        }
    }
};
struct NoPre { __device__ __forceinline__ void operator()() const {} };
__device__ __forceinline__ void stage_b_first(PG8_LAS unsigned char* lds, const bf16_t* Bt, int K, int pn) {
    const int tid = threadIdx.x, wid = __builtin_amdgcn_readfirstlane(tid >> 6);
    const size_t hstep = (size_t)HALF * K * 2; const char* cB = (const char*)Bt + (size_t)pn * 2 * hstep;
#pragma unroll
    for (int h = 0; h < 2; ++h)
#pragma unroll
        for (int i = 0; i < 2; ++i) { int R, C; stage_rc(tid * 16 + i * 8192, R, C); const int Rb = (R & ~31) + perm32(R & 31);
            __builtin_amdgcn_global_load_lds((const unsigned*)(cB + h * hstep + (size_t)(Rb * K + C) * 2u), (PG8_LAS unsigned*)(lds + (4 + h) * HTB + (unsigned)wid * 1024u + i * 8192), 16, 0, 0); }
}
template <class Epi, class Sched, bool ALIGN_EPI = false, bool SP2 = false, class Pre = NoPre>
__device__ __forceinline__ void gemm_phase(PG8_LAS unsigned char* lds, const Gemm g, const Sched& S, const Epi& E, const Pre& pre = Pre(), const bool bpre = false) {
    const int tid = threadIdx.x, wid = __builtin_amdgcn_readfirstlane(tid >> 6), lane = tid & 63, wr = wid >> 2, wc = wid & 3, fr = lane & 15, fq = lane >> 4;
    const int K = g.K, nt = K / BK;
    unsigned voffA[2], voffB[2];
#pragma unroll
    for (int i = 0; i < 2; ++i) { int R, C; stage_rc(tid * 16 + i * 8192, R, C); const int Rb = Epi::PERM ? ((R & ~31) + perm32(R & 31)) : R;
        voffA[i] = (unsigned)(R * K + C) * 2u; voffB[i] = (unsigned)(Rb * K + C) * 2u; }
    const size_t kstep = (size_t)(BK * 2);
    const size_t hstep = (size_t)HALF * K * 2;
    const size_t tstep = 2 * hstep;
    const unsigned ldsw = (unsigned)wid * 1024u;
    const int aoff = lds_byte(wr * 64 + fr, fq * 8), boff = lds_byte(wc * 32 + fr, fq * 8);
#define PG8_SA(b, h) (((b) * 2 + (h)) * HTB)
#define PG8_SB(b, h) ((4 + (b) * 2 + (h)) * HTB)
#define PG8_STAGE(bufoff, gbase, voff) do { _Pragma("unroll") for (int _i = 0; _i < 2; ++_i) \
        __builtin_amdgcn_global_load_lds((const unsigned*)((const char*)(gbase) + (voff)[_i]), (PG8_LAS unsigned*)(lds + (bufoff) + ldsw + _i * 8192), 16, 0, 0); } while (0)
#define PG8_LDA(dst, b, h) do { _Pragma("unroll") for (int m = 0; m < 4; ++m) _Pragma("unroll") for (int k = 0; k < 2; ++k) dst[m][k] = *(const PG8_LAS bf16x8*)(lds + PG8_SA(b, h) + aoff + m * 2048 + k * 1024); } while (0)
#define PG8_LDB(dst, b, h) do { _Pragma("unroll") for (int n = 0; n < 2; ++n) _Pragma("unroll") for (int k = 0; k < 2; ++k) dst[n][k] = *(const PG8_LAS bf16x8*)(lds + PG8_SB(b, h) + boff + n * 2048 + k * 1024); } while (0)
#define PG8_MMA(ai, bj, At, Bt) do { __builtin_amdgcn_s_setprio(1); _Pragma("unroll") for (int m = 0; m < 4; ++m) _Pragma("unroll") for (int n = 0; n < 2; ++n) _Pragma("unroll") for (int k = 0; k < 2; ++k) \
        acc[ai][bj][m][n] = __builtin_amdgcn_mfma_f32_16x16x32_bf16(Bt[n][k], At[m][k], acc[ai][bj][m][n], 0, 0, 0); __builtin_amdgcn_s_setprio(0); } while (0)
#define PG8_WAIT_V(n) asm volatile("s_waitcnt vmcnt(" #n ")" ::: "memory")
#define PG8_WAIT_L(n) asm volatile("s_waitcnt lgkmcnt(" #n ")" ::: "memory")
#define PG8_BAR __builtin_amdgcn_s_barrier()
#define PG8_SCHED __builtin_amdgcn_sched_barrier(0)
    Unit cur, nxt; int ui = 0;
    if (!S.next(0, cur)) return;
    f32x4 acc[2][2][4][2];
#pragma unroll
    for (int a = 0; a < 2; ++a)
#pragma unroll
        for (int b = 0; b < 2; ++b)
#pragma unroll
            for (int m = 0; m < 4; ++m)
#pragma unroll
                for (int n = 0; n < 2; ++n) acc[a][b][m][n] = (f32x4){0.f, 0.f, 0.f, 0.f};
    bf16x8 At[4][2], B0[2][2], B1[2][2];
    const char* cA = (const char*)g.A + (size_t)cur.pm * tstep; const char* cB = (const char*)g.Bt + (size_t)cur.pn * tstep;
    S.a_ready(cur);
    if constexpr (SP2) {
        if (!bpre) { PG8_STAGE(PG8_SB(0, 0), cB, voffB); PG8_STAGE(PG8_SB(0, 1), cB + hstep, voffB); }
        PG8_STAGE(PG8_SA(0, 0), cA, voffA); PG8_STAGE(PG8_SA(0, 1), cA + hstep, voffA);
        pre();
        if (wr == 1) PG8_BAR;
        PG8_WAIT_V(2); PG8_BAR;
        PG8_STAGE(PG8_SB(1, 0), cB + kstep, voffB); PG8_STAGE(PG8_SA(1, 0), cA + kstep, voffA); PG8_STAGE(PG8_SB(1, 1), cB + hstep + kstep, voffB);
        PG8_WAIT_V(6); PG8_BAR;
    } else {
        PG8_STAGE(PG8_SB(0, 0), cB, voffB); PG8_STAGE(PG8_SA(0, 0), cA, voffA); PG8_STAGE(PG8_SB(0, 1), cB + hstep, voffB); PG8_STAGE(PG8_SA(0, 1), cA + hstep, voffA);
        if (wr == 1) PG8_BAR;
        PG8_WAIT_V(4); PG8_BAR;
        PG8_STAGE(PG8_SB(1, 0), cB + kstep, voffB); PG8_STAGE(PG8_SA(1, 0), cA + kstep, voffA); PG8_STAGE(PG8_SB(1, 1), cB + hstep + kstep, voffB);
        PG8_WAIT_V(6); PG8_BAR;
    }
    for (;;) {
        const bool has_next = S.next(ui + 1, nxt);
        const char* nA = has_next ? (const char*)g.A + (size_t)nxt.pm * tstep : cA; const char* nB = has_next ? (const char*)g.Bt + (size_t)nxt.pn * tstep : cB;
        for (int t = 0; t < nt; t += 2) {
            const bool last = (t == nt - 2);
            const char* a1 = cA + (size_t)(t + 1) * kstep;
            const char* a2 = last ? nA : cA + (size_t)(t + 2) * kstep; const char* b2 = last ? nB : cB + (size_t)(t + 2) * kstep;
            const char* a3 = a2 + kstep; const char* b3 = b2 + kstep;
            if (last && has_next) S.a_ready(nxt);
            if constexpr (SP2) {
            PG8_LDB(B0, 0, 0); PG8_LDB(B1, 0, 1); PG8_SCHED; PG8_LDA(At, 0, 0); PG8_STAGE(PG8_SA(1, 1), a1 + hstep, voffA);
            PG8_WAIT_V(8); PG8_WAIT_L(0); PG8_BAR; PG8_MMA(0, 0, At, B0); PG8_MMA(0, 1, At, B1); PG8_BAR; PG8_SCHED;
            PG8_LDA(At, 0, 1); PG8_STAGE(PG8_SB(0, 0), b2, voffB); PG8_STAGE(PG8_SB(0, 1), b2 + hstep, voffB); PG8_STAGE(PG8_SA(0, 0), a2, voffA);
            PG8_WAIT_V(8); PG8_WAIT_L(0); PG8_BAR; PG8_MMA(1, 0, At, B0); PG8_MMA(1, 1, At, B1); PG8_BAR; PG8_SCHED;
            PG8_LDB(B0, 1, 0); PG8_LDB(B1, 1, 1); PG8_SCHED; PG8_LDA(At, 1, 0); PG8_STAGE(PG8_SA(0, 1), a2 + hstep, voffA);
            PG8_WAIT_V(8); PG8_WAIT_L(0); PG8_BAR; PG8_MMA(0, 0, At, B0); PG8_MMA(0, 1, At, B1); PG8_BAR; PG8_SCHED;
            PG8_LDA(At, 1, 1); PG8_STAGE(PG8_SB(1, 0), b3, voffB); PG8_STAGE(PG8_SB(1, 1), b3 + hstep, voffB); PG8_STAGE(PG8_SA(1, 0), a3, voffA);
            PG8_WAIT_V(8); PG8_WAIT_L(0); PG8_BAR; PG8_MMA(1, 0, At, B0); PG8_MMA(1, 1, At, B1); PG8_BAR; PG8_SCHED;
            } else {
            PG8_LDB(B0, 0, 0); PG8_SCHED; PG8_LDA(At, 0, 0); PG8_STAGE(PG8_SA(1, 1), a1 + hstep, voffA);
            PG8_WAIT_L(8); PG8_BAR; PG8_WAIT_L(0); PG8_MMA(0, 0, At, B0); PG8_BAR; PG8_SCHED;
            PG8_LDB(B1, 0, 1); PG8_STAGE(PG8_SB(0, 0), b2, voffB);
            PG8_BAR; PG8_WAIT_L(0); PG8_MMA(0, 1, At, B1); PG8_BAR;
            PG8_LDA(At, 0, 1); PG8_STAGE(PG8_SA(0, 0), a2, voffA);
            PG8_BAR; PG8_WAIT_L(0); PG8_MMA(1, 0, At, B0); PG8_BAR; PG8_SCHED;
            PG8_STAGE(PG8_SB(0, 1), b2 + hstep, voffB);
            PG8_WAIT_V(6); PG8_BAR; PG8_MMA(1, 1, At, B1); PG8_BAR;
            PG8_LDB(B0, 1, 0); PG8_SCHED; PG8_LDA(At, 1, 0); PG8_STAGE(PG8_SA(0, 1), a2 + hstep, voffA);
            PG8_WAIT_L(8); PG8_BAR; PG8_WAIT_L(0); PG8_MMA(0, 0, At, B0); PG8_BAR; PG8_SCHED;
            PG8_LDB(B1, 1, 1); PG8_STAGE(PG8_SB(1, 0), b3, voffB);
            PG8_BAR; PG8_WAIT_L(0); PG8_MMA(0, 1, At, B1); PG8_BAR;
            PG8_LDA(At, 1, 1); PG8_STAGE(PG8_SA(1, 0), a3, voffA);
            PG8_BAR; PG8_WAIT_L(0); PG8_MMA(1, 0, At, B0); PG8_BAR; PG8_SCHED;
            PG8_STAGE(PG8_SB(1, 1), b3 + hstep, voffB);
            PG8_WAIT_V(6); PG8_BAR; PG8_MMA(1, 1, At, B1); PG8_BAR;
            }
        }
        if constexpr (ALIGN_EPI) { if (wr == 0) PG8_BAR; }
        if constexpr (!Epi::AFTER_DRAIN) { E(acc, cur, wr, wc, fr, fq); S.done(cur); }
        if (!has_next) break;
#pragma unroll
        for (int a = 0; a < 2; ++a)
#pragma unroll
            for (int b = 0; b < 2; ++b)
#pragma unroll
                for (int m = 0; m < 4; ++m)
#pragma unroll
                    for (int n = 0; n < 2; ++n) acc[a][b][m][n] = (f32x4){0.f, 0.f, 0.f, 0.f};
        cur = nxt; cA = nA; cB = nB; ++ui;
        if constexpr (ALIGN_EPI) { if (wr == 1) PG8_BAR; }
    }
    PG8_WAIT_V(0);
    if constexpr (!ALIGN_EPI) { if (wr == 0) PG8_BAR; }
    PG8_BAR;
    if constexpr (Epi::AFTER_DRAIN) { E.fused(acc, cur, wr, wc, fr, fq, lds, wid, lane); S.done(cur); }
#undef PG8_SA
#undef PG8_SB
#undef PG8_STAGE
#undef PG8_LDA
#undef PG8_LDB
#undef PG8_MMA
#undef PG8_WAIT_V
#undef PG8_WAIT_L
#undef PG8_BAR
#undef PG8_SCHED
}
}

#ifndef ATT_PROBE
#define ATT_PROBE 0
#endif
namespace attn {
using bf16x8 = __attribute__((ext_vector_type(8))) short;
using s16x4 = __attribute__((ext_vector_type(4))) short;
using f32x16 = __attribute__((ext_vector_type(16))) float;
using u32x4 = __attribute__((ext_vector_type(4))) unsigned;
typedef short v4i16_t __attribute__((ext_vector_type(4)));
typedef __attribute__((address_space(3))) const char* lds_cptr;
constexpr int SLOTB = 32768, NSLOT = 3, LDS_WS = NSLOT * SLOTB  , LDS_X = 0  , LDS_STG = 65536  ;
__device__ __forceinline__ int crow(int r, int hi) { return (r & 3) + 8 * (r >> 2) + 4 * hi; }
__device__ __forceinline__ void glds16(const void* gsrc, unsigned lds_dst) { unsigned keep;
    asm volatile("s_mov_b32 %0, m0\n\ts_mov_b32 m0, %2\n\ts_nop 0\n\tglobal_load_lds_dwordx4 %1, off\n\ts_mov_b32 m0, %0" : "=&s"(keep) : "v"(gsrc), "s"(lds_dst) : "memory"); }
typedef float f32x2_t __attribute__((ext_vector_type(2))); typedef __bf16 bf16x2_t __attribute__((ext_vector_type(2)));
__device__ __forceinline__ unsigned cvtpk(float lo, float hi) { f32x2_t v = {lo, hi}; bf16x2_t b = __builtin_convertvector(v, bf16x2_t); return __builtin_bit_cast(unsigned, b); }
__device__ __forceinline__ s16x4 vtr(lds_cptr p) { return __builtin_bit_cast(s16x4, __builtin_amdgcn_ds_read_tr16_b64_v4i16((__attribute__((address_space(3))) v4i16_t*)p)); }
#define ATT_WAIT_BAR(N) asm volatile("s_waitcnt vmcnt(" #N ") lgkmcnt(0)\n\ts_barrier" ::: "memory")

__device__ __forceinline__ void attn_unit(int b, int h, int cc, const bf16* Q, const bf16* __restrict__ K, const bf16* __restrict__ V, bf16* Y, float lam, float negm_s, const float* subln, LAS unsigned char* lds) {
    const int tid = threadIdx.x, lane = tid & 63, r32 = lane & 31, hi = lane >> 5; const int wid = __builtin_amdgcn_readfirstlane(tid >> 6);
    const int qg = wid & 3, map = wid >> 2;
    const size_t rowbase = (size_t)b * SEQ; const int q0 = 128 * cc;
    const bf16* Qw = Q + (rowbase + q0 + 32 * qg) * PQ + h * 128 + map * 64;
    const bf16* Kh = K + rowbase * PQ + h * 128; const bf16* Vh = V + rowbase * PQ + h * 128;
    const unsigned lds0 = (unsigned)(uintptr_t)lds;
    const lds_cptr lds3 = (lds_cptr)lds;
    LAS float* wsf = (LAS float*)(lds + LDS_WS) + wid * 64;
    const int NT = 2 * cc + 2, my_nt = 2 * cc + (qg >> 1) + 1;
    const bf16* ksrc0 = Kh + (size_t)lane * PQ + wid * 8; const bf16* ksrc1 = ksrc0 + 64;
    const bf16* vsrc0 = Vh + (size_t)(16 * (wid & 3) + (lane >> 2)) * PQ + (wid >> 2) * 32 + (lane & 3) * 8; const bf16* vsrc1 = vsrc0 + 64;
    const unsigned kdst = lds0 + wid * 1024, vdst = lds0 + 16384 + wid * 1024;
#define ATT_DMA(t, slot) do { const size_t to_ = (size_t)(t) * 64 * PQ; const unsigned sl_ = (unsigned)(slot); \
        glds16(ksrc0 + to_, (unsigned)__builtin_amdgcn_readfirstlane(kdst + sl_)); glds16(ksrc1 + to_, (unsigned)__builtin_amdgcn_readfirstlane(kdst + sl_ + 8192u)); \
        glds16(vsrc0 + to_, (unsigned)__builtin_amdgcn_readfirstlane(vdst + sl_)); glds16(vsrc1 + to_, (unsigned)__builtin_amdgcn_readfirstlane(vdst + sl_ + 8192u)); } while (0)
    ATT_DMA(0, 0); ATT_DMA(1, SLOTB);
    bf16x8 qr[4];
#pragma unroll
    for (int s = 0; s < 4; ++s) qr[s] = *reinterpret_cast<const bf16x8*>(&Qw[(size_t)r32 * PQ + s * 16 + hi * 8]);
    f32x16 o[4]; o[0] = f32x16{}; o[1] = f32x16{}; o[2] = f32x16{}; o[3] = f32x16{};
    f32x16 negm; float nm_ = negm_s; asm volatile("" : "+v"(nm_));
#pragma unroll
    for (int r = 0; r < 16; ++r) negm[r] = nm_;
    asm volatile("" : "+v"(negm));
    float l_reg = 0.f;
    const lds_cptr kp0 = lds3 + map * 8192 + hi * 1024 + r32 * 16;
    const lds_cptr vp0 = lds3 + 16384 + ((lane >> 4) & 1) * 32 + (lane & 3) * 8 + (4 * hi + ((lane & 15) >> 2)) * 64;
    int slot = 0;
    for (int t = 0; t < NT; ++t) {
        if (t + 1 < NT) { ATT_WAIT_BAR(4); } else { ATT_WAIT_BAR(0); }
        int s2 = slot + 2 * SLOTB; if (s2 >= NSLOT * SLOTB) s2 -= NSLOT * SLOTB;
        if (t < my_nt) {
            const lds_cptr kp = kp0 + slot; const lds_cptr vp = vp0 + slot;
            bf16x8 kf[8];
#pragma unroll
            for (int s = 0; s < 4; ++s) { kf[2 * s] = *(const __attribute__((address_space(3))) bf16x8*)(kp + s * 2048); kf[2 * s + 1] = *(const __attribute__((address_space(3))) bf16x8*)(kp + s * 2048 + 512); }
            f32x16 p0 = __builtin_amdgcn_mfma_f32_32x32x16_bf16(kf[0], qr[0], negm, 0, 0, 0), p1 = __builtin_amdgcn_mfma_f32_32x32x16_bf16(kf[1], qr[0], negm, 0, 0, 0);
#pragma unroll
            for (int s = 1; s < 4; ++s) { p0 = __builtin_amdgcn_mfma_f32_32x32x16_bf16(kf[2 * s], qr[s], p0, 0, 0, 0); p1 = __builtin_amdgcn_mfma_f32_32x32x16_bf16(kf[2 * s + 1], qr[s], p1, 0, 0, 0); }
#define ATT_VLOAD(VF, KS) do { _Pragma("unroll") for (int db = 0; db < 4; ++db) { const s16x4 vlo = vtr(vp + db * 4096 + (KS) * 1024), vhi = vtr(vp + db * 4096 + (KS) * 1024 + 512); \
                VF[db] = (bf16x8){vlo[0], vlo[1], vlo[2], vlo[3], vhi[0], vhi[1], vhi[2], vhi[3]}; } } while (0)
#define ATT_EXPK(P, B, W) do { _Pragma("unroll") for (int r = 0; r < 8; ++r) { P[(B) + r] = __builtin_amdgcn_exp2f(P[(B) + r]); sacc += P[(B) + r]; } \
                W = (u32x4){cvtpk(P[(B)], P[(B) + 1]), cvtpk(P[(B) + 2], P[(B) + 3]), cvtpk(P[(B) + 4], P[(B) + 5]), cvtpk(P[(B) + 6], P[(B) + 7])}; } while (0)
#define ATT_PVK(VF, W) do { _Pragma("unroll") for (int db = 0; db < 4; ++db) o[db] = __builtin_amdgcn_mfma_f32_32x32x16_bf16(__builtin_bit_cast(bf16x8, W), VF[db], o[db], 0, 0, 0); } while (0)
            bf16x8 vfa[4], vfb[4]; u32x4 pwa, pwb; float sacc = 0.f;
            __builtin_amdgcn_sched_barrier(0);
            ATT_VLOAD(vfa, 0);
            if (t + 2 < NT) ATT_DMA(t + 2, s2);
            __builtin_amdgcn_sched_barrier(0);
            ATT_EXPK(p0, 0, pwa);
            ATT_VLOAD(vfb, 1); __builtin_amdgcn_sched_barrier(0);
            ATT_PVK(vfa, pwa); ATT_EXPK(p0, 8, pwb); __builtin_amdgcn_sched_barrier(0);
            ATT_VLOAD(vfa, 2); __builtin_amdgcn_sched_barrier(0);
            ATT_PVK(vfb, pwb); ATT_EXPK(p1, 0, pwa); __builtin_amdgcn_sched_barrier(0);
            ATT_VLOAD(vfb, 3); __builtin_amdgcn_sched_barrier(0);
            ATT_PVK(vfa, pwa); ATT_EXPK(p1, 8, pwb); __builtin_amdgcn_sched_barrier(0);
            ATT_PVK(vfb, pwb);
#undef ATT_VLOAD
#undef ATT_EXPK
#undef ATT_PVK
            l_reg += sacc;
        }
        else if (t + 2 < NT) ATT_DMA(t + 2, s2);
        slot += SLOTB; if (slot == NSLOT * SLOTB) slot = 0;
    }
    int lane_e = lane; asm volatile("" : "+v"(lane_e));
    const int r32e = lane_e & 31, hie = lane_e >> 5;
    l_reg += __shfl_xor(l_reg, 32);
    const float scl = (map == 0 ? 1.0f : lam) / l_reg;
    if (hie == 0) wsf[r32e] = scl;
    asm volatile("s_waitcnt lgkmcnt(0)" ::: "memory");
    float sc[16];
#pragma unroll
    for (int r = 0; r < 16; ++r) sc[r] = wsf[crow(r, hie)];
#pragma unroll
    for (int db = 0; db < 4; ++db)
#pragma unroll
        for (int r = 0; r < 16; ++r) o[db][r] *= sc[r];
    ATT_WAIT_BAR(0);
    LAS float* xb = (LAS float*)(lds + LDS_X) + qg * 4096;
    if (map == 1) {
#pragma unroll
        for (int db = 0; db < 4; ++db)
#pragma unroll
            for (int r = 0; r < 16; ++r) xb[(db * 16 + r) * 64 + lane_e] = o[db][r];
    }
    ATT_WAIT_BAR(0);
    if (map == 0) {
        float ss[16];
#pragma unroll
        for (int r = 0; r < 16; ++r) ss[r] = 0.f;
#pragma unroll
        for (int db = 0; db < 4; ++db)
#pragma unroll
            for (int r = 0; r < 16; ++r) { o[db][r] -= xb[(db * 16 + r) * 64 + lane_e]; ss[r] += o[db][r] * o[db][r]; }
#pragma unroll
        for (int r = 0; r < 16; ++r) {
#pragma unroll
            for (int m = 1; m < 32; m <<= 1) ss[r] += __shfl_xor(ss[r], m);
            ss[r] = (1.0f - LAMBDA_INIT) / sqrtf(ss[r] * (1.0f / 128.0f) + EPS); }
        LAS bf16* stg = (LAS bf16*)(lds + LDS_STG) + qg * 4096;
#pragma unroll
        for (int db = 0; db < 4; ++db) { const float gsub = subln[32 * db + r32e];
#pragma unroll
            for (int r = 0; r < 16; ++r) stg[crow(r, hie) * 128 + 32 * db + r32e] = (bf16)f2bf(o[db][r] * ss[r] * gsub); }
        asm volatile("s_waitcnt lgkmcnt(0)" ::: "memory");
        bf16* Yw = Y + (rowbase + q0 + 32 * qg) * DM + h * 128;
#pragma unroll
        for (int i = 0; i < 8; ++i) { const int id = i * 64 + lane_e, row = id >> 4, ch = id & 15;
            const u32x4 v = *(const LAS u32x4*)(stg + row * 128 + ch * 8); *(u32x4*)(Yw + (size_t)row * DM + ch * 8) = v; }
    }
    ATT_WAIT_BAR(0);
#undef ATT_DMA
}
#undef ATT_WAIT_BAR
}

namespace rnn {
using bf16x8 = __attribute__((ext_vector_type(8))) short;
using f32x16 = __attribute__((ext_vector_type(16))) float;
typedef float f32x2_t __attribute__((ext_vector_type(2))); typedef __bf16 bf16x2_t __attribute__((ext_vector_type(2)));
typedef unsigned u32x2 __attribute__((ext_vector_type(2)));
__device__ __forceinline__ unsigned cvtpk(float lo, float hi) { f32x2_t v = {lo, hi}; bf16x2_t b = __builtin_convertvector(v, bf16x2_t); return __builtin_bit_cast(unsigned, b); }
__device__ __forceinline__ float sigm2(float z) { return __builtin_amdgcn_rcpf(1.0f + __builtin_amdgcn_exp2f(z)); }
constexpr int LDS_CW = 0  , LDS_CH = 1536  , LDS_COMP = 2048  , LDS_CIN = 6144  , LDS_W = 8192  ,
              LDS_XS = 16384  , XS_BYTES = 264 * 128;
__device__ __forceinline__ void glds16(const void* gsrc, unsigned lds_dst) { unsigned keep;
    asm volatile("s_mov_b32 %0, m0\n\ts_mov_b32 m0, %2\n\ts_nop 0\n\tglobal_load_lds_dwordx4 %1, off\n\ts_mov_b32 m0, %0" : "=&s"(keep) : "v"(gsrc), "s"(lds_dst) : "memory"); }

__device__ __forceinline__ void rnn_consts(int n, int dh, const float* conv_w, const float* conv_b, const float* w_a, const float* b_a, const float* w_x, const float* b_x, const float* a_param, LAS unsigned char* lds) {
    const int tid = threadIdx.x, lane = tid & 63, r32 = lane & 31, hi = lane >> 5; const int wid = __builtin_amdgcn_readfirstlane(tid >> 6);
    LAS float* cwl = (LAS float*)(lds + LDS_CW); LAS float* chl = (LAS float*)(lds + LDS_CH);
    if (tid < 256) cwl[tid] = conv_w[(tid >> 6) * DRNN + n * 64 + (tid & 63)]; else if (tid < 320) cwl[tid] = conv_b[n * 64 + tid - 256];
    else if (tid < 352) { const int ch = n * 64 + 32 * dh + tid - 320; chl[tid - 320] = -1.4426950408889634f * b_a[ch]; chl[32 + tid - 320] = -1.4426950408889634f * b_x[ch]; chl[64 + tid - 320] = -8.0f * 1.4426950408889634f * log1pf(expf(-a_param[ch])); }
    { const int mat = wid >> 2, s = wid & 3; const float* wsrc = mat ? w_x : w_a; bf16x8 f;
#pragma unroll
        for (int j = 0; j < 8; ++j) { const int c = 16 * s + 8 * (j >> 2) + 4 * hi + (j & 3); f[j] = (short)f2bf(-1.4426950408889634f * wsrc[(size_t)(n * 64 + c) * 64 + 32 * dh + r32]); }
        *(LAS bf16x8*)(lds + LDS_W + (wid * 64 + lane) * 16) = f; }
}

template <bool PREP> __device__ __forceinline__ void rnn_unit(int b, int n, int dh, const bf16* __restrict__ XR, const bf16* __restrict__ GATE, bf16* __restrict__ Y, const float* conv_w, const float* conv_b,
                                         const float* w_a, const float* b_a, const float* w_x, const float* b_x, const float* a_param, LAS unsigned char* lds) {
    const int tid = threadIdx.x, lane = tid & 63, r32 = lane & 31, hi = lane >> 5; const int wid = __builtin_amdgcn_readfirstlane(tid >> 6);
    LAS float* cwl = (LAS float*)(lds + LDS_CW); LAS float* chl = (LAS float*)(lds + LDS_CH); LAS float* comp = (LAS float*)(lds + LDS_COMP);
    __syncthreads();
    const size_t seq0 = (size_t)b * SEQ;
    const unsigned lds0 = (unsigned)(uintptr_t)lds;
    const bf16* xsrc = XR + ((long)seq0 - 8 + (lane >> 3)) * PQ + n * 64;
#define RNN_DMA(rd_, buf_) do { const bf16* xs_ = xsrc + (size_t)(rd_) * 256 * PQ; const unsigned db_ = lds0 + LDS_XS + (unsigned)(buf_) * XS_BYTES; \
        _Pragma("unroll") for (int j_ = 0; j_ < 4; ++j_) { const int i_ = wid + 8 * j_; const int rw_ = 8 * i_ + (lane >> 3); \
            glds16(xs_ + (size_t)(8 * i_) * PQ + 8 * ((lane & 7) ^ ((rw_ >> 1) & 7)), (unsigned)__builtin_amdgcn_readfirstlane(db_ + 1024u * i_)); } \
        if (wid == 0) { const int rw_ = 256 + (lane >> 3); glds16(xs_ + (size_t)256 * PQ + 8 * ((lane & 7) ^ ((rw_ >> 1) & 7)), (unsigned)__builtin_amdgcn_readfirstlane(db_ + 32768u)); } } while (0)
    RNN_DMA(0, 0);
    if (!PREP) rnn_consts(n, dh, conv_w, conv_b, w_a, b_a, w_x, b_x, a_param, lds);
    const LAS bf16x8* wfr = (const LAS bf16x8*)(lds + LDS_W) + lane;
    float carry1 = 0.f;
    asm volatile("s_waitcnt vmcnt(0) lgkmcnt(0)\n\ts_barrier" ::: "memory");
    if (wid == 0) *(LAS v4u*)(lds + LDS_XS + lane * 16) = (v4u){0u, 0u, 0u, 0u};
    asm volatile("s_waitcnt lgkmcnt(0)\n\ts_barrier" ::: "memory");
    for (int rd = 0; rd < SEQ / 256; ++rd) {
        const int t = 32 * (8 * rd + wid) + r32; const size_t row = seq0 + t;
        if (rd + 1 < SEQ / 256) RNN_DMA(rd + 1, (rd + 1) & 1);
        bf16x8 xf[4]; float xsel[16];
        u32x2 gv[4];
#pragma unroll
        for (int g = 0; g < 4; ++g) gv[g] = *(const u32x2*)(GATE + row * PQ + n * 64 + 32 * dh + 8 * g + 4 * hi);
        const LAS unsigned char* xsb = lds + LDS_XS + (rd & 1) * XS_BYTES + 8 * hi;
        const int rl0 = 5 + 32 * wid + r32;
#pragma unroll
        for (int s = 0; s < 4; ++s) {
            float xc[8];
#pragma unroll
            for (int hf = 0; hf < 2; ++hf) { const int c0 = 16 * s + 8 * hf + 4 * hi;
                const v4f cb = *(const LAS v4f*)(cwl + 256 + c0); float acc4[4] = {cb[0], cb[1], cb[2], cb[3]};
#pragma unroll
                for (int k = 0; k < 4; ++k) { const int rl = rl0 + k;
                    const u32x2 x2 = *(const LAS u32x2*)(xsb + (rl * 8 + ((2 * s + hf) ^ ((rl >> 1) & 7))) * 16);
                    const v4f cw = *(const LAS v4f*)(cwl + k * 64 + c0);
                    acc4[0] += cw[0] * __builtin_bit_cast(float, x2[0] << 16); acc4[1] += cw[1] * __builtin_bit_cast(float, x2[0] & 0xffff0000u);
                    acc4[2] += cw[2] * __builtin_bit_cast(float, x2[1] << 16); acc4[3] += cw[3] * __builtin_bit_cast(float, x2[1] & 0xffff0000u); }
#pragma unroll
                for (int e = 0; e < 4; ++e) xc[4 * hf + e] = acc4[e]; }
            const unsigned w0 = cvtpk(xc[0], xc[1]), w1 = cvtpk(xc[2], xc[3]), w2 = cvtpk(xc[4], xc[5]), w3 = cvtpk(xc[6], xc[7]);
            xf[s] = __builtin_bit_cast(bf16x8, (v4u){w0, w1, w2, w3});
            if (s < 2) {
#pragma unroll
                for (int j = 0; j < 8; ++j) xsel[8 * s + j] = xc[j];
            } else {
#pragma unroll
                for (int j = 0; j < 8; ++j) xsel[8 * (s - 2) + j] = dh ? xc[j] : xsel[8 * (s - 2) + j];
            }
        }
        f32x16 ga, gx; float sp[16];
#pragma unroll
        for (int g = 0; g < 4; ++g) { const v4f a4 = *(const LAS v4f*)(chl + 8 * g + 4 * hi), x4 = *(const LAS v4f*)(chl + 32 + 8 * g + 4 * hi), s4 = *(const LAS v4f*)(chl + 64 + 8 * g + 4 * hi);
#pragma unroll
            for (int e = 0; e < 4; ++e) { ga[4 * g + e] = a4[e]; gx[4 * g + e] = x4[e]; sp[4 * g + e] = s4[e]; } }
#pragma unroll
        for (int s = 0; s < 4; ++s) { ga = __builtin_amdgcn_mfma_f32_32x32x16_bf16(wfr[s * 64], xf[s], ga, 0, 0, 0); gx = __builtin_amdgcn_mfma_f32_32x32x16_bf16(wfr[(4 + s) * 64], xf[s], gx, 0, 0, 0); }
        float av[16], bv[16];
#pragma unroll
        for (int r = 0; r < 16; ++r) { const float rg = sigm2(ga[r]), ig = sigm2(gx[r]);
            const float aa = __builtin_amdgcn_exp2f(sp[r] * rg); av[r] = aa; bv[r] = __builtin_amdgcn_sqrtf(fmaxf(1.0f - aa * aa, 0.f)) * ig * xsel[r]; }
#define RNN_STEPS(CTRL) \
        "v_fmac_f32_dpp %8, %8, %0 " CTRL "\n\tv_fmac_f32_dpp %9, %9, %1 " CTRL "\n\tv_fmac_f32_dpp %10, %10, %2 " CTRL "\n\tv_fmac_f32_dpp %11, %11, %3 " CTRL "\n\t" \
        "v_fmac_f32_dpp %12, %12, %4 " CTRL "\n\tv_fmac_f32_dpp %13, %13, %5 " CTRL "\n\tv_fmac_f32_dpp %14, %14, %6 " CTRL "\n\tv_fmac_f32_dpp %15, %15, %7 " CTRL "\n\t" \
        "v_mul_f32_dpp %0, %0, %0 " CTRL "\n\tv_mul_f32_dpp %1, %1, %1 " CTRL "\n\tv_mul_f32_dpp %2, %2, %2 " CTRL "\n\tv_mul_f32_dpp %3, %3, %3 " CTRL "\n\t" \
        "v_mul_f32_dpp %4, %4, %4 " CTRL "\n\tv_mul_f32_dpp %5, %5, %5 " CTRL "\n\tv_mul_f32_dpp %6, %6, %6 " CTRL "\n\tv_mul_f32_dpp %7, %7, %7 " CTRL "\n\t"
#define RNN_SCAN8(o) asm volatile("s_nop 1\n\t" RNN_STEPS("row_shr:1 row_mask:0xf bank_mask:0xf") RNN_STEPS("row_shr:2 row_mask:0xf bank_mask:0xf") RNN_STEPS("row_shr:4 row_mask:0xf bank_mask:0xf") \
            RNN_STEPS("row_shr:8 row_mask:0xf bank_mask:0xf") RNN_STEPS("row_bcast:15 row_mask:0xa bank_mask:0xf") \
            : "+v"(av[o]), "+v"(av[o + 1]), "+v"(av[o + 2]), "+v"(av[o + 3]), "+v"(av[o + 4]), "+v"(av[o + 5]), "+v"(av[o + 6]), "+v"(av[o + 7]), \
              "+v"(bv[o]), "+v"(bv[o + 1]), "+v"(bv[o + 2]), "+v"(bv[o + 3]), "+v"(bv[o + 4]), "+v"(bv[o + 5]), "+v"(bv[o + 6]), "+v"(bv[o + 7]))
        RNN_SCAN8(0); RNN_SCAN8(8);
#undef RNN_SCAN8
#undef RNN_STEPS
        LAS float* cp = comp + (rd & 1) * 512;
        if (r32 == 31) {
#pragma unroll
            for (int g = 0; g < 4; ++g) { *(LAS v4f*)(cp + (wid * 2 + 0) * 32 + 8 * g + 4 * hi) = (v4f){av[4 * g], av[4 * g + 1], av[4 * g + 2], av[4 * g + 3]};
                *(LAS v4f*)(cp + (wid * 2 + 1) * 32 + 8 * g + 4 * hi) = (v4f){bv[4 * g], bv[4 * g + 1], bv[4 * g + 2], bv[4 * g + 3]}; }
        }
        asm volatile("s_waitcnt vmcnt(0) lgkmcnt(0)\n\ts_barrier" ::: "memory");
        float cin1 = carry1;
#pragma unroll
        for (int w = 0; w < 8; ++w) { const float A1 = cp[(w * 2 + 0) * 32 + r32], B1 = cp[(w * 2 + 1) * 32 + r32];
            cin1 = (w == wid) ? carry1 : cin1; carry1 = A1 * carry1 + B1; }
        LAS float* cib = (LAS float*)(lds + LDS_CIN) + wid * 32;
        if (hi == 0) cib[r32] = cin1;
        asm volatile("s_waitcnt lgkmcnt(0)" ::: "memory");
        float cin[16];
#pragma unroll
        for (int g = 0; g < 4; ++g) { const v4f c4 = *(const LAS v4f*)(cib + 8 * g + 4 * hi);
#pragma unroll
            for (int e = 0; e < 4; ++e) cin[4 * g + e] = c4[e]; }
#pragma unroll
        for (int g = 0; g < 4; ++g) { const int c0 = n * 64 + 32 * dh + 8 * g + 4 * hi;
            const float gt[4] = {__builtin_bit_cast(float, gv[g][0] << 16), __builtin_bit_cast(float, gv[g][0] & 0xffff0000u), __builtin_bit_cast(float, gv[g][1] << 16), __builtin_bit_cast(float, gv[g][1] & 0xffff0000u)};
            float y[4];
#pragma unroll
            for (int e = 0; e < 4; ++e) { const int r = 4 * g + e; const float h = av[r] * cin[r] + bv[r]; const float x = gt[e];
                y[e] = h * x * sigm2(x * (-2.3022081981531984f + -0.10294323958041973f * (x * x))); }
            *(u32x2*)(Y + row * DM + DATTN + c0) = (u32x2){cvtpk(y[0], y[1]), cvtpk(y[2], y[3])}; }
    }
#undef RNN_DMA
    __syncthreads();
}
}

typedef __attribute__((address_space(1))) unsigned gu32;
#define RLX_AGENT __ATOMIC_RELAXED, __HIP_MEMORY_SCOPE_AGENT
#define XB_TMO      128
#define XB_XCNT(j)  (256  + 64 * (j))
#define XB_XSUB(j)  (1280 + 64 * (j))
#define XB_XGEN(j)  (2304 + 64 * (j))
#define XB_TOP      3328
#define XB_TOPGEN   3392
#define XCD_BAR_WORDS 3456
#define XB_SPIN_CAP (1u << 18)

__device__ __forceinline__ unsigned xb_ld(unsigned* p)              { return __hip_atomic_load(p, __ATOMIC_RELAXED, __HIP_MEMORY_SCOPE_AGENT); }
__device__ __forceinline__ unsigned xb_add(unsigned* p, unsigned v) { return __hip_atomic_fetch_add(p, v, __ATOMIC_RELAXED, __HIP_MEMORY_SCOPE_AGENT); }
__device__ __forceinline__ unsigned xb_xcc_id() { return (unsigned)__builtin_amdgcn_s_getreg((3 << 11) | 20) & 0xFu; }
#define XB_SPIN(cond, bar) do { unsigned _sp = 0; while (cond) { __builtin_amdgcn_s_sleep(1); \
    if ((++_sp & 255u) == 0u) { if (xb_ld(&(bar)[XB_TMO])) break; if (_sp > XB_SPIN_CAP) { atomicAdd(&(bar)[XB_TMO], 1u); break; } } } } while (0)

struct XcdBarrier {
    unsigned* bar; unsigned x;
    volatile LAS unsigned* st;
};

__device__ __forceinline__ XcdBarrier xcd_barrier_post(unsigned* bar, volatile LAS unsigned* st) {
    XcdBarrier b; b.bar = bar; b.x = xb_xcc_id(); b.st = st;
    if (threadIdx.x == 0) (void)xb_add(&bar[XB_XCNT(b.x)], 1u);
    return b;
}
__device__ __forceinline__ void xcd_barrier_complete(unsigned* bar, unsigned x, unsigned& nloc, unsigned& nx) {
    const unsigned G = gridDim.x * gridDim.y * gridDim.z;
    unsigned sum, cnt, mine, sp = 0u;
    for (;;) {
        sum = 0u; cnt = 0u; mine = 0u;
#pragma unroll
        for (unsigned j = 0; j < 16; ++j) { const unsigned c = xb_ld(&bar[XB_XCNT(j)]); sum += c; cnt += (c > 0u) ? 1u : 0u; mine = (j == x) ? c : mine; }
        if (sum == G) break;
        __builtin_amdgcn_s_sleep(1);
        if ((++sp & 255u) == 0u) { if (xb_ld(&bar[XB_TMO])) break; if (sp > XB_SPIN_CAP) { atomicAdd(&bar[XB_TMO], 1u); break; } }
    }
    nloc = mine > 0u ? mine : 1u; nx = cnt > 0u ? cnt : 1u;
}

struct NoMid { __device__ __forceinline__ void operator()() const {} };
template <class Mid = NoMid> __device__ __forceinline__ void xcd_barrier(const XcdBarrier& b, const Mid& mid = Mid()) {
    asm volatile("s_waitcnt vmcnt(0)" ::: "memory");
    __syncthreads();
    mid();
    if (threadIdx.x == 0) {
        unsigned* bar = b.bar;
        __builtin_amdgcn_s_waitcnt(0);
        unsigned nloc = b.st[0], nx = b.st[1];
        if (nloc == 0u) { xcd_barrier_complete(bar, b.x, nloc, nx); b.st[0] = nloc; b.st[1] = nx; }
        const unsigned old = xb_add(&bar[XB_XSUB(b.x)], 1u);
        const unsigned gen = old / nloc;
        if (old + 1u == (gen + 1u) * nloc) {
            __builtin_amdgcn_fence(__ATOMIC_RELEASE, "agent");
            asm volatile("s_waitcnt vmcnt(0)" ::: "memory");
            const unsigned og = xb_add(&bar[XB_TOP], 1u);
            const unsigned tg = og / nx;
            if (og + 1u == (tg + 1u) * nx) xb_add(&bar[XB_TOPGEN], 1u);
            else XB_SPIN(xb_ld(&bar[XB_TOPGEN]) == tg, bar);
            __builtin_amdgcn_fence(__ATOMIC_ACQUIRE, "agent");
            xb_add(&bar[XB_XGEN(b.x)], 1u);
            asm volatile("s_waitcnt vmcnt(0)" ::: "memory");
        } else {
            XB_SPIN(xb_ld(&bar[XB_XGEN(b.x)]) == gen, bar);
            __builtin_amdgcn_fence(__ATOMIC_ACQUIRE, "agent");
            asm volatile("s_waitcnt vmcnt(0)" ::: "memory");
        }
    }
    __syncthreads();
}

#define XL_SUB(j)   (3520 + 64 * (j))
#define XL_GEN(j)   (4544 + 64 * (j))
#define XL_TABLE    6144
template <class Mid = NoMid> __device__ __forceinline__ void xcd_local_barrier(const XcdBarrier& b, const Mid& mid = Mid()) {
    asm volatile("s_waitcnt vmcnt(0)" ::: "memory");
    __syncthreads();
    unsigned old = 0u, nloc = 1u;
    if (threadIdx.x == 0) {
        __builtin_amdgcn_s_waitcnt(0);
        nloc = b.st[0];
        old = xb_add(&b.bar[XL_SUB(b.x)], 1u);
    }
    mid();
    if (threadIdx.x == 0) {
        unsigned* bar = b.bar;
        const unsigned gen = old / nloc;
        if (old + 1u == (gen + 1u) * nloc) xb_add(&bar[XL_GEN(b.x)], 1u);
        else XB_SPIN(xb_ld(&bar[XL_GEN(b.x)]) == gen, bar);
        __builtin_amdgcn_fence(__ATOMIC_ACQUIRE, "agent");
        asm volatile("s_waitcnt vmcnt(0)" ::: "memory");
    }
    __syncthreads();
}

#define XG_SUB(g)   (6400 + 16 * (g))
#define XG_GEN(g)   (7424 + 16 * (g))
template <class Mid = NoMid> __device__ __forceinline__ void panel_group_barrier(const XcdBarrier& b, unsigned grp, const Mid& mid = Mid()) {
    asm volatile("s_waitcnt vmcnt(0)" ::: "memory");
    __syncthreads();
    unsigned old = 0u;
    if (threadIdx.x == 0) { __builtin_amdgcn_s_waitcnt(0); old = xb_add(&b.bar[XG_SUB(grp)], 1u); }
    mid();
    if (threadIdx.x == 0) {
        unsigned* bar = b.bar;
        const unsigned gen = old >> 2;
        if ((old & 3u) == 3u) xb_add(&bar[XG_GEN(grp)], 1u);
        else XB_SPIN(xb_ld(&bar[XG_GEN(grp)]) == gen, bar);
        __builtin_amdgcn_fence(__ATOMIC_ACQUIRE, "agent");
        asm volatile("s_waitcnt vmcnt(0)" ::: "memory");
    }
    __syncthreads();
}

#define XS_SUB(s, j) (8704 + 1024 * (s) + 64 * (j))
#define XS_TOP(s)    (10752 + 128 * (s))
#define XS_FLAG(s)   (10752 + 128 * (s) + 64)
__device__ __forceinline__ void xcd_split_arrive(const XcdBarrier& b, int set) {
    asm volatile("s_waitcnt vmcnt(0)" ::: "memory");
    __syncthreads();
    if (threadIdx.x == 0) {
        unsigned* bar = b.bar;
        __builtin_amdgcn_s_waitcnt(0);
        unsigned nloc = b.st[0], nx = b.st[1];
        if (nloc == 0u) { xcd_barrier_complete(bar, b.x, nloc, nx); b.st[0] = nloc; b.st[1] = nx; }
        const unsigned old = xb_add(&bar[XS_SUB(set, b.x)], 1u);
        if (old + 1u == nloc) {
            __builtin_amdgcn_fence(__ATOMIC_RELEASE, "agent");
            asm volatile("s_waitcnt vmcnt(0)" ::: "memory");
            const unsigned og = xb_add(&bar[XS_TOP(set)], 1u);
            if (og + 1u == nx) xb_add(&bar[XS_FLAG(set)], 1u);
        }
    }
    __syncthreads();
}
__device__ __forceinline__ void xcd_split_wait(const XcdBarrier& b, int set, int who) {
    if ((int)threadIdx.x == who) {
        unsigned* bar = b.bar;
        XB_SPIN(xb_ld(&bar[XS_FLAG(set)]) == 0u, bar);
        __builtin_amdgcn_fence(__ATOMIC_ACQUIRE, "agent");
        asm volatile("s_waitcnt vmcnt(0)" ::: "memory");
    }
}

__device__ __forceinline__ int srcblk(int mode, int nb) {
    if (mode == 1) { const int t = nb >> 3, bj = (nb >> 2) & 1, jb = nb & 3; return bj * 88 + 4 * t + jb; }
    if (mode == 2) { if (nb < 32) { const int t = nb >> 3, bj = (nb >> 2) & 1, wc = nb & 3; return 8 * t + 2 * wc + bj; } return nb; }
    return nb;
}
__device__ __forceinline__ void transpose_item(const float* W, int K, int N, const float* gain, bf16* WT, int mode, LAS float* scr, int item, int lane) {
    const int nblk = N / 32, kb = item / nblk, nb = item % nblk, k0 = 64 * kb, n0d = 32 * nb, n0s = 32 * srcblk(mode, nb);
    const int k0d = (mode == 3) ? (21 - (kb >> 1)) * 128 + 64 * (kb & 1) : k0;
#pragma unroll
    for (int i = 0; i < 8; ++i) { const int kk = 8 * i + (lane >> 3), cc = 4 * (lane & 7);
        const v4f w = __builtin_nontemporal_load((const v4f*)(W + (size_t)(k0 + kk) * N + n0s + cc)); const float gk = gain ? gain[k0 + kk] : 1.0f;
        scr[kk * 33 + cc] = w.x * gk; scr[kk * 33 + cc + 1] = w.y * gk; scr[kk * 33 + cc + 2] = w.z * gk; scr[kk * 33 + cc + 3] = w.w * gk; }
    asm volatile("s_waitcnt lgkmcnt(0)" ::: "memory");
    const int c = lane & 7;
    const bool qkmap = (mode == 2) && nb < 32 && ((nb >> 2) & 1) == 0;
#pragma unroll
    for (int j = 0; j < 4; ++j) { const int n = (lane >> 3) + 8 * j; const int ncol = (qkmap && n < 16) ? 4 * (n >> 3) + 8 * ((n >> 2) & 1) + (n & 3) : n; const LAS float* s = scr + (8 * c) * 33 + ncol;
        v4u o; o.x = pk2(s[0 * 33], s[1 * 33]); o.y = pk2(s[2 * 33], s[3 * 33]); o.z = pk2(s[4 * 33], s[5 * 33]); o.w = pk2(s[6 * 33], s[7 * 33]);
        *(v4u*)(WT + (size_t)(n0d + n) * K + k0d + 8 * c) = o; }
    asm volatile("s_waitcnt lgkmcnt(0)" ::: "memory");
}
__device__ __forceinline__ void xprep_row(const float* xrow, bf16* orow, float* ssrow, int lane) {
    const v4f* xr = (const v4f*)xrow + lane;
    v4f v[4]; float s = 0.f;
#pragma unroll
    for (int j = 0; j < 4; ++j) { v[j] = __builtin_nontemporal_load(xr + 64 * j); s += (v[j].x * v[j].x + v[j].y * v[j].y) + (v[j].z * v[j].z + v[j].w * v[j].w); }
    s = wave_sum(s);
    unsigned long long* o8 = (unsigned long long*)orow + lane;
#pragma unroll
    for (int j = 0; j < 4; ++j) o8[64 * j] = (unsigned long long)pk2(v[j].x, v[j].y) | ((unsigned long long)pk2(v[j].z, v[j].w) << 32);
    if (lane < 16) ssrow[lane] = lane == 0 ? s : 0.f;
}

struct Args {
    const float* in[25]; float* out; unsigned char* ws; float invf[8]; int ph_lo, ph_hi;
};
constexpr int NWAVES = 8, NTHREADS = 512;
constexpr int RING_BYTES = 131072, MISC_OFF = RING_BYTES + 256, LDS_BYTES = 147456;
constexpr int CW_BAR = 4096;
constexpr size_t CTL_ZERO_BYTES = 65536;

__device__ __forceinline__ void p0_rows_all(const Args& a, int tid);
__device__ __forceinline__ void p0_prologue(const Args& a, LAS unsigned char* lds, int tid, int r_lo, int r_hi, bool rows_too) {
    const int lane = tid & 63, wave = tid >> 6;
    LAS float* scr = (LAS float*)(lds + wave * 16384);
    const int gw = blockIdx.x * NWAVES + wave, NGW = gridDim.x * NWAVES;
    unsigned char* ws = a.ws;
    constexpr int I1 = (DM / 64) * (NFF / 32), I2 = (DFF / 64) * (DM / 32), I3 = (DM / 64) * (NPROJ / 32), I4 = (DM / 64) * (DM / 32);
    constexpr int NIT = 2 * I1 + 2 * I2 + I3 + I4;
    for (int it = gw + r_lo * NGW, rd = r_lo; it < NIT && rd < r_hi; it += NGW, ++rd) {
        int r = it;
        if (r < I1) { transpose_item(a.in[3], DM, NFF, a.in[2], (bf16*)(ws + WS_W1T), 1, scr, r, lane); continue; } r -= I1;
        if (r < I1) { transpose_item(a.in[23], DM, NFF, a.in[22], (bf16*)(ws + WS_W5T), 1, scr, r, lane); continue; } r -= I1;
        if (r < I2) { transpose_item(a.in[4], DFF, DM, nullptr, (bf16*)(ws + WS_W2T), 3, scr, r, lane); continue; } r -= I2;
        if (r < I2) { transpose_item(a.in[24], DFF, DM, nullptr, (bf16*)(ws + WS_W6T), 3, scr, r, lane); continue; } r -= I2;
        if (r < I3) { transpose_item(a.in[6], DM, NPROJ, a.in[5], (bf16*)(ws + WS_W3T), 2, scr, r, lane); continue; } r -= I3;
        transpose_item(a.in[21], DM, DM, nullptr, (bf16*)(ws + WS_W4T), 0, scr, r, lane);
    }
    if (rows_too) p0_rows_all(a, tid);
}
__device__ __forceinline__ void p0_rows_all(const Args& a, int tid) {
    const int lane = tid & 63, wave = tid >> 6; const int gw = blockIdx.x * NWAVES + wave, NGW = gridDim.x * NWAVES; unsigned char* ws = a.ws;
    const float* x = a.in[0];
    for (int m = gw; m < MTOK; m += NGW) xprep_row(x + (size_t)m * DM, (bf16*)(ws + WS_XB) + (size_t)m * DM, (float*)(ws + WS_SS) + (size_t)m * 16, lane);
    float* tab = (float*)(ws + WS_ROPE); const int* pos = (const int*)a.in[1];
    for (int i = blockIdx.x * NTHREADS + tid; i < MTOK * 8; i += gridDim.x * NTHREADS) {
        const int row = i >> 3, j = i & 7;
        const float ang = (float)pos[row] * a.invf[j];
        tab[row * 16 + j] = (float)cos((double)ang); tab[row * 16 + 8 + j] = (float)sin((double)ang);
    }
}
__device__ __forceinline__ void p0_rows_own(const Args& a, int tid) {
    const int lane = tid & 63, wave = tid >> 6; unsigned char* ws = a.ws;
    const int xl = (int)blockIdx.x & 7, jg = ((int)blockIdx.x >> 3) & 7, m4 = (int)blockIdx.x >> 6, pA = 16 * xl + jg, pB = pA + 8;
    const float* x = a.in[0];
    for (int i = 0; i < 16; ++i) { const int r = m4 * 8 + wave + 32 * i, m = (r < 256 ? pA : pB) * 256 + (r & 255);
        xprep_row(x + (size_t)m * DM, (bf16*)(ws + WS_XB) + (size_t)m * DM, (float*)(ws + WS_SS) + (size_t)m * 16, lane); }
    float* tab = (float*)(ws + WS_ROPE); const int* pos = (const int*)a.in[1];
    for (int e = m4 * NTHREADS + tid; e < 512 * 8; e += 4 * NTHREADS) {
        const int r = e >> 3, j = e & 7, row = (r < 256 ? pA : pB) * 256 + (r & 255);
        const float ang = (float)pos[row] * a.invf[j];
        tab[row * 16 + j] = (float)cos((double)ang); tab[row * 16 + 8 + j] = (float)sin((double)ang);
    }
}

constexpr int RTAB_OFF = RING_BYTES + 1024;
struct RinvPre {
    const float* ss; int pmA, pmB; LAS float* rtab;
    __device__ __forceinline__ void operator()() const { const int tid = threadIdx.x; const size_t row = (size_t)((tid >> 8) ? pmB : pmA) * 256 + (tid & 255); rtab[tid] = rinv_of(ss, row); }
};
__device__ __forceinline__ RinvPre rinv_prepass(const float* ss, const pg8::StaticOrder& S, LAS unsigned char* lds) {
    pg8::Unit u; int n = 0; while (S.next(n, u)) ++n;
    RinvPre p{ss, 0, 0, (LAS float*)(lds + RTAB_OFF)};
    if (n == 0) return p;
    S.next(0, u); p.pmA = u.pm; S.next(n - 1, u); p.pmB = u.pm;
    return p;
}
struct RevOrder : pg8::StaticOrder {
    int n;
    __device__ void init_rev(int M, int N, int G_, int c_) { init(M, N, G_, c_); pg8::Unit u; n = 0; while (pg8::StaticOrder::next(n, u)) ++n; }
    __device__ bool next(int i, pg8::Unit& u) const { return i < n ? pg8::StaticOrder::next(n - 1 - i, u) : false; }
};
struct BMid { LAS unsigned char* lds; const bf16* Bt; int K, pn; __device__ __forceinline__ void operator()() const { pg8::stage_b_first(lds, Bt, K, pn); } };
__device__ __forceinline__ int first_pn_static(int M, int N, int G, int c) { pg8::StaticOrder S; S.init(M, N, G, c); pg8::Unit u; return S.next(0, u) ? u.pn : 0; }
__device__ __forceinline__ int first_pn_rev(int M, int N, int G, int c) { RevOrder S; S.init_rev(M, N, G, c); pg8::Unit u; return S.next(0, u) ? u.pn : 0; }
#ifndef PG8_ALIGN
#define PG8_ALIGN true
#endif
#ifndef PG8_SP2
#define PG8_SP2 true
#endif
__global__ void __launch_bounds__(NTHREADS, 2) mk_fwd(Args a) {
    extern __shared__ __attribute__((aligned(16))) unsigned char lds_raw[];
    cg::grid_group grid = cg::this_grid();
    LAS unsigned char* lds = (LAS unsigned char*)lds_raw;
    const int tid = threadIdx.x;
    unsigned char* ws = a.ws;
    const int lo = a.ph_lo, hi = a.ph_hi, G = gridDim.x;
    bf16 *W1T = (bf16*)(ws + WS_W1T), *W2T = (bf16*)(ws + WS_W2T), *W3T = (bf16*)(ws + WS_W3T), *W4T = (bf16*)(ws + WS_W4T), *W5T = (bf16*)(ws + WS_W5T), *W6T = (bf16*)(ws + WS_W6T);
    float* tab = (float*)(ws + WS_ROPE); float* ss0 = (float*)(ws + WS_SS); float* ss1 = ss0 + (size_t)MTOK * 16; float* ss2 = ss1 + (size_t)MTOK * 16;
    bf16 *XB = (bf16*)(ws + WS_XB), *Y = (bf16*)(ws + WS_Y), *ACT = (bf16*)(ws + WS_ACT);
    bf16 *Qb = ACT, *Kb = ACT + 512, *Vb = ACT + 1024, *XR = ACT + 1536, *GATE = ACT + 2048;
    float* out = a.out;
#ifndef PROBE_DUP
#define PROBE_DUP -1
#endif
#define REP(k) for (int rep_ = 0; rep_ < ((PROBE_DUP) == (k) ? 2 : 1); ++rep_)
#define REPSYNC() do { if (rep_) xcd_barrier(bar); } while (0)
#define IN(k) (lo <= (k) && (k) < hi)
    volatile LAS unsigned* MISC = (volatile LAS unsigned*)(lds + MISC_OFF);
    if (tid < 16) MISC[tid] = 0u;
    __syncthreads();
    XcdBarrier bar = xcd_barrier_post((unsigned*)(ws + WS_CTL) + CW_BAR, MISC + 8);
    if (tid == 0) __hip_atomic_store((unsigned*)(ws + WS_CTL) + CW_BAR + XL_TABLE + blockIdx.x, bar.x + 1u, __ATOMIC_RELAXED, __HIP_MEMORY_SCOPE_AGENT);
    const unsigned pgrp = ((unsigned)blockIdx.x & 7u) * 8u + (((unsigned)blockIdx.x >> 3) & 7u);
    bool split_b = false;
    bool local_ok = false;
#ifndef MK_LOCAL_SEAMS
#define MK_LOCAL_SEAMS 1
#endif
#ifndef MK_GROUP_SEAMS
#define MK_GROUP_SEAMS 1
#endif
#ifndef MK_CG_SEAM0
#define MK_CG_SEAM0 0
#endif
#define SEAMX(k, MID) do { if (IN(k) && IN((k) + 1)) { if (MK_CG_SEAM0 && (k) == 0) grid.sync(); else if (MK_LOCAL_SEAMS && local_ok && MK_GROUP_SEAMS && ((k) == 1 || (k) == 2 || (k) == 5 || (k) == 6)) panel_group_barrier(bar, pgrp, MID); else if (MK_LOCAL_SEAMS && local_ok && (k) >= 1) xcd_local_barrier(bar, MID); else xcd_barrier(bar, MID); } } while (0)
#define SEAM(k) SEAMX(k, NoMid())
#define BPRE(k) (IN(k) && IN((k) + 1) && !(MK_CG_SEAM0 && (k) == 0))

    const BMid mid1{lds, W1T, DM, first_pn_static(MTOK, NFF, G, (int)blockIdx.x)};
    if (G == 256 && lo == 0 && hi > 2 && !MK_CG_SEAM0) {
        p0_prologue(a, lds, tid, 0, 2, false);
        xcd_split_arrive(bar, 0);
        p0_rows_own(a, tid);
        p0_prologue(a, lds, tid, 2, 1 << 20, false);
        xcd_split_arrive(bar, 1);
        xcd_split_wait(bar, 0, 0);
        __syncthreads();
        if (MK_LOCAL_SEAMS) {
            const unsigned* tblx = (const unsigned*)(ws + WS_CTL) + CW_BAR + XL_TABLE;
            bool okt = true;
            if (tid < 256) { const unsigned mine = __hip_atomic_load(tblx + tid, __ATOMIC_RELAXED, __HIP_MEMORY_SCOPE_AGENT), lead = __hip_atomic_load(tblx + (tid & 7), __ATOMIC_RELAXED, __HIP_MEMORY_SCOPE_AGENT); okt = (mine == lead) && mine != 0u;
                if (tid < 8) { for (int j = 0; j < 8; ++j) if (j != tid && __hip_atomic_load(tblx + j, __ATOMIC_RELAXED, __HIP_MEMORY_SCOPE_AGENT) == mine) okt = false; } }
            local_ok = __syncthreads_and(okt ? 1 : 0) != 0;
        }
        if (MK_LOCAL_SEAMS && local_ok && MK_GROUP_SEAMS) panel_group_barrier(bar, pgrp, mid1); else xcd_barrier(bar, mid1);
        split_b = true;
    } else {
        if (IN(0)) { p0_prologue(a, lds, tid, 0, 1 << 20, true); }
        SEAMX(0, mid1);
    }
#ifdef PROBE_SYNCS
    for (int i_ = 0; i_ < PROBE_SYNCS; ++i_) xcd_barrier(bar);
#endif
    if (IN(1)) REP(1) { REPSYNC(); pg8::Gemm g{XB, W1T, MTOK, NFF, DM}; pg8::StaticOrder S; S.init(MTOK, NFF, G, (int)blockIdx.x);
        const RinvPre rp = rinv_prepass(ss0, S, lds); pg8::EpiSwiglu E{ACT, (const LAS float*)(lds + RTAB_OFF), rp.pmA}; pg8::gemm_phase<pg8::EpiSwiglu, pg8::StaticOrder, PG8_ALIGN, PG8_SP2, RinvPre>(lds, g, S, E, rp, BPRE(0)); }
    if (split_b) xcd_split_wait(bar, 1, 64);
    { const BMid mid{lds, W2T, DFF, first_pn_rev(MTOK, DM, G, (int)blockIdx.x)}; SEAMX(1, mid); }
    if (IN(2)) REP(2) { REPSYNC(); pg8::Gemm g{ACT, W2T, MTOK, DM, DFF}; RevOrder S; S.init_rev(MTOK, DM, G, (int)blockIdx.x);
        pg8::EpiResid<true, true> E{nullptr, XB, nullptr, ss1, 0.5f}; pg8::gemm_phase<pg8::EpiResid<true, true>, RevOrder, PG8_ALIGN, PG8_SP2>(lds, g, S, E, pg8::NoPre(), BPRE(1)); }
    { const BMid mid{lds, W3T, DM, first_pn_static(MTOK, NPROJ, G, (int)blockIdx.x)}; SEAMX(2, mid); }
    if (IN(3)) REP(3) { REPSYNC(); pg8::Gemm g{XB, W3T, MTOK, NPROJ, DM}; pg8::StaticOrder S; S.init(MTOK, NPROJ, G, (int)blockIdx.x);
        const RinvPre rp = rinv_prepass(ss1, S, lds); pg8::EpiProj E{(const LAS float*)(lds + RTAB_OFF), rp.pmA, tab, a.in[7], a.in[8], Qb, 0.125f * 1.4426950408889634f}; pg8::gemm_phase<pg8::EpiProj, pg8::StaticOrder, PG8_ALIGN, PG8_SP2, RinvPre>(lds, g, S, E, rp, BPRE(2)); }
    if (IN(3) && IN(4)) {
        const int vcu0 = (G % 8 == 0) ? ((int)blockIdx.x % 8) * (G / 8) + (int)blockIdx.x / 8 : (int)blockIdx.x;
        if (vcu0 < BATCH * 16) rnn::rnn_consts((vcu0 >> 1) & 7, vcu0 & 1, a.in[14], a.in[15], a.in[16], a.in[17], a.in[18], a.in[19], a.in[20], lds);
        const int l64 = tid & 63;
        float d1 = a.in[9][l64] * a.in[10][l64], d2 = a.in[11][l64] * a.in[12][l64], gq = fabsf(a.in[7][l64]), gk = fabsf(a.in[8][l64]);
        d1 = wave_sum(d1); d2 = wave_sum(d2);
#pragma unroll
        for (int o_ = 1; o_ < 64; o_ <<= 1) { gq = fmaxf(gq, __shfl_xor(gq, o_)); gk = fmaxf(gk, __shfl_xor(gk, o_)); }
        if (tid == 0) { MISC[4] = __float_as_uint(expf(d1) - expf(d2) + LAMBDA_INIT); MISC[5] = __float_as_uint(-8.0f * gq * gk * 1.4426950408889634f); }
    }
    SEAM(3);
    if (IN(4)) {
        const int vcu = (G % 8 == 0) ? ((int)blockIdx.x % 8) * (G / 8) + (int)blockIdx.x / 8 : (int)blockIdx.x;
        if (lo > 3) { for (int u = vcu; u < BATCH * 16; u += G) rnn::rnn_unit<false>(u >> 4, (u >> 1) & 7, u & 1, XR, GATE, Y, a.in[14], a.in[15], a.in[16], a.in[17], a.in[18], a.in[19], a.in[20], lds);
            if (tid == 0) { MISC[4] = 0x7fc00000u; MISC[5] = 0x7fc00000u; } __syncthreads(); }
        else { if (vcu < BATCH * 16) rnn::rnn_unit<true>(vcu >> 4, (vcu >> 1) & 7, vcu & 1, XR, GATE, Y, a.in[14], a.in[15], a.in[16], a.in[17], a.in[18], a.in[19], a.in[20], lds);
            for (int u = vcu + G; u < BATCH * 16; u += G) rnn::rnn_unit<false>(u >> 4, (u >> 1) & 7, u & 1, XR, GATE, Y, a.in[14], a.in[15], a.in[16], a.in[17], a.in[18], a.in[19], a.in[20], lds); }
        const float lam = __uint_as_float(MISC[4]), negm_s = __uint_as_float(MISC[5]);
        REP(42) for (int v = vcu; v < 256; v += G) {
            const int bh = v >> 2, s = v & 3;
            for (int i = 0; i < 4; ++i) { const int cc = (i == 0) ? s : (i == 1) ? 7 - s : (i == 2) ? 8 + s : 15 - s;
                attn::attn_unit(bh >> 2, bh & 3, cc, Qb, Kb, Vb, Y, lam, negm_s, a.in[13], lds); }
        }
        __syncthreads();
    }
    { const BMid mid{lds, W4T, DM, first_pn_static(MTOK, DM, G, (int)blockIdx.x)}; SEAMX(4, mid); }
    if (IN(5)) { pg8::Gemm g{Y, W4T, MTOK, DM, DM}; pg8::StaticOrder S; S.init(MTOK, DM, G, (int)blockIdx.x);
        pg8::EpiResid<true, true> E{nullptr, XB, nullptr, ss2, 1.0f}; pg8::gemm_phase<pg8::EpiResid<true, true>, pg8::StaticOrder, PG8_ALIGN, PG8_SP2>(lds, g, S, E, pg8::NoPre(), BPRE(4)); }
    { const BMid mid{lds, W5T, DM, first_pn_static(MTOK, NFF, G, (int)blockIdx.x)}; SEAMX(5, mid); }
    if (IN(6)) REP(6) { REPSYNC(); pg8::Gemm g{XB, W5T, MTOK, NFF, DM}; pg8::StaticOrder S; S.init(MTOK, NFF, G, (int)blockIdx.x);
        const RinvPre rp = rinv_prepass(ss2, S, lds); pg8::EpiSwiglu E{ACT, (const LAS float*)(lds + RTAB_OFF), rp.pmA}; pg8::gemm_phase<pg8::EpiSwiglu, pg8::StaticOrder, PG8_ALIGN, PG8_SP2, RinvPre>(lds, g, S, E, rp, BPRE(5)); }
    { const BMid mid{lds, W6T, DFF, first_pn_rev(MTOK, DM, G, (int)blockIdx.x)}; SEAMX(6, mid); }
    if (IN(7)) { pg8::Gemm g{ACT, W6T, MTOK, DM, DFF}; RevOrder S; S.init_rev(MTOK, DM, G, (int)blockIdx.x);
        pg8::EpiResid<true, false> E{nullptr, XB, out, nullptr, 0.5f}; pg8::gemm_phase<pg8::EpiResid<true, false>, RevOrder, PG8_ALIGN, PG8_SP2>(lds, g, S, E, pg8::NoPre(), BPRE(6)); }
#undef IN
#undef SEAM
#undef SEAMX
#undef BPRE
}

extern "C" void kernel_launch(void* const* d_in, const int* in_sizes, int n_in, void* d_out, int out_size, void* d_ws, size_t ws_size, hipStream_t stream) {
    static int grid_blocks = 0;
    if (grid_blocks == 0) {
        if (n_in != 25 || in_sizes[0] != MTOK * DM || out_size != MTOK * DM || ws_size < WS_END) { fprintf(stderr, "kernel_launch: unexpected shapes (n_in %d, ws %zu)\n", n_in, ws_size); grid_blocks = -1; return; }
        int dev = 0, cus = 0, per_cu = 0;
        if (hipGetDevice(&dev) != hipSuccess || hipDeviceGetAttribute(&cus, hipDeviceAttributeMultiprocessorCount, dev) != hipSuccess) { grid_blocks = -1; return; }
        if (hipFuncSetAttribute((const void*)mk_fwd, hipFuncAttributeMaxDynamicSharedMemorySize, LDS_BYTES) != hipSuccess) { fprintf(stderr, "kernel_launch: hipFuncSetAttribute failed\n"); grid_blocks = -1; return; }
        if (hipOccupancyMaxActiveBlocksPerMultiprocessor(&per_cu, (const void*)mk_fwd, NTHREADS, LDS_BYTES) != hipSuccess || per_cu < 1) { fprintf(stderr, "kernel_launch: occupancy query says %d blocks/CU\n", per_cu); grid_blocks = -1; return; }
        if (cus != 256) { fprintf(stderr, "kernel_launch: built for a 256-CU device (MI355X), found %d CUs; nothing launched\n", cus); grid_blocks = -1; return; }
        grid_blocks = 256;
    }
    if (grid_blocks < 0) return;
    if (hipMemsetAsync((char*)d_ws + WS_CTL, 0, CTL_ZERO_BYTES, stream) != hipSuccess) { fprintf(stderr, "kernel_launch: hipMemsetAsync failed\n"); return; }
    Args a{};
    for (int i = 0; i < 25; ++i) a.in[i] = (const float*)d_in[i];
    a.out = (float*)d_out; a.ws = (unsigned char*)d_ws;
    for (int j = 0; j < 8; ++j) a.invf[j] = (float)pow(500000.0, -(double)j / 8.0);
    a.ph_lo = 0; a.ph_hi = 8;
    void* args[] = {&a};
    hipError_t e = hipLaunchCooperativeKernel((const void*)mk_fwd, dim3(grid_blocks), dim3(NTHREADS), args, LDS_BYTES, stream);
    if (e != hipSuccess) fprintf(stderr, "cooperative launch failed: %s (grid %d)\n", hipGetErrorString(e), grid_blocks);
}
```

```cpp
#include <hip/hip_runtime.h>
#include <hip/hip_cooperative_groups.h>
#include <cstdio>
#include <cstdint>
#include <cmath>
namespace cg = cooperative_groups;

constexpr int DM = 1024, BATCH = 16, SEQ = 2048, MTOK = BATCH * SEQ;
constexpr int DFF = 2816, NFF = 2 * DFF, DATTN = 512, DRNN = 512, NPROJ = 2560;
constexpr int PQ = DFF;
constexpr float EPS = 1e-6f;
constexpr float LAMBDA_INIT = 0.2f;

typedef unsigned short bf16;
#define LAS __attribute__((address_space(3)))
typedef unsigned v4u __attribute__((ext_vector_type(4)));
typedef float v4f __attribute__((ext_vector_type(4)));

__device__ __forceinline__ unsigned f2bf(float f) { unsigned u = __builtin_bit_cast(unsigned, f); return (u + 0x7fffu + ((u >> 16) & 1u)) >> 16; }
typedef float f32x2_h __attribute__((ext_vector_type(2))); typedef __bf16 bf16x2_h __attribute__((ext_vector_type(2)));
__device__ __forceinline__ unsigned pk2(float lo, float hi) { const f32x2_h v = {lo, hi}; return __builtin_bit_cast(unsigned, __builtin_convertvector(v, bf16x2_h)); }
__device__ __forceinline__ float bf2f(bf16 h) { return __builtin_bit_cast(float, (unsigned)h << 16); }
__device__ __forceinline__ float wave_sum(float v) {
#pragma unroll
    for (int o = 1; o < 64; o <<= 1) v += __shfl_xor(v, o);
    return v;
}
__device__ __forceinline__ float rinv_of(const float* ss, size_t row) {
    const v4f* p = (const v4f*)(ss + row * 16); const v4f a = p[0], b = p[1], c = p[2], d = p[3];
    const float s = ((a.x + a.y) + (a.z + a.w)) + ((b.x + b.y) + (b.z + b.w)) + ((c.x + c.y) + (c.z + c.w)) + ((d.x + d.y) + (d.z + d.w));
    return 1.0f / sqrtf(s * (1.0f / DM) + EPS);
}

__device__ __forceinline__ float rinv_fq(const float* ss, size_t row, int fq) {
    const v4f a = *(const v4f*)(ss + row * 16 + 4 * fq); float s = (a.x + a.y) + (a.z + a.w);
    s += __shfl_xor(s, 16); s += __shfl_xor(s, 32);
    return 1.0f / sqrtf(s * (1.0f / DM) + EPS);
}

constexpr size_t MiB = 1u << 20;
constexpr size_t WS_CTL = 0;
constexpr size_t WS_W1T = 1 * MiB;
constexpr size_t WS_W2T = 12 * MiB;
constexpr size_t WS_W3T = 18 * MiB;
constexpr size_t WS_W4T = 23 * MiB;
constexpr size_t WS_W5T = 25 * MiB;
constexpr size_t WS_W6T = 36 * MiB;
constexpr size_t WS_ROPE = 42 * MiB;
constexpr size_t WS_SS = 44 * MiB;
constexpr size_t WS_XB = 50 * MiB;
constexpr size_t WS_Y = 114 * MiB;
constexpr size_t WS_ACT = 178 * MiB;
constexpr size_t WS_END = 354 * MiB;

namespace pg8 {
#define PG8_LAS __attribute__((address_space(3)))
typedef unsigned short bf16_t;
typedef short bf16x8 __attribute__((ext_vector_type(8)));
typedef float f32x4 __attribute__((ext_vector_type(4)));
typedef unsigned u32x4 __attribute__((ext_vector_type(4)));
constexpr int BM = 256, BK = 64, HALF = 128, HTB = HALF * BK * 2  , STAGE_BYTES = 8 * HTB, NXCD = 8, WGM = 8;

__host__ __device__ __forceinline__ int lds_byte(int r, int c) { const int st = (r >> 4) * 2 + (c >> 5), rr = r & 15, cc = c & 31, ob = rr * 64 + cc * 2; return st * 1024 + (ob ^ (((ob >> 9) & 1) << 5)); }
__host__ __device__ __forceinline__ void stage_rc(int b, int& R, int& C) { const int st = b / 1024, sb = b % 1024, swz = sb ^ (((sb >> 9) & 1) << 5); R = (st >> 1) * 16 + swz / 64; C = (st & 1) * 32 + (swz % 64) / 2; }
__host__ __device__ __forceinline__ int perm32(int rho) { const int n = rho >> 4, i = rho & 15; return 8 * (i >> 2) + 4 * n + (i & 3); }

struct Unit { int pm, pn; };
struct Gemm { const bf16_t* A; const bf16_t* Bt; int M, N, K; };

struct StaticOrder {
    int nM, nN, nwg, G, c;
    __host__ __device__ void init(int M, int N, int G_, int c_) { nM = M / BM; nN = N / BM; nwg = nM * nN; G = G_; c = c_; }
    __host__ __device__ bool next(int i, Unit& u) const {
        const long L = (long)i * G + c; if (L >= nwg) return false;
        int wgid = (int)L; { const int q = nwg / NXCD, r = nwg % NXCD, xcd = wgid % NXCD, off = wgid / NXCD; wgid = (xcd < r ? xcd * (q + 1) : r * (q + 1) + (xcd - r) * q) + off; }
        const int nig = WGM * nN, gid = wgid / nig, fm = gid * WGM, gsz = (nM - fm) < WGM ? (nM - fm) : WGM;
        u.pm = fm + ((wgid % nig) % gsz); u.pn = (wgid % nig) / gsz; return true;
    }
    __device__ __forceinline__ void a_ready(const Unit&) const {}
    __device__ __forceinline__ void done(const Unit&) const {}
};
__device__ __forceinline__ unsigned cvt_pk_bf16(float lo, float hi) { unsigned r; asm volatile("v_cvt_pk_bf16_f32 %0, %1, %2" : "=v"(r) : "v"(lo), "v"(hi)); return r; }
struct EpiSwiglu {
    static constexpr bool PERM = true, AFTER_DRAIN = false;
    bf16_t* act; const PG8_LAS float* rtab; int pmA;
    __device__ __forceinline__ void operator()(const f32x4 (&acc)[2][2][4][2], const Unit& u, int wr, int wc, int fr, int fq) const {
        const int row0 = u.pm * BM + wr * 64 + fr, col0 = (21 - u.pn) * 128 + wc * 32 + 8 * fq;
        const PG8_LAS float* rt = rtab + (u.pm == pmA ? 0 : 256) + wr * 64 + fr;
#pragma unroll
        for (int ai = 0; ai < 2; ++ai)
#pragma unroll
            for (int m = 0; m < 4; ++m) {
                const size_t row = (size_t)(row0 + ai * HALF + m * 16); const float r = rt[ai * HALF + m * 16];
                const float nr = -1.4426950408889634f * r, r2 = r * r;
                unsigned w[4];
#pragma unroll
                for (int n = 0; n < 2; ++n) {
                    typedef float f2 __attribute__((ext_vector_type(2)));
                    const f32x4 g = acc[ai][0][m][n], uu = acc[ai][1][m][n];
                    const f2 ga = {g[0], g[1]}, gb = {g[2], g[3]}, ua = {uu[0], uu[1]}, ub = {uu[2], uu[3]};
                    const f2 ta = ga * nr, tb = gb * nr;
                    f2 ea, eb; ea.x = __builtin_amdgcn_exp2f(ta.x); ea.y = __builtin_amdgcn_exp2f(ta.y); eb.x = __builtin_amdgcn_exp2f(tb.x); eb.y = __builtin_amdgcn_exp2f(tb.y);
                    const f2 da = ea + 1.0f, db = eb + 1.0f;
                    f2 ia, ib; ia.x = __builtin_amdgcn_rcpf(da.x); ia.y = __builtin_amdgcn_rcpf(da.y); ib.x = __builtin_amdgcn_rcpf(db.x); ib.y = __builtin_amdgcn_rcpf(db.y);
                    const f2 ha = (ga * ua) * (ia * r2), hb = (gb * ub) * (ib * r2);
                    w[2 * n] = cvt_pk_bf16(ha.x, ha.y); w[2 * n + 1] = cvt_pk_bf16(hb.x, hb.y); }
                *(u32x4*)(act + row * DFF + col0) = (u32x4){w[0], w[1], w[2], w[3]};
            }
    }
};
template <bool IN_BF16, bool OUT_BF16> struct EpiResid {
    static constexpr bool PERM = true, AFTER_DRAIN = false;
    const float* xin; bf16_t* xb; float* out; float* ssout; float alpha;
    __device__ __forceinline__ void operator()(const f32x4 (&acc)[2][2][4][2], const Unit& u, int wr, int wc, int fr, int fq) const {
        const int row0 = u.pm * BM + wr * 64 + fr, col0 = u.pn * BM + wc * 32 + 8 * fq;
        u32x4 w[2][4][2];
        if (IN_BF16) {
#pragma unroll
            for (int ai = 0; ai < 2; ++ai)
#pragma unroll
                for (int m = 0; m < 4; ++m)
#pragma unroll
                    for (int bj = 0; bj < 2; ++bj) w[ai][m][bj] = *(const u32x4*)(xb + (size_t)(row0 + ai * HALF + m * 16) * DM + col0 + bj * HALF);
        }
#pragma unroll
        for (int ai = 0; ai < 2; ++ai)
#pragma unroll
            for (int m = 0; m < 4; ++m) {
                const size_t row = (size_t)(row0 + ai * HALF + m * 16); float s = 0.f;
#pragma unroll
                for (int bj = 0; bj < 2; ++bj) { const size_t p = row * DM + col0 + bj * HALF;
                    f32x4 x0, x1;
                    if (IN_BF16) { const u32x4 wv = w[ai][m][bj];
                        x0 = (f32x4){__builtin_bit_cast(float, wv[0] << 16), __builtin_bit_cast(float, wv[0] & 0xffff0000u), __builtin_bit_cast(float, wv[1] << 16), __builtin_bit_cast(float, wv[1] & 0xffff0000u)};
                        x1 = (f32x4){__builtin_bit_cast(float, wv[2] << 16), __builtin_bit_cast(float, wv[2] & 0xffff0000u), __builtin_bit_cast(float, wv[3] << 16), __builtin_bit_cast(float, wv[3] & 0xffff0000u)}; }
                    else { x0 = __builtin_nontemporal_load((const f32x4*)(xin + p)); x1 = __builtin_nontemporal_load((const f32x4*)(xin + p + 4)); }
                    const f32x4 v0 = x0 + alpha * acc[ai][bj][m][0], v1 = x1 + alpha * acc[ai][bj][m][1];
                    if (OUT_BF16) { *(u32x4*)(xb + p) = (u32x4){cvt_pk_bf16(v0[0], v0[1]), cvt_pk_bf16(v0[2], v0[3]), cvt_pk_bf16(v1[0], v1[1]), cvt_pk_bf16(v1[2], v1[3])};
                        s += ((v0[0] * v0[0] + v0[1] * v0[1]) + (v0[2] * v0[2] + v0[3] * v0[3])) + ((v1[0] * v1[0] + v1[1] * v1[1]) + (v1[2] * v1[2] + v1[3] * v1[3])); }
                    else { __builtin_nontemporal_store(v0, (f32x4*)(out + p)); __builtin_nontemporal_store(v1, (f32x4*)(out + p + 4)); } }
                if (OUT_BF16) { s += __shfl_xor(s, 16); s += __shfl_xor(s, 32); if (fq == 0) ssout[row * 16 + 4 * u.pn + wc] = s; }
            }
    }
};
struct EpiProj {
    static constexpr bool PERM = true, AFTER_DRAIN = false;
    const PG8_LAS float* rtab; int pmA; const float* tab; const float* qn; const float* kn; bf16_t* qkv; float qscale;
    __device__ __forceinline__ void operator()(const f32x4 (&acc)[2][2][4][2], const Unit& u, int wr, int wc, int fr, int fq) const {
        const int row0 = u.pm * BM + wr * 64 + fr, kind = u.pn >> 1, half = u.pn & 1;
        const PG8_LAS float* rt = rtab + (u.pm == pmA ? 0 : 256) + wr * 64 + fr;
        bf16_t* base = qkv + kind * 512;
        if (kind >= 2) {
            const int col0 = half * 256 + wc * 32 + 8 * fq;
#pragma unroll
            for (int ai = 0; ai < 2; ++ai)
#pragma unroll
                for (int m = 0; m < 4; ++m) { const size_t row = (size_t)(row0 + ai * HALF + m * 16); const float r = rt[ai * HALF + m * 16];
#pragma unroll
                    for (int bj = 0; bj < 2; ++bj) { const f32x4 v0 = acc[ai][bj][m][0] * r, v1 = acc[ai][bj][m][1] * r;
                        *(u32x4*)(base + row * PQ + col0 + bj * HALF) = (u32x4){cvt_pk_bf16(v0[0], v0[1]), cvt_pk_bf16(v0[2], v0[3]), cvt_pk_bf16(v1[0], v1[1]), cvt_pk_bf16(v1[2], v1[3])}; } }
        } else {
            const int g = 4 * half + wc; const float* gp = kind == 0 ? qn : kn; const float sc = kind == 0 ? qscale : 1.0f;
            const bool rot = fq < 2; const int d00 = rot ? 4 * fq : 8 * fq, d01 = rot ? 8 + 4 * fq : 8 * fq + 4;
            f32x4 gn[2][2];
            gn[0][0] = *(const f32x4*)(gp + d00); gn[0][1] = *(const f32x4*)(gp + d01); gn[1][0] = *(const f32x4*)(gp + 32 + 8 * fq); gn[1][1] = *(const f32x4*)(gp + 36 + 8 * fq);
#pragma unroll
            for (int ai = 0; ai < 2; ++ai)
#pragma unroll
                for (int m = 0; m < 4; ++m) { const size_t row = (size_t)(row0 + ai * HALF + m * 16); const float r = rt[ai * HALF + m * 16];
                    const f32x4 cs = *(const f32x4*)(tab + row * 16 + 4 * (fq & 1)), sn = *(const f32x4*)(tab + row * 16 + 8 + 4 * (fq & 1));
                    f32x4 v[2][2]; float s = 0.f;
#pragma unroll
                    for (int bj = 0; bj < 2; ++bj)
#pragma unroll
                        for (int n = 0; n < 2; ++n) { v[bj][n] = acc[ai][bj][m][n] * r; s += (v[bj][n][0] * v[bj][n][0] + v[bj][n][1] * v[bj][n][1]) + (v[bj][n][2] * v[bj][n][2] + v[bj][n][3] * v[bj][n][3]); }
                    s += __shfl_xor(s, 16); s += __shfl_xor(s, 32);
                    const float nrm = sc * __builtin_amdgcn_rsqf(s * (1.0f / 64.0f) + EPS);
#pragma unroll
                    for (int bj = 0; bj < 2; ++bj)
#pragma unroll
                        for (int n = 0; n < 2; ++n) v[bj][n] = v[bj][n] * nrm * gn[bj][n];
                    { const f32x4 x1 = v[0][0], x2 = v[0][1], o1 = x1 * cs - x2 * sn, o2 = x2 * cs + x1 * sn;
#pragma unroll
                      for (int e = 0; e < 4; ++e) { v[0][0][e] = rot ? o1[e] : x1[e]; v[0][1][e] = rot ? o2[e] : x2[e]; } }
                    typedef unsigned u32x2e __attribute__((ext_vector_type(2)));
                    bf16_t* orow = base + row * PQ + 64 * g;
                    *(u32x2e*)(orow + d00) = (u32x2e){cvt_pk_bf16(v[0][0][0], v[0][0][1]), cvt_pk_bf16(v[0][0][2], v[0][0][3])};
                    *(u32x2e*)(orow + d01) = (u32x2e){cvt_pk_bf16(v[0][1][0], v[0][1][1]), cvt_pk_bf16(v[0][1][2], v[0][1][3])};
                    *(u32x4*)(orow + 32 + 8 * fq) = (u32x4){cvt_pk_bf16(v[1][0][0], v[1][0][1]), cvt_pk_bf16(v[1][0][2], v[1][0][3]), cvt_pk_bf16(v[1][1][0], v[1][1][1]), cvt_pk_bf16(v[1][1][2], v[1][1][3])};
                }
        }
    }
};
struct NoPre { __device__ __forceinline__ void operator()() const {} };
__device__ __forceinline__ void stage_b_first(PG8_LAS unsigned char* lds, const bf16_t* Bt, int K, int pn) {
    const int tid = threadIdx.x, wid = __builtin_amdgcn_readfirstlane(tid >> 6);
    const size_t hstep = (size_t)HALF * K * 2; const char* cB = (const char*)Bt + (size_t)pn * 2 * hstep;
#pragma unroll
    for (int h = 0; h < 2; ++h)
#pragma unroll
        for (int i = 0; i < 2; ++i) { int R, C; stage_rc(tid * 16 + i * 8192, R, C); const int Rb = (R & ~31) + perm32(R & 31);
            __builtin_amdgcn_global_load_lds((const unsigned*)(cB + h * hstep + (size_t)(Rb * K + C) * 2u), (PG8_LAS unsigned*)(lds + (4 + h) * HTB + (unsigned)wid * 1024u + i * 8192), 16, 0, 0); }
}
template <class Epi, class Sched, bool ALIGN_EPI = false, bool SP2 = false, class Pre = NoPre>
__device__ __forceinline__ void gemm_phase(PG8_LAS unsigned char* lds, const Gemm g, const Sched& S, const Epi& E, const Pre& pre = Pre(), const bool bpre = false) {
    const int tid = threadIdx.x, wid = __builtin_amdgcn_readfirstlane(tid >> 6), lane = tid & 63, wr = wid >> 2, wc = wid & 3, fr = lane & 15, fq = lane >> 4;
    const int K = g.K, nt = K / BK;
    unsigned voffA[2], voffB[2];
#pragma unroll
    for (int i = 0; i < 2; ++i) { int R, C; stage_rc(tid * 16 + i * 8192, R, C); const int Rb = Epi::PERM ? ((R & ~31) + perm32(R & 31)) : R;
        voffA[i] = (unsigned)(R * K + C) * 2u; voffB[i] = (unsigned)(Rb * K + C) * 2u; }
    const size_t kstep = (size_t)(BK * 2);
    const size_t hstep = (size_t)HALF * K * 2;
    const size_t tstep = 2 * hstep;
    const unsigned ldsw = (unsigned)wid * 1024u;
    const int aoff = lds_byte(wr * 64 + fr, fq * 8), boff = lds_byte(wc * 32 + fr, fq * 8);
#define PG8_SA(b, h) (((b) * 2 + (h)) * HTB)
#define PG8_SB(b, h) ((4 + (b) * 2 + (h)) * HTB)
#define PG8_STAGE(bufoff, gbase, voff) do { _Pragma("unroll") for (int _i = 0; _i < 2; ++_i) \
        __builtin_amdgcn_global_load_lds((const unsigned*)((const char*)(gbase) + (voff)[_i]), (PG8_LAS unsigned*)(lds + (bufoff) + ldsw + _i * 8192), 16, 0, 0); } while (0)
#define PG8_LDA(dst, b, h) do { _Pragma("unroll") for (int m = 0; m < 4; ++m) _Pragma("unroll") for (int k = 0; k < 2; ++k) dst[m][k] = *(const PG8_LAS bf16x8*)(lds + PG8_SA(b, h) + aoff + m * 2048 + k * 1024); } while (0)
#define PG8_LDB(dst, b, h) do { _Pragma("unroll") for (int n = 0; n < 2; ++n) _Pragma("unroll") for (int k = 0; k < 2; ++k) dst[n][k] = *(const PG8_LAS bf16x8*)(lds + PG8_SB(b, h) + boff + n * 2048 + k * 1024); } while (0)
#define PG8_MMA(ai, bj, At, Bt) do { __builtin_amdgcn_s_setprio(1); _Pragma("unroll") for (int m = 0; m < 4; ++m) _Pragma("unroll") for (int n = 0; n < 2; ++n) _Pragma("unroll") for (int k = 0; k < 2; ++k) \
        acc[ai][bj][m][n] = __builtin_amdgcn_mfma_f32_16x16x32_bf16(Bt[n][k], At[m][k], acc[ai][bj][m][n], 0, 0, 0); __builtin_amdgcn_s_setprio(0); } while (0)
#define PG8_WAIT_V(n) asm volatile("s_waitcnt vmcnt(" #n ")" ::: "memory")
#define PG8_WAIT_L(n) asm volatile("s_waitcnt lgkmcnt(" #n ")" ::: "memory")
#define PG8_BAR __builtin_amdgcn_s_barrier()
#define PG8_SCHED __builtin_amdgcn_sched_barrier(0)
    Unit cur, nxt; int ui = 0;
    if (!S.next(0, cur)) return;
    f32x4 acc[2][2][4][2];
#pragma unroll
    for (int a = 0; a < 2; ++a)
#pragma unroll
        for (int b = 0; b < 2; ++b)
#pragma unroll
            for (int m = 0; m < 4; ++m)
#pragma unroll
                for (int n = 0; n < 2; ++n) acc[a][b][m][n] = (f32x4){0.f, 0.f, 0.f, 0.f};
    bf16x8 At[4][2], B0[2][2], B1[2][2];
    const char* cA = (const char*)g.A + (size_t)cur.pm * tstep; const char* cB = (const char*)g.Bt + (size_t)cur.pn * tstep;
    S.a_ready(cur);
    if constexpr (SP2) {
        if (!bpre) { PG8_STAGE(PG8_SB(0, 0), cB, voffB); PG8_STAGE(PG8_SB(0, 1), cB + hstep, voffB); }
        PG8_STAGE(PG8_SA(0, 0), cA, voffA); PG8_STAGE(PG8_SA(0, 1), cA + hstep, voffA);
        pre();
        if (wr == 1) PG8_BAR;
        PG8_WAIT_V(2); PG8_BAR;
        PG8_STAGE(PG8_SB(1, 0), cB + kstep, voffB); PG8_STAGE(PG8_SA(1, 0), cA + kstep, voffA); PG8_STAGE(PG8_SB(1, 1), cB + hstep + kstep, voffB);
        PG8_WAIT_V(6); PG8_BAR;
    } else {
        PG8_STAGE(PG8_SB(0, 0), cB, voffB); PG8_STAGE(PG8_SA(0, 0), cA, voffA); PG8_STAGE(PG8_SB(0, 1), cB + hstep, voffB); PG8_STAGE(PG8_SA(0, 1), cA + hstep, voffA);
        if (wr == 1) PG8_BAR;
        PG8_WAIT_V(4); PG8_BAR;
        PG8_STAGE(PG8_SB(1, 0), cB + kstep, voffB); PG8_STAGE(PG8_SA(1, 0), cA + kstep, voffA); PG8_STAGE(PG8_SB(1, 1), cB + hstep + kstep, voffB);
        PG8_WAIT_V(6); PG8_BAR;
    }
    for (;;) {
        const bool has_next = S.next(ui + 1, nxt);
        const char* nA = has_next ? (const char*)g.A + (size_t)nxt.pm * tstep : cA; const char* nB = has_next ? (const char*)g.Bt + (size_t)nxt.pn * tstep : cB;
        for (int t = 0; t < nt; t += 2) {
            const bool last = (t == nt - 2);
            const char* a1 = cA + (size_t)(t + 1) * kstep;
            const char* a2 = last ? nA : cA + (size_t)(t + 2) * kstep; const char* b2 = last ? nB : cB + (size_t)(t + 2) * kstep;
            const char* a3 = a2 + kstep; const char* b3 = b2 + kstep;
            if (last && has_next) S.a_ready(nxt);
            if constexpr (SP2) {
            PG8_LDB(B0, 0, 0); PG8_LDB(B1, 0, 1); PG8_SCHED; PG8_LDA(At, 0, 0); PG8_STAGE(PG8_SA(1, 1), a1 + hstep, voffA);
            PG8_WAIT_V(8); PG8_WAIT_L(0); PG8_BAR; PG8_MMA(0, 0, At, B0); PG8_MMA(0, 1, At, B1); PG8_BAR; PG8_SCHED;
            PG8_LDA(At, 0, 1); PG8_STAGE(PG8_SB(0, 0), b2, voffB); PG8_STAGE(PG8_SB(0, 1), b2 + hstep, voffB); PG8_STAGE(PG8_SA(0, 0), a2, voffA);
            PG8_WAIT_V(8); PG8_WAIT_L(0); PG8_BAR; PG8_MMA(1, 0, At, B0); PG8_MMA(1, 1, At, B1); PG8_BAR; PG8_SCHED;
            PG8_LDB(B0, 1, 0); PG8_LDB(B1, 1, 1); PG8_SCHED; PG8_LDA(At, 1, 0); PG8_STAGE(PG8_SA(0, 1), a2 + hstep, voffA);
            PG8_WAIT_V(8); PG8_WAIT_L(0); PG8_BAR; PG8_MMA(0, 0, At, B0); PG8_MMA(0, 1, At, B1); PG8_BAR; PG8_SCHED;
            PG8_LDA(At, 1, 1); PG8_STAGE(PG8_SB(1, 0), b3, voffB); PG8_STAGE(PG8_SB(1, 1), b3 + hstep, voffB); PG8_STAGE(PG8_SA(1, 0), a3, voffA);
            PG8_WAIT_V(8); PG8_WAIT_L(0); PG8_BAR; PG8_MMA(1, 0, At, B0); PG8_MMA(1, 1, At, B1); PG8_BAR; PG8_SCHED;
            } else {
            PG8_LDB(B0, 0, 0); PG8_SCHED; PG8_LDA(At, 0, 0); PG8_STAGE(PG8_SA(1, 1), a1 + hstep, voffA);
            PG8_WAIT_L(8); PG8_BAR; PG8_WAIT_L(0); PG8_MMA(0, 0, At, B0); PG8_BAR; PG8_SCHED;
            PG8_LDB(B1, 0, 1); PG8_STAGE(PG8_SB(0, 0), b2, voffB);
            PG8_BAR; PG8_WAIT_L(0); PG8_MMA(0, 1, At, B1); PG8_BAR;
            PG8_LDA(At, 0, 1); PG8_STAGE(PG8_SA(0, 0), a2, voffA);
            PG8_BAR; PG8_WAIT_L(0); PG8_MMA(1, 0, At, B0); PG8_BAR; PG8_SCHED;
            PG8_STAGE(PG8_SB(0, 1), b2 + hstep, voffB);
            PG8_WAIT_V(6); PG8_BAR; PG8_MMA(1, 1, At, B1); PG8_BAR;
            PG8_LDB(B0, 1, 0); PG8_SCHED; PG8_LDA(At, 1, 0); PG8_STAGE(PG8_SA(0, 1), a2 + hstep, voffA);
            PG8_WAIT_L(8); PG8_BAR; PG8_WAIT_L(0); PG8_MMA(0, 0, At, B0); PG8_BAR; PG8_SCHED;
            PG8_LDB(B1, 1, 1); PG8_STAGE(PG8_SB(1, 0), b3, voffB);
            PG8_BAR; PG8_WAIT_L(0); PG8_MMA(0, 1, At, B1); PG8_BAR;
            PG8_LDA(At, 1, 1); PG8_STAGE(PG8_SA(1, 0), a3, voffA);
            PG8_BAR; PG8_WAIT_L(0); PG8_MMA(1, 0, At, B0); PG8_BAR; PG8_SCHED;
            PG8_STAGE(PG8_SB(1, 1), b3 + hstep, voffB);
            PG8_WAIT_V(6); PG8_BAR; PG8_MMA(1, 1, At, B1); PG8_BAR;
            }
        }
        if constexpr (ALIGN_EPI) { if (wr == 0) PG8_BAR; }
        if constexpr (!Epi::AFTER_DRAIN) { E(acc, cur, wr, wc, fr, fq); S.done(cur); }
        if (!has_next) break;
#pragma unroll
        for (int a = 0; a < 2; ++a)
#pragma unroll
            for (int b = 0; b < 2; ++b)
#pragma unroll
                for (int m = 0; m < 4; ++m)
#pragma unroll
                    for (int n = 0; n < 2; ++n) acc[a][b][m][n] = (f32x4){0.f, 0.f, 0.f, 0.f};
        cur = nxt; cA = nA; cB = nB; ++ui;
        if constexpr (ALIGN_EPI) { if (wr == 1) PG8_BAR; }
    }
    PG8_WAIT_V(0);
    if constexpr (!ALIGN_EPI) { if (wr == 0) PG8_BAR; }
    PG8_BAR;
    if constexpr (Epi::AFTER_DRAIN) { E.fused(acc, cur, wr, wc, fr, fq, lds, wid, lane); S.done(cur); }
#undef PG8_SA
#undef PG8_SB
#undef PG8_STAGE
#undef PG8_LDA
#undef PG8_LDB
#undef PG8_MMA
#undef PG8_WAIT_V
#undef PG8_WAIT_L
#undef PG8_BAR
#undef PG8_SCHED
}
}

#ifndef ATT_PROBE
#define ATT_PROBE 0
#endif
namespace attn {
using bf16x8 = __attribute__((ext_vector_type(8))) short;
using s16x4 = __attribute__((ext_vector_type(4))) short;
using f32x16 = __attribute__((ext_vector_type(16))) float;
using u32x4 = __attribute__((ext_vector_type(4))) unsigned;
typedef short v4i16_t __attribute__((ext_vector_type(4)));
typedef __attribute__((address_space(3))) const char* lds_cptr;
constexpr int SLOTB = 32768, NSLOT = 3, LDS_WS = NSLOT * SLOTB  , LDS_X = 0  , LDS_STG = 65536  ;
__device__ __forceinline__ int crow(int r, int hi) { return (r & 3) + 8 * (r >> 2) + 4 * hi; }
__device__ __forceinline__ void glds16(const void* gsrc, unsigned lds_dst) { unsigned keep;
    asm volatile("s_mov_b32 %0, m0\n\ts_mov_b32 m0, %2\n\ts_nop 0\n\tglobal_load_lds_dwordx4 %1, off\n\ts_mov_b32 m0, %0" : "=&s"(keep) : "v"(gsrc), "s"(lds_dst) : "memory"); }
typedef float f32x2_t __attribute__((ext_vector_type(2))); typedef __bf16 bf16x2_t __attribute__((ext_vector_type(2)));
__device__ __forceinline__ unsigned cvtpk(float lo, float hi) { f32x2_t v = {lo, hi}; bf16x2_t b = __builtin_convertvector(v, bf16x2_t); return __builtin_bit_cast(unsigned, b); }
__device__ __forceinline__ s16x4 vtr(lds_cptr p) { return __builtin_bit_cast(s16x4, __builtin_amdgcn_ds_read_tr16_b64_v4i16((__attribute__((address_space(3))) v4i16_t*)p)); }
#define ATT_WAIT_BAR(N) asm volatile("s_waitcnt vmcnt(" #N ") lgkmcnt(0)\n\ts_barrier" ::: "memory")

__device__ __forceinline__ void attn_unit(int b, int h, int cc, const bf16* Q, const bf16* __restrict__ K, const bf16* __restrict__ V, bf16* Y, float lam, float negm_s, const float* subln, LAS unsigned char* lds) {
    const int tid = threadIdx.x, lane = tid & 63, r32 = lane & 31, hi = lane >> 5; const int wid = __builtin_amdgcn_readfirstlane(tid >> 6);
    const int qg = wid & 3, map = wid >> 2;
    const size_t rowbase = (size_t)b * SEQ; const int q0 = 128 * cc;
    const bf16* Qw = Q + (rowbase + q0 + 32 * qg) * PQ + h * 128 + map * 64;
    const bf16* Kh = K + rowbase * PQ + h * 128; const bf16* Vh = V + rowbase * PQ + h * 128;
    const unsigned lds0 = (unsigned)(uintptr_t)lds;
    const lds_cptr lds3 = (lds_cptr)lds;
    LAS float* wsf = (LAS float*)(lds + LDS_WS) + wid * 64;
    const int NT = 2 * cc + 2, my_nt = 2 * cc + (qg >> 1) + 1;
    const bf16* ksrc0 = Kh + (size_t)lane * PQ + wid * 8; const bf16* ksrc1 = ksrc0 + 64;
    const bf16* vsrc0 = Vh + (size_t)(16 * (wid & 3) + (lane >> 2)) * PQ + (wid >> 2) * 32 + (lane & 3) * 8; const bf16* vsrc1 = vsrc0 + 64;
    const unsigned kdst = lds0 + wid * 1024, vdst = lds0 + 16384 + wid * 1024;
#define ATT_DMA(t, slot) do { const size_t to_ = (size_t)(t) * 64 * PQ; const unsigned sl_ = (unsigned)(slot); \
        glds16(ksrc0 + to_, (unsigned)__builtin_amdgcn_readfirstlane(kdst + sl_)); glds16(ksrc1 + to_, (unsigned)__builtin_amdgcn_readfirstlane(kdst + sl_ + 8192u)); \
        glds16(vsrc0 + to_, (unsigned)__builtin_amdgcn_readfirstlane(vdst + sl_)); glds16(vsrc1 + to_, (unsigned)__builtin_amdgcn_readfirstlane(vdst + sl_ + 8192u)); } while (0)
    ATT_DMA(0, 0); ATT_DMA(1, SLOTB);
    bf16x8 qr[4];
#pragma unroll
    for (int s = 0; s < 4; ++s) qr[s] = *reinterpret_cast<const bf16x8*>(&Qw[(size_t)r32 * PQ + s * 16 + hi * 8]);
    f32x16 o[4]; o[0] = f32x16{}; o[1] = f32x16{}; o[2] = f32x16{}; o[3] = f32x16{};
    f32x16 negm; float nm_ = negm_s; asm volatile("" : "+v"(nm_));
#pragma unroll
    for (int r = 0; r < 16; ++r) negm[r] = nm_;
    asm volatile("" : "+v"(negm));
    float l_reg = 0.f;
    const lds_cptr kp0 = lds3 + map * 8192 + hi * 1024 + r32 * 16;
    const lds_cptr vp0 = lds3 + 16384 + ((lane >> 4) & 1) * 32 + (lane & 3) * 8 + (4 * hi + ((lane & 15) >> 2)) * 64;
    int slot = 0;
    __builtin_amdgcn_s_waitcnt(0x0F70);
    for (int t = 0; t < my_nt; ++t) {
        if (t + 1 < NT) { ATT_WAIT_BAR(4); } else { ATT_WAIT_BAR(0); }
        int s2 = slot + 2 * SLOTB; if (s2 >= NSLOT * SLOTB) s2 -= NSLOT * SLOTB;
        {
            const lds_cptr kp = kp0 + slot; const lds_cptr vp = vp0 + slot;
            bf16x8 kf[8];
#pragma unroll
            for (int s = 0; s < 4; ++s) { kf[2 * s] = *(const __attribute__((address_space(3))) bf16x8*)(kp + s * 2048); kf[2 * s + 1] = *(const __attribute__((address_space(3))) bf16x8*)(kp + s * 2048 + 512); }
            f32x16 p0 = __builtin_amdgcn_mfma_f32_32x32x16_bf16(kf[0], qr[0], negm, 0, 0, 0), p1 = __builtin_amdgcn_mfma_f32_32x32x16_bf16(kf[1], qr[0], negm, 0, 0, 0);
#pragma unroll
            for (int s = 1; s < 4; ++s) { p0 = __builtin_amdgcn_mfma_f32_32x32x16_bf16(kf[2 * s], qr[s], p0, 0, 0, 0); p1 = __builtin_amdgcn_mfma_f32_32x32x16_bf16(kf[2 * s + 1], qr[s], p1, 0, 0, 0); }
#define ATT_VLOAD(VF, KS) do { _Pragma("unroll") for (int db = 0; db < 4; ++db) { const s16x4 vlo = vtr(vp + db * 4096 + (KS) * 1024), vhi = vtr(vp + db * 4096 + (KS) * 1024 + 512); \
                VF[db] = (bf16x8){vlo[0], vlo[1], vlo[2], vlo[3], vhi[0], vhi[1], vhi[2], vhi[3]}; } } while (0)
#define ATT_EXPK(P, B, W) do { _Pragma("unroll") for (int r = 0; r < 8; ++r) { P[(B) + r] = __builtin_amdgcn_exp2f(P[(B) + r]); sacc += P[(B) + r]; } \
                W = (u32x4){cvtpk(P[(B)], P[(B) + 1]), cvtpk(P[(B) + 2], P[(B) + 3]), cvtpk(P[(B) + 4], P[(B) + 5]), cvtpk(P[(B) + 6], P[(B) + 7])}; } while (0)
#define ATT_PVK(VF, W) do { _Pragma("unroll") for (int db = 0; db < 4; ++db) o[db] = __builtin_amdgcn_mfma_f32_32x32x16_bf16(__builtin_bit_cast(bf16x8, W), VF[db], o[db], 0, 0, 0); } while (0)
            bf16x8 vfa[4], vfb[4]; u32x4 pwa, pwb; float sacc = 0.f;
            __builtin_amdgcn_sched_barrier(0);
            ATT_VLOAD(vfa, 0);
            if (t + 2 < NT) ATT_DMA(t + 2, s2);
            __builtin_amdgcn_sched_barrier(0);
            ATT_EXPK(p0, 0, pwa);
            ATT_VLOAD(vfb, 1); __builtin_amdgcn_sched_barrier(0);
            ATT_PVK(vfa, pwa); ATT_EXPK(p0, 8, pwb); __builtin_amdgcn_sched_barrier(0);
            ATT_VLOAD(vfa, 2); __builtin_amdgcn_sched_barrier(0);
            ATT_PVK(vfb, pwb); ATT_EXPK(p1, 0, pwa); __builtin_amdgcn_sched_barrier(0);
            ATT_VLOAD(vfb, 3); __builtin_amdgcn_sched_barrier(0);
            ATT_PVK(vfa, pwa); ATT_EXPK(p1, 8, pwb); __builtin_amdgcn_sched_barrier(0);
            ATT_PVK(vfb, pwb);
#undef ATT_VLOAD
#undef ATT_EXPK
#undef ATT_PVK
            l_reg += sacc;
        }
        slot += SLOTB; if (slot == NSLOT * SLOTB) slot = 0;
    }
    if (my_nt < NT) ATT_WAIT_BAR(0);
    int lane_e = lane; asm volatile("" : "+v"(lane_e));
    const int r32e = lane_e & 31, hie = lane_e >> 5;
    l_reg += __shfl_xor(l_reg, 32);
    const float scl = (map == 0 ? 1.0f : lam) / l_reg;
    if (hie == 0) wsf[r32e] = scl;
    asm volatile("s_waitcnt lgkmcnt(0)" ::: "memory");
    float sc[16];
#pragma unroll
    for (int r = 0; r < 16; ++r) sc[r] = wsf[crow(r, hie)];
#pragma unroll
    for (int db = 0; db < 4; ++db)
#pragma unroll
        for (int r = 0; r < 16; ++r) o[db][r] *= sc[r];
    ATT_WAIT_BAR(0);
    LAS float* xb = (LAS float*)(lds + LDS_X) + qg * 4096;
    if (map == 1) {
#pragma unroll
        for (int db = 0; db < 4; ++db)
#pragma unroll
            for (int r = 0; r < 16; ++r) xb[(db * 16 + r) * 64 + lane_e] = o[db][r];
    }
    ATT_WAIT_BAR(0);
    if (map == 0) {
        float ss[16];
#pragma unroll
        for (int r = 0; r < 16; ++r) ss[r] = 0.f;
#pragma unroll
        for (int db = 0; db < 4; ++db)
#pragma unroll
            for (int r = 0; r < 16; ++r) { o[db][r] -= xb[(db * 16 + r) * 64 + lane_e]; ss[r] += o[db][r] * o[db][r]; }
#pragma unroll
        for (int r = 0; r < 16; ++r) {
#pragma unroll
            for (int m = 1; m < 32; m <<= 1) ss[r] += __shfl_xor(ss[r], m);
            ss[r] = (1.0f - LAMBDA_INIT) / sqrtf(ss[r] * (1.0f / 128.0f) + EPS); }
        LAS bf16* stg = (LAS bf16*)(lds + LDS_STG) + qg * 4096;
#pragma unroll
        for (int db = 0; db < 4; ++db) { const float gsub = subln[32 * db + r32e];
#pragma unroll
            for (int r = 0; r < 16; ++r) stg[crow(r, hie) * 128 + 32 * db + r32e] = (bf16)f2bf(o[db][r] * ss[r] * gsub); }
        asm volatile("s_waitcnt lgkmcnt(0)" ::: "memory");
        bf16* Yw = Y + (rowbase + q0 + 32 * qg) * DM + h * 128;
#pragma unroll
        for (int i = 0; i < 8; ++i) { const int id = i * 64 + lane_e, row = id >> 4, ch = id & 15;
            const u32x4 v = *(const LAS u32x4*)(stg + row * 128 + ch * 8); *(u32x4*)(Yw + (size_t)row * DM + ch * 8) = v; }
    }
    ATT_WAIT_BAR(0);
#undef ATT_DMA
}
#undef ATT_WAIT_BAR
}

namespace rnn {
using bf16x8 = __attribute__((ext_vector_type(8))) short;
using f32x16 = __attribute__((ext_vector_type(16))) float;
typedef float f32x2_t __attribute__((ext_vector_type(2))); typedef __bf16 bf16x2_t __attribute__((ext_vector_type(2)));
typedef unsigned u32x2 __attribute__((ext_vector_type(2)));
__device__ __forceinline__ unsigned cvtpk(float lo, float hi) { f32x2_t v = {lo, hi}; bf16x2_t b = __builtin_convertvector(v, bf16x2_t); return __builtin_bit_cast(unsigned, b); }
__device__ __forceinline__ float sigm2(float z) { return __builtin_amdgcn_rcpf(1.0f + __builtin_amdgcn_exp2f(z)); }
constexpr int LDS_CW = 0  , LDS_CH = 1536  , LDS_COMP = 2048  , LDS_CIN = 6144  , LDS_W = 8192  ,
              LDS_XS = 16384  , XS_BYTES = 264 * 128;
__device__ __forceinline__ void glds16(const void* gsrc, unsigned lds_dst) { unsigned keep;
    asm volatile("s_mov_b32 %0, m0\n\ts_mov_b32 m0, %2\n\ts_nop 0\n\tglobal_load_lds_dwordx4 %1, off\n\ts_mov_b32 m0, %0" : "=&s"(keep) : "v"(gsrc), "s"(lds_dst) : "memory"); }

__device__ __forceinline__ void rnn_consts(int n, int dh, const float* conv_w, const float* conv_b, const float* w_a, const float* b_a, const float* w_x, const float* b_x, const float* a_param, LAS unsigned char* lds) {
    const int tid = threadIdx.x, lane = tid & 63, r32 = lane & 31, hi = lane >> 5; const int wid = __builtin_amdgcn_readfirstlane(tid >> 6);
    LAS float* cwl = (LAS float*)(lds + LDS_CW); LAS float* chl = (LAS float*)(lds + LDS_CH);
    if (tid < 256) cwl[tid] = conv_w[(tid >> 6) * DRNN + n * 64 + (tid & 63)]; else if (tid < 320) cwl[tid] = conv_b[n * 64 + tid - 256];
    else if (tid < 352) { const int ch = n * 64 + 32 * dh + tid - 320; chl[tid - 320] = -1.4426950408889634f * b_a[ch]; chl[32 + tid - 320] = -1.4426950408889634f * b_x[ch]; chl[64 + tid - 320] = -8.0f * 1.4426950408889634f * log1pf(expf(-a_param[ch])); }
    { const int mat = wid >> 2, s = wid & 3; const float* wsrc = mat ? w_x : w_a; bf16x8 f;
#pragma unroll
        for (int j = 0; j < 8; ++j) { const int c = 16 * s + 8 * (j >> 2) + 4 * hi + (j & 3); f[j] = (short)f2bf(-1.4426950408889634f * wsrc[(size_t)(n * 64 + c) * 64 + 32 * dh + r32]); }
        *(LAS bf16x8*)(lds + LDS_W + (wid * 64 + lane) * 16) = f; }
}

template <bool PREP> __device__ __forceinline__ void rnn_unit(int b, int n, int dh, const bf16* __restrict__ XR, const bf16* __restrict__ GATE, bf16* __restrict__ Y, const float* conv_w, const float* conv_b,
                                         const float* w_a, const float* b_a, const float* w_x, const float* b_x, const float* a_param, LAS unsigned char* lds) {
    const int tid = threadIdx.x, lane = tid & 63, r32 = lane & 31, hi = lane >> 5; const int wid = __builtin_amdgcn_readfirstlane(tid >> 6);
    LAS float* cwl = (LAS float*)(lds + LDS_CW); LAS float* chl = (LAS float*)(lds + LDS_CH); LAS float* comp = (LAS float*)(lds + LDS_COMP);
    __syncthreads();
    const size_t seq0 = (size_t)b * SEQ;
    const unsigned lds0 = (unsigned)(uintptr_t)lds;
    const bf16* xsrc = XR + ((long)seq0 - 8 + (lane >> 3)) * PQ + n * 64;
#define RNN_DMA(rd_, buf_) do { const bf16* xs_ = xsrc + (size_t)(rd_) * 256 * PQ; const unsigned db_ = lds0 + LDS_XS + (unsigned)(buf_) * XS_BYTES; \
        _Pragma("unroll") for (int j_ = 0; j_ < 4; ++j_) { const int i_ = wid + 8 * j_; const int rw_ = 8 * i_ + (lane >> 3); \
            glds16(xs_ + (size_t)(8 * i_) * PQ + 8 * ((lane & 7) ^ ((rw_ >> 1) & 7)), (unsigned)__builtin_amdgcn_readfirstlane(db_ + 1024u * i_)); } \
        if (wid == 0) { const int rw_ = 256 + (lane >> 3); glds16(xs_ + (size_t)256 * PQ + 8 * ((lane & 7) ^ ((rw_ >> 1) & 7)), (unsigned)__builtin_amdgcn_readfirstlane(db_ + 32768u)); } } while (0)
    RNN_DMA(0, 0);
    if (!PREP) rnn_consts(n, dh, conv_w, conv_b, w_a, b_a, w_x, b_x, a_param, lds);
    const LAS bf16x8* wfr = (const LAS bf16x8*)(lds + LDS_W) + lane;
    float carry1 = 0.f;
    asm volatile("s_waitcnt vmcnt(0) lgkmcnt(0)\n\ts_barrier" ::: "memory");
    if (wid == 0) *(LAS v4u*)(lds + LDS_XS + lane * 16) = (v4u){0u, 0u, 0u, 0u};
    asm volatile("s_waitcnt lgkmcnt(0)\n\ts_barrier" ::: "memory");
    for (int rd = 0; rd < SEQ / 256; ++rd) {
        const int t = 32 * (8 * rd + wid) + r32; const size_t row = seq0 + t;
        if (rd + 1 < SEQ / 256) RNN_DMA(rd + 1, (rd + 1) & 1);
        bf16x8 xf[4]; float xsel[16];
        u32x2 gv[4];
#pragma unroll
        for (int g = 0; g < 4; ++g) gv[g] = *(const u32x2*)(GATE + row * PQ + n * 64 + 32 * dh + 8 * g + 4 * hi);
        const LAS unsigned char* xsb = lds + LDS_XS + (rd & 1) * XS_BYTES + 8 * hi;
        const int rl0 = 5 + 32 * wid + r32;
#pragma unroll
        for (int s = 0; s < 4; ++s) {
            float xc[8];
#pragma unroll
            for (int hf = 0; hf < 2; ++hf) { const int c0 = 16 * s + 8 * hf + 4 * hi;
                const v4f cb = *(const LAS v4f*)(cwl + 256 + c0); float acc4[4] = {cb[0], cb[1], cb[2], cb[3]};
#pragma unroll
                for (int k = 0; k < 4; ++k) { const int rl = rl0 + k;
                    const u32x2 x2 = *(const LAS u32x2*)(xsb + (rl * 8 + ((2 * s + hf) ^ ((rl >> 1) & 7))) * 16);
                    const v4f cw = *(const LAS v4f*)(cwl + k * 64 + c0);
                    acc4[0] += cw[0] * __builtin_bit_cast(float, x2[0] << 16); acc4[1] += cw[1] * __builtin_bit_cast(float, x2[0] & 0xffff0000u);
                    acc4[2] += cw[2] * __builtin_bit_cast(float, x2[1] << 16); acc4[3] += cw[3] * __builtin_bit_cast(float, x2[1] & 0xffff0000u); }
#pragma unroll
                for (int e = 0; e < 4; ++e) xc[4 * hf + e] = acc4[e]; }
            const unsigned w0 = cvtpk(xc[0], xc[1]), w1 = cvtpk(xc[2], xc[3]), w2 = cvtpk(xc[4], xc[5]), w3 = cvtpk(xc[6], xc[7]);
            xf[s] = __builtin_bit_cast(bf16x8, (v4u){w0, w1, w2, w3});
            if (s < 2) {
#pragma unroll
                for (int j = 0; j < 8; ++j) xsel[8 * s + j] = xc[j];
            } else {
#pragma unroll
                for (int j = 0; j < 8; ++j) xsel[8 * (s - 2) + j] = dh ? xc[j] : xsel[8 * (s - 2) + j];
            }
        }
        f32x16 ga, gx; float sp[16];
#pragma unroll
        for (int g = 0; g < 4; ++g) { const v4f a4 = *(const LAS v4f*)(chl + 8 * g + 4 * hi), x4 = *(const LAS v4f*)(chl + 32 + 8 * g + 4 * hi), s4 = *(const LAS v4f*)(chl + 64 + 8 * g + 4 * hi);
#pragma unroll
            for (int e = 0; e < 4; ++e) { ga[4 * g + e] = a4[e]; gx[4 * g + e] = x4[e]; sp[4 * g + e] = s4[e]; } }
#pragma unroll
        for (int s = 0; s < 4; ++s) { ga = __builtin_amdgcn_mfma_f32_32x32x16_bf16(wfr[s * 64], xf[s], ga, 0, 0, 0); gx = __builtin_amdgcn_mfma_f32_32x32x16_bf16(wfr[(4 + s) * 64], xf[s], gx, 0, 0, 0); }
        float av[16], bv[16];
#pragma unroll
        for (int r = 0; r < 16; ++r) { const float rg = sigm2(ga[r]), ig = sigm2(gx[r]);
            const float aa = __builtin_amdgcn_exp2f(sp[r] * rg); av[r] = aa; bv[r] = __builtin_amdgcn_sqrtf(fmaxf(1.0f - aa * aa, 0.f)) * ig * xsel[r]; }
#define RNN_STEPS(CTRL) \
        "v_fmac_f32_dpp %8, %8, %0 " CTRL "\n\tv_fmac_f32_dpp %9, %9, %1 " CTRL "\n\tv_fmac_f32_dpp %10, %10, %2 " CTRL "\n\tv_fmac_f32_dpp %11, %11, %3 " CTRL "\n\t" \
        "v_fmac_f32_dpp %12, %12, %4 " CTRL "\n\tv_fmac_f32_dpp %13, %13, %5 " CTRL "\n\tv_fmac_f32_dpp %14, %14, %6 " CTRL "\n\tv_fmac_f32_dpp %15, %15, %7 " CTRL "\n\t" \
        "v_mul_f32_dpp %0, %0, %0 " CTRL "\n\tv_mul_f32_dpp %1, %1, %1 " CTRL "\n\tv_mul_f32_dpp %2, %2, %2 " CTRL "\n\tv_mul_f32_dpp %3, %3, %3 " CTRL "\n\t" \
        "v_mul_f32_dpp %4, %4, %4 " CTRL "\n\tv_mul_f32_dpp %5, %5, %5 " CTRL "\n\tv_mul_f32_dpp %6, %6, %6 " CTRL "\n\tv_mul_f32_dpp %7, %7, %7 " CTRL "\n\t"
#define RNN_SCAN8(o) asm volatile("s_nop 1\n\t" RNN_STEPS("row_shr:1 row_mask:0xf bank_mask:0xf") RNN_STEPS("row_shr:2 row_mask:0xf bank_mask:0xf") RNN_STEPS("row_shr:4 row_mask:0xf bank_mask:0xf") \
            RNN_STEPS("row_shr:8 row_mask:0xf bank_mask:0xf") RNN_STEPS("row_bcast:15 row_mask:0xa bank_mask:0xf") \
            : "+v"(av[o]), "+v"(av[o + 1]), "+v"(av[o + 2]), "+v"(av[o + 3]), "+v"(av[o + 4]), "+v"(av[o + 5]), "+v"(av[o + 6]), "+v"(av[o + 7]), \
              "+v"(bv[o]), "+v"(bv[o + 1]), "+v"(bv[o + 2]), "+v"(bv[o + 3]), "+v"(bv[o + 4]), "+v"(bv[o + 5]), "+v"(bv[o + 6]), "+v"(bv[o + 7]))
        RNN_SCAN8(0); RNN_SCAN8(8);
#undef RNN_SCAN8
#undef RNN_STEPS
        LAS float* cp = comp + (rd & 1) * 512;
        if (r32 == 31) {
#pragma unroll
            for (int g = 0; g < 4; ++g) { *(LAS v4f*)(cp + (wid * 2 + 0) * 32 + 8 * g + 4 * hi) = (v4f){av[4 * g], av[4 * g + 1], av[4 * g + 2], av[4 * g + 3]};
                *(LAS v4f*)(cp + (wid * 2 + 1) * 32 + 8 * g + 4 * hi) = (v4f){bv[4 * g], bv[4 * g + 1], bv[4 * g + 2], bv[4 * g + 3]}; }
        }
        asm volatile("s_waitcnt vmcnt(0) lgkmcnt(0)\n\ts_barrier" ::: "memory");
        float cin1 = carry1;
#pragma unroll
        for (int w = 0; w < 8; ++w) { const float A1 = cp[(w * 2 + 0) * 32 + r32], B1 = cp[(w * 2 + 1) * 32 + r32];
            cin1 = (w == wid) ? carry1 : cin1; carry1 = A1 * carry1 + B1; }
        LAS float* cib = (LAS float*)(lds + LDS_CIN) + wid * 32;
        if (hi == 0) cib[r32] = cin1;
        asm volatile("s_waitcnt lgkmcnt(0)" ::: "memory");
        float cin[16];
#pragma unroll
        for (int g = 0; g < 4; ++g) { const v4f c4 = *(const LAS v4f*)(cib + 8 * g + 4 * hi);
#pragma unroll
            for (int e = 0; e < 4; ++e) cin[4 * g + e] = c4[e]; }
#pragma unroll
        for (int g = 0; g < 4; ++g) { const int c0 = n * 64 + 32 * dh + 8 * g + 4 * hi;
            const float gt[4] = {__builtin_bit_cast(float, gv[g][0] << 16), __builtin_bit_cast(float, gv[g][0] & 0xffff0000u), __builtin_bit_cast(float, gv[g][1] << 16), __builtin_bit_cast(float, gv[g][1] & 0xffff0000u)};
            float y[4];
#pragma unroll
            for (int e = 0; e < 4; ++e) { const int r = 4 * g + e; const float h = av[r] * cin[r] + bv[r]; const float x = gt[e];
                y[e] = h * x * sigm2(x * (-2.3022081981531984f + -0.10294323958041973f * (x * x))); }
            *(u32x2*)(Y + row * DM + DATTN + c0) = (u32x2){cvtpk(y[0], y[1]), cvtpk(y[2], y[3])}; }
    }
#undef RNN_DMA
    __syncthreads();
}
}

typedef __attribute__((address_space(1))) unsigned gu32;
#define RLX_AGENT __ATOMIC_RELAXED, __HIP_MEMORY_SCOPE_AGENT
#define XB_TMO      128
#define XB_XCNT(j)  (256  + 64 * (j))
#define XB_XSUB(j)  (1280 + 64 * (j))
#define XB_XGEN(j)  (2304 + 64 * (j))
#define XB_TOP      3328
#define XB_TOPGEN   3392
#define XCD_BAR_WORDS 3456
#define XB_SPIN_CAP (1u << 18)

__device__ __forceinline__ unsigned xb_ld(unsigned* p)              { return __hip_atomic_load(p, __ATOMIC_RELAXED, __HIP_MEMORY_SCOPE_AGENT); }
__device__ __forceinline__ unsigned xb_add(unsigned* p, unsigned v) { return __hip_atomic_fetch_add(p, v, __ATOMIC_RELAXED, __HIP_MEMORY_SCOPE_AGENT); }
__device__ __forceinline__ unsigned xb_xcc_id() { return (unsigned)__builtin_amdgcn_s_getreg((3 << 11) | 20) & 0xFu; }
#define XB_SPIN(cond, bar) do { unsigned _sp = 0; while (cond) { __builtin_amdgcn_s_sleep(1); \
    if ((++_sp & 255u) == 0u) { if (xb_ld(&(bar)[XB_TMO])) break; if (_sp > XB_SPIN_CAP) { atomicAdd(&(bar)[XB_TMO], 1u); break; } } } } while (0)

struct XcdBarrier {
    unsigned* bar; unsigned x;
    volatile LAS unsigned* st;
};

__device__ __forceinline__ XcdBarrier xcd_barrier_post(unsigned* bar, volatile LAS unsigned* st) {
    XcdBarrier b; b.bar = bar; b.x = xb_xcc_id(); b.st = st;
    if (threadIdx.x == 0) (void)xb_add(&bar[XB_XCNT(b.x)], 1u);
    return b;
}
__device__ __forceinline__ void xcd_barrier_complete(unsigned* bar, unsigned x, unsigned& nloc, unsigned& nx) {
    const unsigned G = gridDim.x * gridDim.y * gridDim.z;
    unsigned sum, cnt, mine, sp = 0u;
    for (;;) {
        sum = 0u; cnt = 0u; mine = 0u;
#pragma unroll
        for (unsigned j = 0; j < 16; ++j) { const unsigned c = xb_ld(&bar[XB_XCNT(j)]); sum += c; cnt += (c > 0u) ? 1u : 0u; mine = (j == x) ? c : mine; }
        if (sum == G) break;
        __builtin_amdgcn_s_sleep(1);
        if ((++sp & 255u) == 0u) { if (xb_ld(&bar[XB_TMO])) break; if (sp > XB_SPIN_CAP) { atomicAdd(&bar[XB_TMO], 1u); break; } }
    }
    nloc = mine > 0u ? mine : 1u; nx = cnt > 0u ? cnt : 1u;
}

struct NoMid { __device__ __forceinline__ void operator()() const {} };
template <class Mid = NoMid> __device__ __forceinline__ void xcd_barrier(const XcdBarrier& b, const Mid& mid = Mid()) {
    asm volatile("s_waitcnt vmcnt(0)" ::: "memory");
    __syncthreads();
    mid();
    if (threadIdx.x == 0) {
        unsigned* bar = b.bar;
        __builtin_amdgcn_s_waitcnt(0);
        unsigned nloc = b.st[0], nx = b.st[1];
        if (nloc == 0u) { xcd_barrier_complete(bar, b.x, nloc, nx); b.st[0] = nloc; b.st[1] = nx; }
        const unsigned old = xb_add(&bar[XB_XSUB(b.x)], 1u);
        const unsigned gen = old / nloc;
        if (old + 1u == (gen + 1u) * nloc) {
            __builtin_amdgcn_fence(__ATOMIC_RELEASE, "agent");
            asm volatile("s_waitcnt vmcnt(0)" ::: "memory");
            const unsigned og = xb_add(&bar[XB_TOP], 1u);
            const unsigned tg = og / nx;
            if (og + 1u == (tg + 1u) * nx) xb_add(&bar[XB_TOPGEN], 1u);
            else XB_SPIN(xb_ld(&bar[XB_TOPGEN]) == tg, bar);
            __builtin_amdgcn_fence(__ATOMIC_ACQUIRE, "agent");
            xb_add(&bar[XB_XGEN(b.x)], 1u);
            asm volatile("s_waitcnt vmcnt(0)" ::: "memory");
        } else {
            XB_SPIN(xb_ld(&bar[XB_XGEN(b.x)]) == gen, bar);
            __builtin_amdgcn_fence(__ATOMIC_ACQUIRE, "agent");
            asm volatile("s_waitcnt vmcnt(0)" ::: "memory");
        }
    }
    __syncthreads();
}

#define XL_SUB(j)   (3520 + 64 * (j))
#define XL_GEN(j)   (4544 + 64 * (j))
#define XL_TABLE    6144
template <class Mid = NoMid> __device__ __forceinline__ void xcd_local_barrier(const XcdBarrier& b, const Mid& mid = Mid()) {
    asm volatile("s_waitcnt vmcnt(0)" ::: "memory");
    __syncthreads();
    unsigned old = 0u, nloc = 1u;
    if (threadIdx.x == 0) {
        __builtin_amdgcn_s_waitcnt(0);
        nloc = b.st[0];
        old = xb_add(&b.bar[XL_SUB(b.x)], 1u);
    }
    mid();
    if (threadIdx.x == 0) {
        unsigned* bar = b.bar;
        const unsigned gen = old / nloc;
        if (old + 1u == (gen + 1u) * nloc) xb_add(&bar[XL_GEN(b.x)], 1u);
        else XB_SPIN(xb_ld(&bar[XL_GEN(b.x)]) == gen, bar);
        __builtin_amdgcn_fence(__ATOMIC_ACQUIRE, "agent");
        asm volatile("s_waitcnt vmcnt(0)" ::: "memory");
    }
    __syncthreads();
}

#define XG_SUB(g)   (6400 + 16 * (g))
#define XG_GEN(g)   (7424 + 16 * (g))
template <class Mid = NoMid> __device__ __forceinline__ void panel_group_barrier(const XcdBarrier& b, unsigned grp, const Mid& mid = Mid()) {
    asm volatile("s_waitcnt vmcnt(0)" ::: "memory");
    __syncthreads();
    unsigned old = 0u;
    if (threadIdx.x == 0) { __builtin_amdgcn_s_waitcnt(0); old = xb_add(&b.bar[XG_SUB(grp)], 1u); }
    mid();
    if (threadIdx.x == 0) {
        unsigned* bar = b.bar;
        const unsigned gen = old >> 2;
        if ((old & 3u) == 3u) xb_add(&bar[XG_GEN(grp)], 1u);
        else XB_SPIN(xb_ld(&bar[XG_GEN(grp)]) == gen, bar);
        __builtin_amdgcn_fence(__ATOMIC_ACQUIRE, "agent");
        asm volatile("s_waitcnt vmcnt(0)" ::: "memory");
    }
    __syncthreads();
}

#define XS_SUB(s, j) (8704 + 1024 * (s) + 64 * (j))
#define XS_TOP(s)    (10752 + 128 * (s))
#define XS_FLAG(s)   (10752 + 128 * (s) + 64)
__device__ __forceinline__ void xcd_split_arrive(const XcdBarrier& b, int set) {
    asm volatile("s_waitcnt vmcnt(0)" ::: "memory");
    __syncthreads();
    if (threadIdx.x == 0) {
        unsigned* bar = b.bar;
        __builtin_amdgcn_s_waitcnt(0);
        unsigned nloc = b.st[0], nx = b.st[1];
        if (nloc == 0u) { xcd_barrier_complete(bar, b.x, nloc, nx); b.st[0] = nloc; b.st[1] = nx; }
        const unsigned old = xb_add(&bar[XS_SUB(set, b.x)], 1u);
        if (old + 1u == nloc) {
            __builtin_amdgcn_fence(__ATOMIC_RELEASE, "agent");
            asm volatile("s_waitcnt vmcnt(0)" ::: "memory");
            const unsigned og = xb_add(&bar[XS_TOP(set)], 1u);
            if (og + 1u == nx) xb_add(&bar[XS_FLAG(set)], 1u);
        }
    }
    __syncthreads();
}
__device__ __forceinline__ void xcd_split_wait(const XcdBarrier& b, int set, int who) {
    if ((int)threadIdx.x == who) {
        unsigned* bar = b.bar;
        XB_SPIN(xb_ld(&bar[XS_FLAG(set)]) == 0u, bar);
        __builtin_amdgcn_fence(__ATOMIC_ACQUIRE, "agent");
        asm volatile("s_waitcnt vmcnt(0)" ::: "memory");
    }
}

__device__ __forceinline__ int srcblk(int mode, int nb) {
    if (mode == 1) { const int t = nb >> 3, bj = (nb >> 2) & 1, jb = nb & 3; return bj * 88 + 4 * t + jb; }
    if (mode == 2) { if (nb < 32) { const int t = nb >> 3, bj = (nb >> 2) & 1, wc = nb & 3; return 8 * t + 2 * wc + bj; } return nb; }
    return nb;
}
__device__ __forceinline__ void transpose_item(const float* W, int K, int N, const float* gain, bf16* WT, int mode, LAS float* scr, int item, int lane) {
    const int nblk = N / 32, kb = item / nblk, nb = item % nblk, k0 = 64 * kb, n0d = 32 * nb, n0s = 32 * srcblk(mode, nb);
    const int k0d = (mode == 3) ? (21 - (kb >> 1)) * 128 + 64 * (kb & 1) : k0;
#pragma unroll
    for (int i = 0; i < 8; ++i) { const int kk = 8 * i + (lane >> 3), cc = 4 * (lane & 7);
        const v4f w = __builtin_nontemporal_load((const v4f*)(W + (size_t)(k0 + kk) * N + n0s + cc)); const float gk = gain ? gain[k0 + kk] : 1.0f;
        scr[kk * 33 + cc] = w.x * gk; scr[kk * 33 + cc + 1] = w.y * gk; scr[kk * 33 + cc + 2] = w.z * gk; scr[kk * 33 + cc + 3] = w.w * gk; }
    asm volatile("s_waitcnt lgkmcnt(0)" ::: "memory");
    const int c = lane & 7;
    const bool qkmap = (mode == 2) && nb < 32 && ((nb >> 2) & 1) == 0;
#pragma unroll
    for (int j = 0; j < 4; ++j) { const int n = (lane >> 3) + 8 * j; const int ncol = (qkmap && n < 16) ? 4 * (n >> 3) + 8 * ((n >> 2) & 1) + (n & 3) : n; const LAS float* s = scr + (8 * c) * 33 + ncol;
        v4u o; o.x = pk2(s[0 * 33], s[1 * 33]); o.y = pk2(s[2 * 33], s[3 * 33]); o.z = pk2(s[4 * 33], s[5 * 33]); o.w = pk2(s[6 * 33], s[7 * 33]);
        *(v4u*)(WT + (size_t)(n0d + n) * K + k0d + 8 * c) = o; }
    asm volatile("s_waitcnt lgkmcnt(0)" ::: "memory");
}
__device__ __forceinline__ void xprep_row(const float* xrow, bf16* orow, float* ssrow, int lane) {
    const v4f* xr = (const v4f*)xrow + lane;
    v4f v[4]; float s = 0.f;
#pragma unroll
    for (int j = 0; j < 4; ++j) { v[j] = __builtin_nontemporal_load(xr + 64 * j); s += (v[j].x * v[j].x + v[j].y * v[j].y) + (v[j].z * v[j].z + v[j].w * v[j].w); }
    s = wave_sum(s);
    unsigned long long* o8 = (unsigned long long*)orow + lane;
#pragma unroll
    for (int j = 0; j < 4; ++j) o8[64 * j] = (unsigned long long)pk2(v[j].x, v[j].y) | ((unsigned long long)pk2(v[j].z, v[j].w) << 32);
    if (lane < 16) ssrow[lane] = lane == 0 ? s : 0.f;
}

struct Args {
    const float* in[25]; float* out; unsigned char* ws; float invf[8]; int ph_lo, ph_hi;
};
constexpr int NWAVES = 8, NTHREADS = 512;
constexpr int RING_BYTES = 131072, MISC_OFF = RING_BYTES + 256, LDS_BYTES = 147456;
constexpr int CW_BAR = 4096;
constexpr size_t CTL_ZERO_BYTES = 65536;

__device__ __forceinline__ void p0_rows_all(const Args& a, int tid);
__device__ __forceinline__ void p0_prologue(const Args& a, LAS unsigned char* lds, int tid, int r_lo, int r_hi, bool rows_too) {
    const int lane = tid & 63, wave = tid >> 6;
    LAS float* scr = (LAS float*)(lds + wave * 16384);
    const int gw = blockIdx.x * NWAVES + wave, NGW = gridDim.x * NWAVES;
    unsigned char* ws = a.ws;
    constexpr int I1 = (DM / 64) * (NFF / 32), I2 = (DFF / 64) * (DM / 32), I3 = (DM / 64) * (NPROJ / 32), I4 = (DM / 64) * (DM / 32);
    constexpr int NIT = 2 * I1 + 2 * I2 + I3 + I4;
    for (int it = gw + r_lo * NGW, rd = r_lo; it < NIT && rd < r_hi; it += NGW, ++rd) {
        int r = it;
        if (r < I1) { transpose_item(a.in[3], DM, NFF, a.in[2], (bf16*)(ws + WS_W1T), 1, scr, r, lane); continue; } r -= I1;
        if (r < I1) { transpose_item(a.in[23], DM, NFF, a.in[22], (bf16*)(ws + WS_W5T), 1, scr, r, lane); continue; } r -= I1;
        if (r < I2) { transpose_item(a.in[4], DFF, DM, nullptr, (bf16*)(ws + WS_W2T), 3, scr, r, lane); continue; } r -= I2;
        if (r < I2) { transpose_item(a.in[24], DFF, DM, nullptr, (bf16*)(ws + WS_W6T), 3, scr, r, lane); continue; } r -= I2;
        if (r < I3) { transpose_item(a.in[6], DM, NPROJ, a.in[5], (bf16*)(ws + WS_W3T), 2, scr, r, lane); continue; } r -= I3;
        transpose_item(a.in[21], DM, DM, nullptr, (bf16*)(ws + WS_W4T), 0, scr, r, lane);
    }
    if (rows_too) p0_rows_all(a, tid);
}
__device__ __forceinline__ void p0_rows_all(const Args& a, int tid) {
    const int lane = tid & 63, wave = tid >> 6; const int gw = blockIdx.x * NWAVES + wave, NGW = gridDim.x * NWAVES; unsigned char* ws = a.ws;
    const float* x = a.in[0];
    for (int m = gw; m < MTOK; m += NGW) xprep_row(x + (size_t)m * DM, (bf16*)(ws + WS_XB) + (size_t)m * DM, (float*)(ws + WS_SS) + (size_t)m * 16, lane);
    float* tab = (float*)(ws + WS_ROPE); const int* pos = (const int*)a.in[1];
    for (int i = blockIdx.x * NTHREADS + tid; i < MTOK * 8; i += gridDim.x * NTHREADS) {
        const int row = i >> 3, j = i & 7;
        const float ang = (float)pos[row] * a.invf[j];
        tab[row * 16 + j] = (float)cos((double)ang); tab[row * 16 + 8 + j] = (float)sin((double)ang);
    }
}
__device__ __forceinline__ void p0_rows_own(const Args& a, int tid) {
    const int lane = tid & 63, wave = tid >> 6; unsigned char* ws = a.ws;
    const int xl = (int)blockIdx.x & 7, jg = ((int)blockIdx.x >> 3) & 7, m4 = (int)blockIdx.x >> 6, pA = 16 * xl + jg, pB = pA + 8;
    const float* x = a.in[0];
    for (int i = 0; i < 16; ++i) { const int r = m4 * 8 + wave + 32 * i, m = (r < 256 ? pA : pB) * 256 + (r & 255);
        xprep_row(x + (size_t)m * DM, (bf16*)(ws + WS_XB) + (size_t)m * DM, (float*)(ws + WS_SS) + (size_t)m * 16, lane); }
    float* tab = (float*)(ws + WS_ROPE); const int* pos = (const int*)a.in[1];
    for (int e = m4 * NTHREADS + tid; e < 512 * 8; e += 4 * NTHREADS) {
        const int r = e >> 3, j = e & 7, row = (r < 256 ? pA : pB) * 256 + (r & 255);
        const float ang = (float)pos[row] * a.invf[j];
        tab[row * 16 + j] = (float)cos((double)ang); tab[row * 16 + 8 + j] = (float)sin((double)ang);
    }
}

constexpr int RTAB_OFF = RING_BYTES + 1024;
struct RinvPre {
    const float* ss; int pmA, pmB; LAS float* rtab;
    __device__ __forceinline__ void operator()() const { const int tid = threadIdx.x; const size_t row = (size_t)((tid >> 8) ? pmB : pmA) * 256 + (tid & 255); rtab[tid] = rinv_of(ss, row); }
};
__device__ __forceinline__ RinvPre rinv_prepass(const float* ss, const pg8::StaticOrder& S, LAS unsigned char* lds) {
    pg8::Unit u; int n = 0; while (S.next(n, u)) ++n;
    RinvPre p{ss, 0, 0, (LAS float*)(lds + RTAB_OFF)};
    if (n == 0) return p;
    S.next(0, u); p.pmA = u.pm; S.next(n - 1, u); p.pmB = u.pm;
    return p;
}
struct RevOrder : pg8::StaticOrder {
    int n;
    __device__ void init_rev(int M, int N, int G_, int c_) { init(M, N, G_, c_); pg8::Unit u; n = 0; while (pg8::StaticOrder::next(n, u)) ++n; }
    __device__ bool next(int i, pg8::Unit& u) const { return i < n ? pg8::StaticOrder::next(n - 1 - i, u) : false; }
};
struct BMid { LAS unsigned char* lds; const bf16* Bt; int K, pn; __device__ __forceinline__ void operator()() const { pg8::stage_b_first(lds, Bt, K, pn); } };
__device__ __forceinline__ int first_pn_static(int M, int N, int G, int c) { pg8::StaticOrder S; S.init(M, N, G, c); pg8::Unit u; return S.next(0, u) ? u.pn : 0; }
__device__ __forceinline__ int first_pn_rev(int M, int N, int G, int c) { RevOrder S; S.init_rev(M, N, G, c); pg8::Unit u; return S.next(0, u) ? u.pn : 0; }
#ifndef PG8_ALIGN
#define PG8_ALIGN true
#endif
#ifndef PG8_SP2
#define PG8_SP2 true
#endif
__global__ void __launch_bounds__(NTHREADS, 2) mk_fwd(Args a) {
    extern __shared__ __attribute__((aligned(16))) unsigned char lds_raw[];
    cg::grid_group grid = cg::this_grid();
    LAS unsigned char* lds = (LAS unsigned char*)lds_raw;
    const int tid = threadIdx.x;
    unsigned char* ws = a.ws;
    const int lo = a.ph_lo, hi = a.ph_hi, G = gridDim.x;
    bf16 *W1T = (bf16*)(ws + WS_W1T), *W2T = (bf16*)(ws + WS_W2T), *W3T = (bf16*)(ws + WS_W3T), *W4T = (bf16*)(ws + WS_W4T), *W5T = (bf16*)(ws + WS_W5T), *W6T = (bf16*)(ws + WS_W6T);
    float* tab = (float*)(ws + WS_ROPE); float* ss0 = (float*)(ws + WS_SS); float* ss1 = ss0 + (size_t)MTOK * 16; float* ss2 = ss1 + (size_t)MTOK * 16;
    bf16 *XB = (bf16*)(ws + WS_XB), *Y = (bf16*)(ws + WS_Y), *ACT = (bf16*)(ws + WS_ACT);
    bf16 *Qb = ACT, *Kb = ACT + 512, *Vb = ACT + 1024, *XR = ACT + 1536, *GATE = ACT + 2048;
    float* out = a.out;
#ifndef PROBE_DUP
#define PROBE_DUP -1
#endif
#define REP(k) for (int rep_ = 0; rep_ < ((PROBE_DUP) == (k) ? 2 : 1); ++rep_)
#define REPSYNC() do { if (rep_) xcd_barrier(bar); } while (0)
#define IN(k) (lo <= (k) && (k) < hi)
    volatile LAS unsigned* MISC = (volatile LAS unsigned*)(lds + MISC_OFF);
    if (tid < 16) MISC[tid] = 0u;
    __syncthreads();
    XcdBarrier bar = xcd_barrier_post((unsigned*)(ws + WS_CTL) + CW_BAR, MISC + 8);
    if (tid == 0) __hip_atomic_store((unsigned*)(ws + WS_CTL) + CW_BAR + XL_TABLE + blockIdx.x, bar.x + 1u, __ATOMIC_RELAXED, __HIP_MEMORY_SCOPE_AGENT);
    const unsigned pgrp = ((unsigned)blockIdx.x & 7u) * 8u + (((unsigned)blockIdx.x >> 3) & 7u);
    bool split_b = false;
    bool local_ok = false;
#ifndef MK_LOCAL_SEAMS
#define MK_LOCAL_SEAMS 1
#endif
#ifndef MK_GROUP_SEAMS
#define MK_GROUP_SEAMS 1
#endif
#ifndef MK_CG_SEAM0
#define MK_CG_SEAM0 0
#endif
#define SEAMX(k, MID) do { if (IN(k) && IN((k) + 1)) { if (MK_CG_SEAM0 && (k) == 0) grid.sync(); else if (MK_LOCAL_SEAMS && local_ok && MK_GROUP_SEAMS && ((k) == 1 || (k) == 2 || (k) == 5 || (k) == 6)) panel_group_barrier(bar, pgrp, MID); else if (MK_LOCAL_SEAMS && local_ok && (k) >= 1) xcd_local_barrier(bar, MID); else xcd_barrier(bar, MID); } } while (0)
#define SEAM(k) SEAMX(k, NoMid())
#define BPRE(k) (IN(k) && IN((k) + 1) && !(MK_CG_SEAM0 && (k) == 0))

    const BMid mid1{lds, W1T, DM, first_pn_static(MTOK, NFF, G, (int)blockIdx.x)};
    if (G == 256 && lo == 0 && hi > 2 && !MK_CG_SEAM0) {
        p0_prologue(a, lds, tid, 0, 2, false);
        xcd_split_arrive(bar, 0);
        p0_rows_own(a, tid);
        p0_prologue(a, lds, tid, 2, 1 << 20, false);
        xcd_split_arrive(bar, 1);
        xcd_split_wait(bar, 0, 0);
        __syncthreads();
        if (MK_LOCAL_SEAMS) {
            const unsigned* tblx = (const unsigned*)(ws + WS_CTL) + CW_BAR + XL_TABLE;
            bool okt = true;
            if (tid < 256) { const unsigned mine = __hip_atomic_load(tblx + tid, __ATOMIC_RELAXED, __HIP_MEMORY_SCOPE_AGENT), lead = __hip_atomic_load(tblx + (tid & 7), __ATOMIC_RELAXED, __HIP_MEMORY_SCOPE_AGENT); okt = (mine == lead) && mine != 0u;
                if (tid < 8) { for (int j = 0; j < 8; ++j) if (j != tid && __hip_atomic_load(tblx + j, __ATOMIC_RELAXED, __HIP_MEMORY_SCOPE_AGENT) == mine) okt = false; } }
            local_ok = __syncthreads_and(okt ? 1 : 0) != 0;
        }
        if (MK_LOCAL_SEAMS && local_ok && MK_GROUP_SEAMS) panel_group_barrier(bar, pgrp, mid1); else xcd_barrier(bar, mid1);
        split_b = true;
    } else {
        if (IN(0)) { p0_prologue(a, lds, tid, 0, 1 << 20, true); }
        SEAMX(0, mid1);
    }
#ifdef PROBE_SYNCS
    for (int i_ = 0; i_ < PROBE_SYNCS; ++i_) xcd_barrier(bar);
#endif
    if (IN(1)) REP(1) { REPSYNC(); pg8::Gemm g{XB, W1T, MTOK, NFF, DM}; pg8::StaticOrder S; S.init(MTOK, NFF, G, (int)blockIdx.x);
        const RinvPre rp = rinv_prepass(ss0, S, lds); pg8::EpiSwiglu E{ACT, (const LAS float*)(lds + RTAB_OFF), rp.pmA}; pg8::gemm_phase<pg8::EpiSwiglu, pg8::StaticOrder, PG8_ALIGN, PG8_SP2, RinvPre>(lds, g, S, E, rp, BPRE(0)); }
    if (split_b) xcd_split_wait(bar, 1, 64);
    { const BMid mid{lds, W2T, DFF, first_pn_rev(MTOK, DM, G, (int)blockIdx.x)}; SEAMX(1, mid); }
    if (IN(2)) REP(2) { REPSYNC(); pg8::Gemm g{ACT, W2T, MTOK, DM, DFF}; RevOrder S; S.init_rev(MTOK, DM, G, (int)blockIdx.x);
        pg8::EpiResid<true, true> E{nullptr, XB, nullptr, ss1, 0.5f}; pg8::gemm_phase<pg8::EpiResid<true, true>, RevOrder, PG8_ALIGN, PG8_SP2>(lds, g, S, E, pg8::NoPre(), BPRE(1)); }
    { const BMid mid{lds, W3T, DM, first_pn_static(MTOK, NPROJ, G, (int)blockIdx.x)}; SEAMX(2, mid); }
    if (IN(3)) REP(3) { REPSYNC(); pg8::Gemm g{XB, W3T, MTOK, NPROJ, DM}; pg8::StaticOrder S; S.init(MTOK, NPROJ, G, (int)blockIdx.x);
        const RinvPre rp = rinv_prepass(ss1, S, lds); pg8::EpiProj E{(const LAS float*)(lds + RTAB_OFF), rp.pmA, tab, a.in[7], a.in[8], Qb, 0.125f * 1.4426950408889634f}; pg8::gemm_phase<pg8::EpiProj, pg8::StaticOrder, PG8_ALIGN, PG8_SP2, RinvPre>(lds, g, S, E, rp, BPRE(2)); }
    if (IN(3) && IN(4)) {
        const int vcu0 = (G % 8 == 0) ? ((int)blockIdx.x % 8) * (G / 8) + (int)blockIdx.x / 8 : (int)blockIdx.x;
        if (vcu0 < BATCH * 16) rnn::rnn_consts((vcu0 >> 1) & 7, vcu0 & 1, a.in[14], a.in[15], a.in[16], a.in[17], a.in[18], a.in[19], a.in[20], lds);
        const int l64 = tid & 63;
        float d1 = a.in[9][l64] * a.in[10][l64], d2 = a.in[11][l64] * a.in[12][l64], gq = fabsf(a.in[7][l64]), gk = fabsf(a.in[8][l64]);
        d1 = wave_sum(d1); d2 = wave_sum(d2);
#pragma unroll
        for (int o_ = 1; o_ < 64; o_ <<= 1) { gq = fmaxf(gq, __shfl_xor(gq, o_)); gk = fmaxf(gk, __shfl_xor(gk, o_)); }
        if (tid == 0) { MISC[4] = __float_as_uint(expf(d1) - expf(d2) + LAMBDA_INIT); MISC[5] = __float_as_uint(-8.0f * gq * gk * 1.4426950408889634f); }
    }
    SEAM(3);
    if (IN(4)) {
        const int vcu = (G % 8 == 0) ? ((int)blockIdx.x % 8) * (G / 8) + (int)blockIdx.x / 8 : (int)blockIdx.x;
        if (lo > 3) { for (int u = vcu; u < BATCH * 16; u += G) rnn::rnn_unit<false>(u >> 4, (u >> 1) & 7, u & 1, XR, GATE, Y, a.in[14], a.in[15], a.in[16], a.in[17], a.in[18], a.in[19], a.in[20], lds);
            if (tid == 0) { MISC[4] = 0x7fc00000u; MISC[5] = 0x7fc00000u; } __syncthreads(); }
        else { if (vcu < BATCH * 16) rnn::rnn_unit<true>(vcu >> 4, (vcu >> 1) & 7, vcu & 1, XR, GATE, Y, a.in[14], a.in[15], a.in[16], a.in[17], a.in[18], a.in[19], a.in[20], lds);
            for (int u = vcu + G; u < BATCH * 16; u += G) rnn::rnn_unit<false>(u >> 4, (u >> 1) & 7, u & 1, XR, GATE, Y, a.in[14], a.in[15], a.in[16], a.in[17], a.in[18], a.in[19], a.in[20], lds); }
        const float lam = __uint_as_float(MISC[4]), negm_s = __uint_as_float(MISC[5]);
        REP(42) for (int v = vcu; v < 256; v += G) {
            const int bh = v >> 2, s = v & 3;
            for (int i = 0; i < 4; ++i) { const int cc = (i == 0) ? s : (i == 1) ? 7 - s : (i == 2) ? 8 + s : 15 - s;
                attn::attn_unit(bh >> 2, bh & 3, cc, Qb, Kb, Vb, Y, lam, negm_s, a.in[13], lds); }
        }
        __syncthreads();
    }
    { const BMid mid{lds, W4T, DM, first_pn_static(MTOK, DM, G, (int)blockIdx.x)}; SEAMX(4, mid); }
    if (IN(5)) { pg8::Gemm g{Y, W4T, MTOK, DM, DM}; pg8::StaticOrder S; S.init(MTOK, DM, G, (int)blockIdx.x);
        pg8::EpiResid<true, true> E{nullptr, XB, nullptr, ss2, 1.0f}; pg8::gemm_phase<pg8::EpiResid<true, true>, pg8::StaticOrder, PG8_ALIGN, PG8_SP2>(lds, g, S, E, pg8::NoPre(), BPRE(4)); }
    { const BMid mid{lds, W5T, DM, first_pn_static(MTOK, NFF, G, (int)blockIdx.x)}; SEAMX(5, mid); }
    if (IN(6)) REP(6) { REPSYNC(); pg8::Gemm g{XB, W5T, MTOK, NFF, DM}; pg8::StaticOrder S; S.init(MTOK, NFF, G, (int)blockIdx.x);
        const RinvPre rp = rinv_prepass(ss2, S, lds); pg8::EpiSwiglu E{ACT, (const LAS float*)(lds + RTAB_OFF), rp.pmA}; pg8::gemm_phase<pg8::EpiSwiglu, pg8::StaticOrder, PG8_ALIGN, PG8_SP2, RinvPre>(lds, g, S, E, rp, BPRE(5)); }
    { const BMid mid{lds, W6T, DFF, first_pn_rev(MTOK, DM, G, (int)blockIdx.x)}; SEAMX(6, mid); }
    if (IN(7)) { pg8::Gemm g{ACT, W6T, MTOK, DM, DFF}; RevOrder S; S.init_rev(MTOK, DM, G, (int)blockIdx.x);
        pg8::EpiResid<true, false> E{nullptr, XB, out, nullptr, 0.5f}; pg8::gemm_phase<pg8::EpiResid<true, false>, RevOrder, PG8_ALIGN, PG8_SP2>(lds, g, S, E, pg8::NoPre(), BPRE(6)); }
#undef IN
#undef SEAM
#undef SEAMX
#undef BPRE
}

extern "C" void kernel_launch(void* const* d_in, const int* in_sizes, int n_in, void* d_out, int out_size, void* d_ws, size_t ws_size, hipStream_t stream) {
    static int grid_blocks = 0;
    if (grid_blocks == 0) {
        if (n_in != 25 || in_sizes[0] != MTOK * DM || out_size != MTOK * DM || ws_size < WS_END) { fprintf(stderr, "kernel_launch: unexpected shapes (n_in %d, ws %zu)\n", n_in, ws_size); grid_blocks = -1; return; }
        int dev = 0, cus = 0, per_cu = 0;
        if (hipGetDevice(&dev) != hipSuccess || hipDeviceGetAttribute(&cus, hipDeviceAttributeMultiprocessorCount, dev) != hipSuccess) { grid_blocks = -1; return; }
        if (hipFuncSetAttribute((const void*)mk_fwd, hipFuncAttributeMaxDynamicSharedMemorySize, LDS_BYTES) != hipSuccess) { fprintf(stderr, "kernel_launch: hipFuncSetAttribute failed\n"); grid_blocks = -1; return; }
        if (hipOccupancyMaxActiveBlocksPerMultiprocessor(&per_cu, (const void*)mk_fwd, NTHREADS, LDS_BYTES) != hipSuccess || per_cu < 1) { fprintf(stderr, "kernel_launch: occupancy query says %d blocks/CU\n", per_cu); grid_blocks = -1; return; }
        if (cus != 256) { fprintf(stderr, "kernel_launch: built for a 256-CU device (MI355X), found %d CUs; nothing launched\n", cus); grid_blocks = -1; return; }
        grid_blocks = 256;
    }
    if (grid_blocks < 0) return;
    if (hipMemsetAsync((char*)d_ws + WS_CTL, 0, CTL_ZERO_BYTES, stream) != hipSuccess) { fprintf(stderr, "kernel_launch: hipMemsetAsync failed\n"); return; }
    Args a{};
    for (int i = 0; i < 25; ++i) a.in[i] = (const float*)d_in[i];
    a.out = (float*)d_out; a.ws = (unsigned char*)d_ws;
    for (int j = 0; j < 8; ++j) a.invf[j] = (float)pow(500000.0, -(double)j / 8.0);
    a.ph_lo = 0; a.ph_hi = 8;
    void* args[] = {&a};
    hipError_t e = hipLaunchCooperativeKernel((const void*)mk_fwd, dim3(grid_blocks), dim3(NTHREADS), args, LDS_BYTES, stream);
    if (e != hipSuccess) fprintf(stderr, "cooperative launch failed: %s (grid %d)\n", hipGetErrorString(e), grid_blocks);
}
```

```cpp
#include <hip/hip_runtime.h>
#include <hip/hip_cooperative_groups.h>
#include <cstdio>
#include <cstdint>
#include <cmath>
namespace cg = cooperative_groups;

constexpr int DM = 1024, BATCH = 16, SEQ = 2048, MTOK = BATCH * SEQ;
constexpr int DFF = 2816, NFF = 2 * DFF, DATTN = 512, DRNN = 512, NPROJ = 2560;
constexpr int PQ = DFF;
constexpr float EPS = 1e-6f;
constexpr float LAMBDA_INIT = 0.2f;

typedef unsigned short bf16;
#define LAS __attribute__((address_space(3)))
typedef unsigned v4u __attribute__((ext_vector_type(4)));
typedef float v4f __attribute__((ext_vector_type(4)));

__device__ __forceinline__ unsigned f2bf(float f) { unsigned u = __builtin_bit_cast(unsigned, f); return (u + 0x7fffu + ((u >> 16) & 1u)) >> 16; }
typedef float f32x2_h __attribute__((ext_vector_type(2))); typedef __bf16 bf16x2_h __attribute__((ext_vector_type(2)));
__device__ __forceinline__ unsigned pk2(float lo, float hi) { const f32x2_h v = {lo, hi}; return __builtin_bit_cast(unsigned, __builtin_convertvector(v, bf16x2_h)); }
__device__ __forceinline__ float bf2f(bf16 h) { return __builtin_bit_cast(float, (unsigned)h << 16); }
__device__ __forceinline__ float wave_sum(float v) {
#pragma unroll
    for (int o = 1; o < 64; o <<= 1) v += __shfl_xor(v, o);
    return v;
}
__device__ __forceinline__ float rinv_of(const float* ss, size_t row) {
    const v4f* p = (const v4f*)(ss + row * 16); const v4f a = p[0], b = p[1], c = p[2], d = p[3];
    const float s = ((a.x + a.y) + (a.z + a.w)) + ((b.x + b.y) + (b.z + b.w)) + ((c.x + c.y) + (c.z + c.w)) + ((d.x + d.y) + (d.z + d.w));
    return 1.0f / sqrtf(s * (1.0f / DM) + EPS);
}

__device__ __forceinline__ float rinv_fq(const float* ss, size_t row, int fq) {
    const v4f a = *(const v4f*)(ss + row * 16 + 4 * fq); float s = (a.x + a.y) + (a.z + a.w);
    s += __shfl_xor(s, 16); s += __shfl_xor(s, 32);
    return 1.0f / sqrtf(s * (1.0f / DM) + EPS);
}

constexpr size_t MiB = 1u << 20;
constexpr size_t WS_CTL = 0;
constexpr size_t WS_W1T = 1 * MiB;
constexpr size_t WS_W2T = 12 * MiB;
constexpr size_t WS_W3T = 18 * MiB;
constexpr size_t WS_W4T = 23 * MiB;
constexpr size_t WS_W5T = 25 * MiB;
constexpr size_t WS_W6T = 36 * MiB;
constexpr size_t WS_ROPE = 42 * MiB;
constexpr size_t WS_SS = 44 * MiB;
constexpr size_t WS_XB = 50 * MiB;
constexpr size_t WS_Y = 114 * MiB;
constexpr size_t WS_ACT = 178 * MiB;
constexpr size_t WS_END = 354 * MiB;

namespace pg8 {
#define PG8_LAS __attribute__((address_space(3)))
typedef unsigned short bf16_t;
typedef short bf16x8 __attribute__((ext_vector_type(8)));
typedef float f32x4 __attribute__((ext_vector_type(4)));
typedef unsigned u32x4 __attribute__((ext_vector_type(4)));
constexpr int BM = 256, BK = 64, HALF = 128, HTB = HALF * BK * 2  , STAGE_BYTES = 8 * HTB, NXCD = 8, WGM = 8;

__host__ __device__ __forceinline__ int lds_byte(int r, int c) { const int st = (r >> 4) * 2 + (c >> 5), rr = r & 15, cc = c & 31, ob = rr * 64 + cc * 2; return st * 1024 + (ob ^ (((ob >> 9) & 1) << 5)); }
__host__ __device__ __forceinline__ void stage_rc(int b, int& R, int& C) { const int st = b / 1024, sb = b % 1024, swz = sb ^ (((sb >> 9) & 1) << 5); R = (st >> 1) * 16 + swz / 64; C = (st & 1) * 32 + (swz % 64) / 2; }
__host__ __device__ __forceinline__ int perm32(int rho) { const int n = rho >> 4, i = rho & 15; return 8 * (i >> 2) + 4 * n + (i & 3); }

struct Unit { int pm, pn; };
struct Gemm { const bf16_t* A; const bf16_t* Bt; int M, N, K; };

struct StaticOrder {
    int nM, nN, nwg, G, c;
    __host__ __device__ void init(int M, int N, int G_, int c_) { nM = M / BM; nN = N / BM; nwg = nM * nN; G = G_; c = c_; }
    __host__ __device__ bool next(int i, Unit& u) const {
        const long L = (long)i * G + c; if (L >= nwg) return false;
        int wgid = (int)L; { const int q = nwg / NXCD, r = nwg % NXCD, xcd = wgid % NXCD, off = wgid / NXCD; wgid = (xcd < r ? xcd * (q + 1) : r * (q + 1) + (xcd - r) * q) + off; }
        const int nig = WGM * nN, gid = wgid / nig, fm = gid * WGM, gsz = (nM - fm) < WGM ? (nM - fm) : WGM;
        u.pm = fm + ((wgid % nig) % gsz); u.pn = (wgid % nig) / gsz; return true;
    }
    __device__ __forceinline__ void a_ready(const Unit&) const {}
    __device__ __forceinline__ void done(const Unit&) const {}
};
__device__ __forceinline__ unsigned cvt_pk_bf16(float lo, float hi) { unsigned r; asm volatile("v_cvt_pk_bf16_f32 %0, %1, %2" : "=v"(r) : "v"(lo), "v"(hi)); return r; }
struct EpiSwiglu {
    static constexpr bool PERM = true, AFTER_DRAIN = false;
    bf16_t* act; const PG8_LAS float* rtab; int pmA;
    __device__ __forceinline__ void operator()(const f32x4 (&acc)[2][2][4][2], const Unit& u, int wr, int wc, int fr, int fq) const {
        const int row0 = u.pm * BM + wr * 64 + fr, col0 = (21 - u.pn) * 128 + wc * 32 + 8 * fq;
        const PG8_LAS float* rt = rtab + (u.pm == pmA ? 0 : 256) + wr * 64 + fr;
#pragma unroll
        for (int ai = 0; ai < 2; ++ai)
#pragma unroll
            for (int m = 0; m < 4; ++m) {
                const size_t row = (size_t)(row0 + ai * HALF + m * 16); const float r = rt[ai * HALF + m * 16];
                const float nr = -1.4426950408889634f * r, r2 = r * r;
                unsigned w[4];
#pragma unroll
                for (int n = 0; n < 2; ++n) {
                    typedef float f2 __attribute__((ext_vector_type(2)));
                    const f32x4 g = acc[ai][0][m][n], uu = acc[ai][1][m][n];
                    const f2 ga = {g[0], g[1]}, gb = {g[2], g[3]}, ua = {uu[0], uu[1]}, ub = {uu[2], uu[3]};
                    const f2 ta = ga * nr, tb = gb * nr;
                    f2 ea, eb; ea.x = __builtin_amdgcn_exp2f(ta.x); ea.y = __builtin_amdgcn_exp2f(ta.y); eb.x = __builtin_amdgcn_exp2f(tb.x); eb.y = __builtin_amdgcn_exp2f(tb.y);
                    const f2 da = ea + 1.0f, db = eb + 1.0f;
                    f2 ia, ib; ia.x = __builtin_amdgcn_rcpf(da.x); ia.y = __builtin_amdgcn_rcpf(da.y); ib.x = __builtin_amdgcn_rcpf(db.x); ib.y = __builtin_amdgcn_rcpf(db.y);
                    const f2 ha = (ga * ua) * (ia * r2), hb = (gb * ub) * (ib * r2);
                    w[2 * n] = cvt_pk_bf16(ha.x, ha.y); w[2 * n + 1] = cvt_pk_bf16(hb.x, hb.y); }
                *(u32x4*)(act + row * DFF + col0) = (u32x4){w[0], w[1], w[2], w[3]};
            }
    }
};
template <bool IN_BF16, bool OUT_BF16> struct EpiResid {
    static constexpr bool PERM = true, AFTER_DRAIN = false;
    const float* xin; bf16_t* xb; float* out; float* ssout; float alpha;
    __device__ __forceinline__ void operator()(const f32x4 (&acc)[2][2][4][2], const Unit& u, int wr, int wc, int fr, int fq) const {
        const int row0 = u.pm * BM + wr * 64 + fr, col0 = u.pn * BM + wc * 32 + 8 * fq;
        u32x4 w[2][4][2];
        if (IN_BF16) {
#pragma unroll
            for (int ai = 0; ai < 2; ++ai)
#pragma unroll
                for (int m = 0; m < 4; ++m)
#pragma unroll
                    for (int bj = 0; bj < 2; ++bj) w[ai][m][bj] = *(const u32x4*)(xb + (size_t)(row0 + ai * HALF + m * 16) * DM + col0 + bj * HALF);
        }
#pragma unroll
        for (int ai = 0; ai < 2; ++ai)
#pragma unroll
            for (int m = 0; m < 4; ++m) {
                const size_t row = (size_t)(row0 + ai * HALF + m * 16); float s = 0.f;
#pragma unroll
                for (int bj = 0; bj < 2; ++bj) { const size_t p = row * DM + col0 + bj * HALF;
                    f32x4 x0, x1;
                    if (IN_BF16) { const u32x4 wv = w[ai][m][bj];
                        x0 = (f32x4){__builtin_bit_cast(float, wv[0] << 16), __builtin_bit_cast(float, wv[0] & 0xffff0000u), __builtin_bit_cast(float, wv[1] << 16), __builtin_bit_cast(float, wv[1] & 0xffff0000u)};
                        x1 = (f32x4){__builtin_bit_cast(float, wv[2] << 16), __builtin_bit_cast(float, wv[2] & 0xffff0000u), __builtin_bit_cast(float, wv[3] << 16), __builtin_bit_cast(float, wv[3] & 0xffff0000u)}; }
                    else { x0 = __builtin_nontemporal_load((const f32x4*)(xin + p)); x1 = __builtin_nontemporal_load((const f32x4*)(xin + p + 4)); }
                    const f32x4 v0 = x0 + alpha * acc[ai][bj][m][0], v1 = x1 + alpha * acc[ai][bj][m][1];
                    if (OUT_BF16) { *(u32x4*)(xb + p) = (u32x4){cvt_pk_bf16(v0[0], v0[1]), cvt_pk_bf16(v0[2], v0[3]), cvt_pk_bf16(v1[0], v1[1]), cvt_pk_bf16(v1[2], v1[3])};
                        s += ((v0[0] * v0[0] + v0[1] * v0[1]) + (v0[2] * v0[2] + v0[3] * v0[3])) + ((v1[0] * v1[0] + v1[1] * v1[1]) + (v1[2] * v1[2] + v1[3] * v1[3])); }
                    else { __builtin_nontemporal_store(v0, (f32x4*)(out + p)); __builtin_nontemporal_store(v1, (f32x4*)(out + p + 4)); } }
                if (OUT_BF16) { s += __shfl_xor(s, 16); s += __shfl_xor(s, 32); if (fq == 0) ssout[row * 16 + 4 * u.pn + wc] = s; }
            }
    }
};
struct EpiProj {
    static constexpr bool PERM = true, AFTER_DRAIN = false;
    const PG8_LAS float* rtab; int pmA; const float* tab; const float* qn; const float* kn; bf16_t* qkv; float qscale;
    __device__ __forceinline__ void operator()(const f32x4 (&acc)[2][2][4][2], const Unit& u, int wr, int wc, int fr, int fq) const {
        const int row0 = u.pm * BM + wr * 64 + fr, kind = u.pn >> 1, half = u.pn & 1;
        const PG8_LAS float* rt = rtab + (u.pm == pmA ? 0 : 256) + wr * 64 + fr;
        bf16_t* base = qkv + kind * 512;
        if (kind >= 2) {
            const int col0 = half * 256 + wc * 32 + 8 * fq;
#pragma unroll
            for (int ai = 0; ai < 2; ++ai)
#pragma unroll
                for (int m = 0; m < 4; ++m) { const size_t row = (size_t)(row0 + ai * HALF + m * 16); const float r = rt[ai * HALF + m * 16];
#pragma unroll
                    for (int bj = 0; bj < 2; ++bj) { const f32x4 v0 = acc[ai][bj][m][0] * r, v1 = acc[ai][bj][m][1] * r;
                        *(u32x4*)(base + row * PQ + col0 + bj * HALF) = (u32x4){cvt_pk_bf16(v0[0], v0[1]), cvt_pk_bf16(v0[2], v0[3]), cvt_pk_bf16(v1[0], v1[1]), cvt_pk_bf16(v1[2], v1[3])}; } }
        } else {
            const int g = 4 * half + wc; const float* gp = kind == 0 ? qn : kn; const float sc = kind == 0 ? qscale : 1.0f;
            const bool rot = fq < 2; const int d00 = rot ? 4 * fq : 8 * fq, d01 = rot ? 8 + 4 * fq : 8 * fq + 4;
            f32x4 gn[2][2];
            gn[0][0] = *(const f32x4*)(gp + d00); gn[0][1] = *(const f32x4*)(gp + d01); gn[1][0] = *(const f32x4*)(gp + 32 + 8 * fq); gn[1][1] = *(const f32x4*)(gp + 36 + 8 * fq);
#pragma unroll
            for (int ai = 0; ai < 2; ++ai)
#pragma unroll
                for (int m = 0; m < 4; ++m) { const size_t row = (size_t)(row0 + ai * HALF + m * 16); const float r = rt[ai * HALF + m * 16];
                    const f32x4 cs = *(const f32x4*)(tab + row * 16 + 4 * (fq & 1)), sn = *(const f32x4*)(tab + row * 16 + 8 + 4 * (fq & 1));
                    f32x4 v[2][2]; float s = 0.f;
#pragma unroll
                    for (int bj = 0; bj < 2; ++bj)
#pragma unroll
                        for (int n = 0; n < 2; ++n) { v[bj][n] = acc[ai][bj][m][n] * r; s += (v[bj][n][0] * v[bj][n][0] + v[bj][n][1] * v[bj][n][1]) + (v[bj][n][2] * v[bj][n][2] + v[bj][n][3] * v[bj][n][3]); }
                    s += __shfl_xor(s, 16); s += __shfl_xor(s, 32);
                    const float nrm = sc * __builtin_amdgcn_rsqf(s * (1.0f / 64.0f) + EPS);
#pragma unroll
                    for (int bj = 0; bj < 2; ++bj)
#pragma unroll
                        for (int n = 0; n < 2; ++n) v[bj][n] = v[bj][n] * nrm * gn[bj][n];
                    { const f32x4 x1 = v[0][0], x2 = v[0][1], o1 = x1 * cs - x2 * sn, o2 = x2 * cs + x1 * sn;
#pragma unroll
                      for (int e = 0; e < 4; ++e) { v[0][0][e] = rot ? o1[e] : x1[e]; v[0][1][e] = rot ? o2[e] : x2[e]; } }
                    typedef unsigned u32x2e __attribute__((ext_vector_type(2)));
                    bf16_t* orow = base + row * PQ + 64 * g;
                    *(u32x2e*)(orow + d00) = (u32x2e){cvt_pk_bf16(v[0][0][0], v[0][0][1]), cvt_pk_bf16(v[0][0][2], v[0][0][3])};
                    *(u32x2e*)(orow + d01) = (u32x2e){cvt_pk_bf16(v[0][1][0], v[0][1][1]), cvt_pk_bf16(v[0][1][2], v[0][1][3])};
                    *(u32x4*)(orow + 32 + 8 * fq) = (u32x4){cvt_pk_bf16(v[1][0][0], v[1][0][1]), cvt_pk_bf16(v[1][0][2], v[1][0][3]), cvt_pk_bf16(v[1][1][0], v[1][1][1]), cvt_pk_bf16(v[1][1][2], v[1][1][3])};
                }
        }
    }
};
struct NoPre { __device__ __forceinline__ void operator()() const {} };
__device__ __forceinline__ void stage_b_first(PG8_LAS unsigned char* lds, const bf16_t* Bt, int K, int pn) {
    const int tid = threadIdx.x, wid = __builtin_amdgcn_readfirstlane(tid >> 6);
    const size_t hstep = (size_t)HALF * K * 2; const char* cB = (const char*)Bt + (size_t)pn * 2 * hstep;
#pragma unroll
    for (int h = 0; h < 2; ++h)
#pragma unroll
        for (int i = 0; i < 2; ++i) { int R, C; stage_rc(tid * 16 + i * 8192, R, C); const int Rb = (R & ~31) + perm32(R & 31);
            __builtin_amdgcn_global_load_lds((const unsigned*)(cB + h * hstep + (size_t)(Rb * K + C) * 2u), (PG8_LAS unsigned*)(lds + (4 + h) * HTB + (unsigned)wid * 1024u + i * 8192), 16, 0, 0); }
}
template <class Epi, class Sched, bool ALIGN_EPI = false, bool SP2 = false, class Pre = NoPre>
__device__ __forceinline__ void gemm_phase(PG8_LAS unsigned char* lds, const Gemm g, const Sched& S, const Epi& E, const Pre& pre = Pre(), const bool bpre = false) {
    const int tid = threadIdx.x, wid = __builtin_amdgcn_readfirstlane(tid >> 6), lane = tid & 63, wr = wid >> 2, wc = wid & 3, fr = lane & 15, fq = lane >> 4;
    const int K = g.K, nt = K / BK;
    unsigned voffA[2], voffB[2];
#pragma unroll
    for (int i = 0; i < 2; ++i) { int R, C; stage_rc(tid * 16 + i * 8192, R, C); const int Rb = Epi::PERM ? ((R & ~31) + perm32(R & 31)) : R;
        voffA[i] = (unsigned)(R * K + C) * 2u; voffB[i] = (unsigned)(Rb * K + C) * 2u; }
    const size_t kstep = (size_t)(BK * 2);
    const size_t hstep = (size_t)HALF * K * 2;
    const size_t tstep = 2 * hstep;
    const unsigned ldsw = (unsigned)wid * 1024u;
    const int aoff = lds_byte(wr * 64 + fr, fq * 8), boff = lds_byte(wc * 32 + fr, fq * 8);
#define PG8_SA(b, h) (((b) * 2 + (h)) * HTB)
#define PG8_SB(b, h) ((4 + (b) * 2 + (h)) * HTB)
#define PG8_STAGE(bufoff, gbase, voff) do { _Pragma("unroll") for (int _i = 0; _i < 2; ++_i) \
        __builtin_amdgcn_global_load_lds((const unsigned*)((const char*)(gbase) + (voff)[_i]), (PG8_LAS unsigned*)(lds + (bufoff) + ldsw + _i * 8192), 16, 0, 0); } while (0)
#define PG8_LDA(dst, b, h) do { _Pragma("unroll") for (int m = 0; m < 4; ++m) _Pragma("unroll") for (int k = 0; k < 2; ++k) dst[m][k] = *(const PG8_LAS bf16x8*)(lds + PG8_SA(b, h) + aoff + m * 2048 + k * 1024); } while (0)
#define PG8_LDB(dst, b, h) do { _Pragma("unroll") for (int n = 0; n < 2; ++n) _Pragma("unroll") for (int k = 0; k < 2; ++k) dst[n][k] = *(const PG8_LAS bf16x8*)(lds + PG8_SB(b, h) + boff + n * 2048 + k * 1024); } while (0)
#define PG8_MMA(ai, bj, At, Bt) do { __builtin_amdgcn_s_setprio(1); _Pragma("unroll") for (int m = 0; m < 4; ++m) _Pragma("unroll") for (int n = 0; n < 2; ++n) _Pragma("unroll") for (int k = 0; k < 2; ++k) \
        acc[ai][bj][m][n] = __builtin_amdgcn_mfma_f32_16x16x32_bf16(Bt[n][k], At[m][k], acc[ai][bj][m][n], 0, 0, 0); __builtin_amdgcn_s_setprio(0); } while (0)
#define PG8_WAIT_V(n) asm volatile("s_waitcnt vmcnt(" #n ")" ::: "memory")
#define PG8_WAIT_L(n) asm volatile("s_waitcnt lgkmcnt(" #n ")" ::: "memory")
#define PG8_BAR __builtin_amdgcn_s_barrier()
#define PG8_SCHED __builtin_amdgcn_sched_barrier(0)
    Unit cur, nxt; int ui = 0;
    if (!S.next(0, cur)) return;
    f32x4 acc[2][2][4][2];
#pragma unroll
    for (int a = 0; a < 2; ++a)
#pragma unroll
        for (int b = 0; b < 2; ++b)
#pragma unroll
            for (int m = 0; m < 4; ++m)
#pragma unroll
                for (int n = 0; n < 2; ++n) acc[a][b][m][n] = (f32x4){0.f, 0.f, 0.f, 0.f};
    bf16x8 At[4][2], B0[2][2], B1[2][2];
    const char* cA = (const char*)g.A + (size_t)cur.pm * tstep; const char* cB = (const char*)g.Bt + (size_t)cur.pn * tstep;
    S.a_ready(cur);
    if constexpr (SP2) {
        if (!bpre) { PG8_STAGE(PG8_SB(0, 0), cB, voffB); PG8_STAGE(PG8_SB(0, 1), cB + hstep, voffB); }
        PG8_STAGE(PG8_SA(0, 0), cA, voffA); PG8_STAGE(PG8_SA(0, 1), cA + hstep, voffA);
        pre();
        if (wr == 1) PG8_BAR;
        PG8_WAIT_V(2); PG8_BAR;
        PG8_STAGE(PG8_SB(1, 0), cB + kstep, voffB); PG8_STAGE(PG8_SA(1, 0), cA + kstep, voffA); PG8_STAGE(PG8_SB(1, 1), cB + hstep + kstep, voffB);
        PG8_WAIT_V(6); PG8_BAR;
    } else {
        PG8_STAGE(PG8_SB(0, 0), cB, voffB); PG8_STAGE(PG8_SA(0, 0), cA, voffA); PG8_STAGE(PG8_SB(0, 1), cB + hstep, voffB); PG8_STAGE(PG8_SA(0, 1), cA + hstep, voffA);
        if (wr == 1) PG8_BAR;
        PG8_WAIT_V(4); PG8_BAR;
        PG8_STAGE(PG8_SB(1, 0), cB + kstep, voffB); PG8_STAGE(PG8_SA(1, 0), cA + kstep, voffA); PG8_STAGE(PG8_SB(1, 1), cB + hstep + kstep, voffB);
        PG8_WAIT_V(6); PG8_BAR;
    }
    for (;;) {
        const bool has_next = S.next(ui + 1, nxt);
        const char* nA = has_next ? (const char*)g.A + (size_t)nxt.pm * tstep : cA; const char* nB = has_next ? (const char*)g.Bt + (size_t)nxt.pn * tstep : cB;
        for (int t = 0; t < nt; t += 2) {
            const bool last = (t == nt - 2);
            const char* a1 = cA + (size_t)(t + 1) * kstep;
            const char* a2 = last ? nA : cA + (size_t)(t + 2) * kstep; const char* b2 = last ? nB : cB + (size_t)(t + 2) * kstep;
            const char* a3 = a2 + kstep; const char* b3 = b2 + kstep;
            if (last && has_next) S.a_ready(nxt);
            if constexpr (SP2) {
            PG8_LDB(B0, 0, 0); PG8_LDB(B1, 0, 1); PG8_SCHED; PG8_LDA(At, 0, 0); PG8_STAGE(PG8_SA(1, 1), a1 + hstep, voffA);
            PG8_WAIT_V(8); PG8_WAIT_L(0); PG8_BAR; PG8_MMA(0, 0, At, B0); PG8_MMA(0, 1, At, B1); PG8_BAR; PG8_SCHED;
            PG8_LDA(At, 0, 1); PG8_STAGE(PG8_SB(0, 0), b2, voffB); PG8_STAGE(PG8_SB(0, 1), b2 + hstep, voffB); PG8_STAGE(PG8_SA(0, 0), a2, voffA);
            PG8_WAIT_V(8); PG8_WAIT_L(0); PG8_BAR; PG8_MMA(1, 0, At, B0); PG8_MMA(1, 1, At, B1); PG8_BAR; PG8_SCHED;
            PG8_LDB(B0, 1, 0); PG8_LDB(B1, 1, 1); PG8_SCHED; PG8_LDA(At, 1, 0); PG8_STAGE(PG8_SA(0, 1), a2 + hstep, voffA);
            PG8_WAIT_V(8); PG8_WAIT_L(0); PG8_BAR; PG8_MMA(0, 0, At, B0); PG8_MMA(0, 1, At, B1); PG8_BAR; PG8_SCHED;
            PG8_LDA(At, 1, 1); PG8_STAGE(PG8_SB(1, 0), b3, voffB); PG8_STAGE(PG8_SB(1, 1), b3 + hstep, voffB); PG8_STAGE(PG8_SA(1, 0), a3, voffA);
            PG8_WAIT_V(8); PG8_WAIT_L(0); PG8_BAR; PG8_MMA(1, 0, At, B0); PG8_MMA(1, 1, At, B1); PG8_BAR; PG8_SCHED;
            } else {
            PG8_LDB(B0, 0, 0); PG8_SCHED; PG8_LDA(At, 0, 0); PG8_STAGE(PG8_SA(1, 1), a1 + hstep, voffA);
            PG8_WAIT_L(8); PG8_BAR; PG8_WAIT_L(0); PG8_MMA(0, 0, At, B0); PG8_BAR; PG8_SCHED;
            PG8_LDB(B1, 0, 1); PG8_STAGE(PG8_SB(0, 0), b2, voffB);
            PG8_BAR; PG8_WAIT_L(0); PG8_MMA(0, 1, At, B1); PG8_BAR;
            PG8_LDA(At, 0, 1); PG8_STAGE(PG8_SA(0, 0), a2, voffA);
            PG8_BAR; PG8_WAIT_L(0); PG8_MMA(1, 0, At, B0); PG8_BAR; PG8_SCHED;
            PG8_STAGE(PG8_SB(0, 1), b2 + hstep, voffB);
            PG8_WAIT_V(6); PG8_BAR; PG8_MMA(1, 1, At, B1); PG8_BAR;
            PG8_LDB(B0, 1, 0); PG8_SCHED; PG8_LDA(At, 1, 0); PG8_STAGE(PG8_SA(0, 1), a2 + hstep, voffA);
            PG8_WAIT_L(8); PG8_BAR; PG8_WAIT_L(0); PG8_MMA(0, 0, At, B0); PG8_BAR; PG8_SCHED;
            PG8_LDB(B1, 1, 1); PG8_STAGE(PG8_SB(1, 0), b3, voffB);
            PG8_BAR; PG8_WAIT_L(0); PG8_MMA(0, 1, At, B1); PG8_BAR;
            PG8_LDA(At, 1, 1); PG8_STAGE(PG8_SA(1, 0), a3, voffA);
            PG8_BAR; PG8_WAIT_L(0); PG8_MMA(1, 0, At, B0); PG8_BAR; PG8_SCHED;
            PG8_STAGE(PG8_SB(1, 1), b3 + hstep, voffB);
            PG8_WAIT_V(6); PG8_BAR; PG8_MMA(1, 1, At, B1); PG8_BAR;
            }
        }
        if constexpr (ALIGN_EPI) { if (wr == 0) PG8_BAR; }
        if constexpr (!Epi::AFTER_DRAIN) { E(acc, cur, wr, wc, fr, fq); S.done(cur); }
        if (!has_next) break;
#pragma unroll
        for (int a = 0; a < 2; ++a)
#pragma unroll
            for (int b = 0; b < 2; ++b)
#pragma unroll
                for (int m = 0; m < 4; ++m)
#pragma unroll
                    for (int n = 0; n < 2; ++n) acc[a][b][m][n] = (f32x4){0.f, 0.f, 0.f, 0.f};
        cur = nxt; cA = nA; cB = nB; ++ui;
        if constexpr (ALIGN_EPI) { if (wr == 1) PG8_BAR; }
    }
    PG8_WAIT_V(0);
    if constexpr (!ALIGN_EPI) { if (wr == 0) PG8_BAR; }
    PG8_BAR;
    if constexpr (Epi::AFTER_DRAIN) { E.fused(acc, cur, wr, wc, fr, fq, lds, wid, lane); S.done(cur); }
#undef PG8_SA
#undef PG8_SB
#undef PG8_STAGE
#undef PG8_LDA
#undef PG8_LDB
#undef PG8_MMA
#undef PG8_WAIT_V
#undef PG8_WAIT_L
#undef PG8_BAR
#undef PG8_SCHED
}
}

#ifndef ATT_PROBE
#define ATT_PROBE 0
#endif
namespace attn {
using bf16x8 = __attribute__((ext_vector_type(8))) short;
using s16x4 = __attribute__((ext_vector_type(4))) short;
using f32x16 = __attribute__((ext_vector_type(16))) float;
using u32x4 = __attribute__((ext_vector_type(4))) unsigned;
typedef short v4i16_t __attribute__((ext_vector_type(4)));
typedef __attribute__((address_space(3))) const char* lds_cptr;
constexpr int SLOTB = 32768, NSLOT = 3, LDS_WS = NSLOT * SLOTB  , LDS_X = 0  , LDS_STG = 65536  ;
__device__ __forceinline__ int crow(int r, int hi) { return (r & 3) + 8 * (r >> 2) + 4 * hi; }
__device__ __forceinline__ void glds16(const void* gsrc, unsigned lds_dst) { unsigned keep;
    asm volatile("s_mov_b32 %0, m0\n\ts_mov_b32 m0, %2\n\ts_nop 0\n\tglobal_load_lds_dwordx4 %1, off\n\ts_mov_b32 m0, %0" : "=&s"(keep) : "v"(gsrc), "s"(lds_dst) : "memory"); }
typedef float f32x2_t __attribute__((ext_vector_type(2))); typedef __bf16 bf16x2_t __attribute__((ext_vector_type(2)));
__device__ __forceinline__ unsigned cvtpk(float lo, float hi) { f32x2_t v = {lo, hi}; bf16x2_t b = __builtin_convertvector(v, bf16x2_t); return __builtin_bit_cast(unsigned, b); }
__device__ __forceinline__ s16x4 vtr(lds_cptr p) { return __builtin_bit_cast(s16x4, __builtin_amdgcn_ds_read_tr16_b64_v4i16((__attribute__((address_space(3))) v4i16_t*)p)); }
#define ATT_WAIT_BAR(N) asm volatile("s_waitcnt vmcnt(" #N ") lgkmcnt(0)\n\ts_barrier" ::: "memory")

__device__ __forceinline__ void attn_unit(int b, int h, int cc, const bf16* Q, const bf16* __restrict__ K, const bf16* __restrict__ V, bf16* Y, float lam, float negm_s, const float* subln, LAS unsigned char* lds) {
    const int tid = threadIdx.x, lane = tid & 63, r32 = lane & 31, hi = lane >> 5; const int wid = __builtin_amdgcn_readfirstlane(tid >> 6);
#ifdef PROBE_CLK
    unsigned long long pk_ta = 0; if (tid == 0) pk_ta = __builtin_amdgcn_s_memrealtime();
#endif
    const int qg = wid & 3, map = wid >> 2;
    const size_t rowbase = (size_t)b * SEQ; const int q0 = 128 * cc;
    const bf16* Qw = Q + (rowbase + q0 + 32 * qg) * PQ + h * 128 + map * 64;
    const bf16* Kh = K + rowbase * PQ + h * 128; const bf16* Vh = V + rowbase * PQ + h * 128;
    const unsigned lds0 = (unsigned)(uintptr_t)lds;
    const lds_cptr lds3 = (lds_cptr)lds;
    LAS float* wsf = (LAS float*)(lds + LDS_WS) + wid * 64;
    const int NT = 2 * cc + 2, my_nt = 2 * cc + (qg >> 1) + 1;
    const bf16* ksrc0 = Kh + (size_t)lane * PQ + wid * 8; const bf16* ksrc1 = ksrc0 + 64;
    const bf16* vsrc0 = Vh + (size_t)(16 * (wid & 3) + (lane >> 2)) * PQ + (wid >> 2) * 32 + (lane & 3) * 8; const bf16* vsrc1 = vsrc0 + 64;
    const unsigned kdst = lds0 + wid * 1024, vdst = lds0 + 16384 + wid * 1024;
#define ATT_DMA(t, slot) do { const size_t to_ = (size_t)(t) * 64 * PQ; const unsigned sl_ = (unsigned)(slot); \
        glds16(ksrc0 + to_, (unsigned)__builtin_amdgcn_readfirstlane(kdst + sl_)); glds16(ksrc1 + to_, (unsigned)__builtin_amdgcn_readfirstlane(kdst + sl_ + 8192u)); \
        glds16(vsrc0 + to_, (unsigned)__builtin_amdgcn_readfirstlane(vdst + sl_)); glds16(vsrc1 + to_, (unsigned)__builtin_amdgcn_readfirstlane(vdst + sl_ + 8192u)); } while (0)
    ATT_DMA(0, 0); ATT_DMA(1, SLOTB);
    bf16x8 qr[4];
#pragma unroll
    for (int s = 0; s < 4; ++s) qr[s] = *reinterpret_cast<const bf16x8*>(&Qw[(size_t)r32 * PQ + s * 16 + hi * 8]);
    f32x16 o[4]; o[0] = f32x16{}; o[1] = f32x16{}; o[2] = f32x16{}; o[3] = f32x16{};
    f32x16 negm; float nm_ = negm_s; asm volatile("" : "+v"(nm_));
#pragma unroll
    for (int r = 0; r < 16; ++r) negm[r] = nm_;
    asm volatile("" : "+v"(negm));
    float l_reg = 0.f;
    const lds_cptr kp0 = lds3 + map * 8192 + hi * 1024 + r32 * 16;
    const lds_cptr vp0 = lds3 + 16384 + ((lane >> 4) & 1) * 32 + (lane & 3) * 8 + (4 * hi + ((lane & 15) >> 2)) * 64;
    int slot = 0;
    __builtin_amdgcn_s_waitcnt(0x0F70);
#ifdef PROBE_CLK
    unsigned long long pk_t0 = 0; if (tid == 0) pk_t0 = __builtin_amdgcn_s_memrealtime();
#endif
    for (int t = 0; t < my_nt; ++t) {
        if (t + 1 < NT) { ATT_WAIT_BAR(4); } else { ATT_WAIT_BAR(0); }
        int s2 = slot + 2 * SLOTB; if (s2 >= NSLOT * SLOTB) s2 -= NSLOT * SLOTB;
        {
            const lds_cptr kp = kp0 + slot; const lds_cptr vp = vp0 + slot;
            bf16x8 kf[8];
#pragma unroll
            for (int s = 0; s < 4; ++s) { kf[2 * s] = *(const __attribute__((address_space(3))) bf16x8*)(kp + s * 2048); kf[2 * s + 1] = *(const __attribute__((address_space(3))) bf16x8*)(kp + s * 2048 + 512); }
            f32x16 p0 = __builtin_amdgcn_mfma_f32_32x32x16_bf16(kf[0], qr[0], negm, 0, 0, 0), p1 = __builtin_amdgcn_mfma_f32_32x32x16_bf16(kf[1], qr[0], negm, 0, 0, 0);
#pragma unroll
            for (int s = 1; s < 4; ++s) { p0 = __builtin_amdgcn_mfma_f32_32x32x16_bf16(kf[2 * s], qr[s], p0, 0, 0, 0); p1 = __builtin_amdgcn_mfma_f32_32x32x16_bf16(kf[2 * s + 1], qr[s], p1, 0, 0, 0); }
#define ATT_VLOAD(VF, KS) do { _Pragma("unroll") for (int db = 0; db < 4; ++db) { const s16x4 vlo = vtr(vp + db * 4096 + (KS) * 1024), vhi = vtr(vp + db * 4096 + (KS) * 1024 + 512); \
                VF[db] = (bf16x8){vlo[0], vlo[1], vlo[2], vlo[3], vhi[0], vhi[1], vhi[2], vhi[3]}; } } while (0)
#define ATT_EXPK(P, B, W) do { _Pragma("unroll") for (int r = 0; r < 8; ++r) { P[(B) + r] = __builtin_amdgcn_exp2f(P[(B) + r]); sacc += P[(B) + r]; } \
                W = (u32x4){cvtpk(P[(B)], P[(B) + 1]), cvtpk(P[(B) + 2], P[(B) + 3]), cvtpk(P[(B) + 4], P[(B) + 5]), cvtpk(P[(B) + 6], P[(B) + 7])}; } while (0)
#define ATT_PVK(VF, W) do { _Pragma("unroll") for (int db = 0; db < 4; ++db) o[db] = __builtin_amdgcn_mfma_f32_32x32x16_bf16(__builtin_bit_cast(bf16x8, W), VF[db], o[db], 0, 0, 0); } while (0)
            bf16x8 vfa[4], vfb[4]; u32x4 pwa, pwb; float sacc = 0.f;
            __builtin_amdgcn_sched_barrier(0);
            ATT_VLOAD(vfa, 0);
            if (t + 2 < NT) ATT_DMA(t + 2, s2);
            __builtin_amdgcn_sched_barrier(0);
            ATT_EXPK(p0, 0, pwa);
            ATT_VLOAD(vfb, 1); __builtin_amdgcn_sched_barrier(0);
            ATT_PVK(vfa, pwa); ATT_EXPK(p0, 8, pwb); __builtin_amdgcn_sched_barrier(0);
            ATT_VLOAD(vfa, 2); __builtin_amdgcn_sched_barrier(0);
            ATT_PVK(vfb, pwb); ATT_EXPK(p1, 0, pwa); __builtin_amdgcn_sched_barrier(0);
            ATT_VLOAD(vfb, 3); __builtin_amdgcn_sched_barrier(0);
            ATT_PVK(vfa, pwa); ATT_EXPK(p1, 8, pwb); __builtin_amdgcn_sched_barrier(0);
            ATT_PVK(vfb, pwb);
#undef ATT_VLOAD
#undef ATT_EXPK
#undef ATT_PVK
            l_reg += sacc;
        }
        slot += SLOTB; if (slot == NSLOT * SLOTB) slot = 0;
    }
#ifdef PROBE_CLK
    unsigned long long pk_t1 = 0; if (tid == 0) { pk_t1 = __builtin_amdgcn_s_memrealtime(); volatile LAS unsigned* pk_w = (volatile LAS unsigned*)(lds + 131072 + 256 + 56); if (PROBE_CLK == 4) *pk_w = *pk_w + (unsigned)(pk_t0 - pk_ta); if (PROBE_CLK == 5) *pk_w = *pk_w + (unsigned)(pk_t1 - pk_t0); }
#endif
    if (my_nt < NT) ATT_WAIT_BAR(0);
    int lane_e = lane; asm volatile("" : "+v"(lane_e));
    const int r32e = lane_e & 31, hie = lane_e >> 5;
    l_reg += __shfl_xor(l_reg, 32);
    const float scl = (map == 0 ? 1.0f : lam) * __builtin_amdgcn_rcpf(l_reg);
    if (hie == 0) wsf[r32e] = scl;
    asm volatile("s_waitcnt lgkmcnt(0)" ::: "memory");
    float sc[16];
#pragma unroll
    for (int r = 0; r < 16; ++r) sc[r] = wsf[crow(r, hie)];
    ATT_WAIT_BAR(0);
    LAS float* xb = (LAS float*)(lds + LDS_X) + qg * 4096;
    if (map == 1) {
#pragma unroll
        for (int db = 0; db < 4; ++db)
#pragma unroll
            for (int r = 0; r < 16; ++r) xb[(db * 16 + r) * 64 + lane_e] = o[db][r] * sc[r];
    }
    ATT_WAIT_BAR(0);
    if (map == 0) {
        float ss[16];
#pragma unroll
        for (int r = 0; r < 16; ++r) ss[r] = 0.f;
#pragma unroll
        for (int db = 0; db < 4; ++db)
#pragma unroll
            for (int r = 0; r < 16; ++r) { o[db][r] = o[db][r] * sc[r] - xb[(db * 16 + r) * 64 + lane_e]; ss[r] += o[db][r] * o[db][r]; }
#pragma unroll
        for (int r = 0; r < 16; ++r) {
#pragma unroll
            for (int m = 1; m < 32; m <<= 1) ss[r] += __shfl_xor(ss[r], m);
            ss[r] = (1.0f - LAMBDA_INIT) * __builtin_amdgcn_rsqf(ss[r] * (1.0f / 128.0f) + EPS); }
        LAS bf16* stg = (LAS bf16*)(lds + LDS_STG) + qg * 4096;
#pragma unroll
        for (int db = 0; db < 4; ++db) { const float gsub = subln[32 * db + r32e];
#pragma unroll
            for (int r = 0; r < 16; ++r) stg[crow(r, hie) * 128 + 32 * db + r32e] = (bf16)cvtpk(o[db][r] * ss[r] * gsub, 0.f); }
        asm volatile("s_waitcnt lgkmcnt(0)" ::: "memory");
        bf16* Yw = Y + (rowbase + q0 + 32 * qg) * DM + h * 128;
#pragma unroll
        for (int i = 0; i < 8; ++i) { const int id = i * 64 + lane_e, row = id >> 4, ch = id & 15;
            const u32x4 v = *(const LAS u32x4*)(stg + row * 128 + ch * 8); *(u32x4*)(Yw + (size_t)row * DM + ch * 8) = v; }
    }
    asm volatile("s_waitcnt lgkmcnt(0)\n\ts_barrier" ::: "memory");
#undef ATT_DMA
}
#undef ATT_WAIT_BAR
}

namespace rnn {
using bf16x8 = __attribute__((ext_vector_type(8))) short;
using f32x16 = __attribute__((ext_vector_type(16))) float;
typedef float f32x2_t __attribute__((ext_vector_type(2))); typedef __bf16 bf16x2_t __attribute__((ext_vector_type(2)));
typedef unsigned u32x2 __attribute__((ext_vector_type(2)));
__device__ __forceinline__ unsigned cvtpk(float lo, float hi) { f32x2_t v = {lo, hi}; bf16x2_t b = __builtin_convertvector(v, bf16x2_t); return __builtin_bit_cast(unsigned, b); }
__device__ __forceinline__ float sigm2(float z) { return __builtin_amdgcn_rcpf(1.0f + __builtin_amdgcn_exp2f(z)); }
constexpr int LDS_CW = 0  , LDS_CH = 1536  , LDS_COMP = 2048  , LDS_CIN = 6144  , LDS_W = 8192  ,
              LDS_XS = 16384  , XS_BYTES = 264 * 128;
__device__ __forceinline__ void glds16(const void* gsrc, unsigned lds_dst) { unsigned keep;
    asm volatile("s_mov_b32 %0, m0\n\ts_mov_b32 m0, %2\n\ts_nop 0\n\tglobal_load_lds_dwordx4 %1, off\n\ts_mov_b32 m0, %0" : "=&s"(keep) : "v"(gsrc), "s"(lds_dst) : "memory"); }

__device__ __forceinline__ void rnn_consts(int n, int dh, const float* conv_w, const float* conv_b, const float* w_a, const float* b_a, const float* w_x, const float* b_x, const float* a_param, LAS unsigned char* lds) {
    const int tid = threadIdx.x, lane = tid & 63, r32 = lane & 31, hi = lane >> 5; const int wid = __builtin_amdgcn_readfirstlane(tid >> 6);
    LAS float* cwl = (LAS float*)(lds + LDS_CW); LAS float* chl = (LAS float*)(lds + LDS_CH);
    if (tid < 256) cwl[tid] = conv_w[(tid >> 6) * DRNN + n * 64 + (tid & 63)]; else if (tid < 320) cwl[tid] = conv_b[n * 64 + tid - 256];
    else if (tid < 352) { const int ch = n * 64 + 32 * dh + tid - 320; chl[tid - 320] = -1.4426950408889634f * b_a[ch]; chl[32 + tid - 320] = -1.4426950408889634f * b_x[ch]; chl[64 + tid - 320] = -8.0f * 1.4426950408889634f * log1pf(expf(-a_param[ch])); }
    { const int mat = wid >> 2, s = wid & 3; const float* wsrc = mat ? w_x : w_a; bf16x8 f;
#pragma unroll
        for (int j = 0; j < 8; ++j) { const int c = 16 * s + 8 * (j >> 2) + 4 * hi + (j & 3); f[j] = (short)f2bf(-1.4426950408889634f * wsrc[(size_t)(n * 64 + c) * 64 + 32 * dh + r32]); }
        *(LAS bf16x8*)(lds + LDS_W + (wid * 64 + lane) * 16) = f; }
}

template <bool PREP> __device__ __forceinline__ void rnn_unit(int b, int n, int dh, const bf16* __restrict__ XR, const bf16* __restrict__ GATE, bf16* __restrict__ Y, const float* conv_w, const float* conv_b,
                                         const float* w_a, const float* b_a, const float* w_x, const float* b_x, const float* a_param, LAS unsigned char* lds) {
    const int tid = threadIdx.x, lane = tid & 63, r32 = lane & 31, hi = lane >> 5; const int wid = __builtin_amdgcn_readfirstlane(tid >> 6);
    LAS float* cwl = (LAS float*)(lds + LDS_CW); LAS float* chl = (LAS float*)(lds + LDS_CH); LAS float* comp = (LAS float*)(lds + LDS_COMP);
    __syncthreads();
    const size_t seq0 = (size_t)b * SEQ;
    const unsigned lds0 = (unsigned)(uintptr_t)lds;
    const bf16* xsrc = XR + ((long)seq0 - 8 + (lane >> 3)) * PQ + n * 64;
#define RNN_DMA(rd_, buf_) do { const bf16* xs_ = xsrc + (size_t)(rd_) * 256 * PQ; const unsigned db_ = lds0 + LDS_XS + (unsigned)(buf_) * XS_BYTES; \
        _Pragma("unroll") for (int j_ = 0; j_ < 4; ++j_) { const int i_ = wid + 8 * j_; const int rw_ = 8 * i_ + (lane >> 3); \
            glds16(xs_ + (size_t)(8 * i_) * PQ + 8 * ((lane & 7) ^ ((rw_ >> 1) & 7)), (unsigned)__builtin_amdgcn_readfirstlane(db_ + 1024u * i_)); } \
        if (wid == 0) { const int rw_ = 256 + (lane >> 3); glds16(xs_ + (size_t)256 * PQ + 8 * ((lane & 7) ^ ((rw_ >> 1) & 7)), (unsigned)__builtin_amdgcn_readfirstlane(db_ + 32768u)); } } while (0)
    RNN_DMA(0, 0);
    if (!PREP) rnn_consts(n, dh, conv_w, conv_b, w_a, b_a, w_x, b_x, a_param, lds);
    const LAS bf16x8* wfr = (const LAS bf16x8*)(lds + LDS_W) + lane;
    float carry1 = 0.f;
    asm volatile("s_waitcnt vmcnt(0) lgkmcnt(0)\n\ts_barrier" ::: "memory");
    if (wid == 0) *(LAS v4u*)(lds + LDS_XS + lane * 16) = (v4u){0u, 0u, 0u, 0u};
    asm volatile("s_waitcnt lgkmcnt(0)\n\ts_barrier" ::: "memory");
    for (int rd = 0; rd < SEQ / 256; ++rd) {
        const int t = 32 * (8 * rd + wid) + r32; const size_t row = seq0 + t;
        if (rd + 1 < SEQ / 256) RNN_DMA(rd + 1, (rd + 1) & 1);
        bf16x8 xf[4]; float xsel[16];
        u32x2 gv[4];
#pragma unroll
        for (int g = 0; g < 4; ++g) gv[g] = *(const u32x2*)(GATE + row * PQ + n * 64 + 32 * dh + 8 * g + 4 * hi);
        const LAS unsigned char* xsb = lds + LDS_XS + (rd & 1) * XS_BYTES + 8 * hi;
        const int rl0 = 5 + 32 * wid + r32;
#pragma unroll
        for (int s = 0; s < 4; ++s) {
            float xc[8];
#pragma unroll
            for (int hf = 0; hf < 2; ++hf) { const int c0 = 16 * s + 8 * hf + 4 * hi;
                const v4f cb = *(const LAS v4f*)(cwl + 256 + c0); float acc4[4] = {cb[0], cb[1], cb[2], cb[3]};
#pragma unroll
                for (int k = 0; k < 4; ++k) { const int rl = rl0 + k;
                    const u32x2 x2 = *(const LAS u32x2*)(xsb + (rl * 8 + ((2 * s + hf) ^ ((rl >> 1) & 7))) * 16);
                    const v4f cw = *(const LAS v4f*)(cwl + k * 64 + c0);
                    acc4[0] += cw[0] * __builtin_bit_cast(float, x2[0] << 16); acc4[1] += cw[1] * __builtin_bit_cast(float, x2[0] & 0xffff0000u);
                    acc4[2] += cw[2] * __builtin_bit_cast(float, x2[1] << 16); acc4[3] += cw[3] * __builtin_bit_cast(float, x2[1] & 0xffff0000u); }
#pragma unroll
                for (int e = 0; e < 4; ++e) xc[4 * hf + e] = acc4[e]; }
            const unsigned w0 = cvtpk(xc[0], xc[1]), w1 = cvtpk(xc[2], xc[3]), w2 = cvtpk(xc[4], xc[5]), w3 = cvtpk(xc[6], xc[7]);
            xf[s] = __builtin_bit_cast(bf16x8, (v4u){w0, w1, w2, w3});
            if (s < 2) {
#pragma unroll
                for (int j = 0; j < 8; ++j) xsel[8 * s + j] = xc[j];
            } else {
#pragma unroll
                for (int j = 0; j < 8; ++j) xsel[8 * (s - 2) + j] = dh ? xc[j] : xsel[8 * (s - 2) + j];
            }
        }
        f32x16 ga, gx; float sp[16];
#pragma unroll
        for (int g = 0; g < 4; ++g) { const v4f a4 = *(const LAS v4f*)(chl + 8 * g + 4 * hi), x4 = *(const LAS v4f*)(chl + 32 + 8 * g + 4 * hi), s4 = *(const LAS v4f*)(chl + 64 + 8 * g + 4 * hi);
#pragma unroll
            for (int e = 0; e < 4; ++e) { ga[4 * g + e] = a4[e]; gx[4 * g + e] = x4[e]; sp[4 * g + e] = s4[e]; } }
#pragma unroll
        for (int s = 0; s < 4; ++s) { ga = __builtin_amdgcn_mfma_f32_32x32x16_bf16(wfr[s * 64], xf[s], ga, 0, 0, 0); gx = __builtin_amdgcn_mfma_f32_32x32x16_bf16(wfr[(4 + s) * 64], xf[s], gx, 0, 0, 0); }
        float av[16], bv[16];
#pragma unroll
        for (int r = 0; r < 16; ++r) { const float rg = sigm2(ga[r]), ig = sigm2(gx[r]);
            const float aa = __builtin_amdgcn_exp2f(sp[r] * rg); av[r] = aa; bv[r] = __builtin_amdgcn_sqrtf(fmaxf(1.0f - aa * aa, 0.f)) * ig * xsel[r]; }
#define RNN_STEPS(CTRL) \
        "v_fmac_f32_dpp %8, %8, %0 " CTRL "\n\tv_fmac_f32_dpp %9, %9, %1 " CTRL "\n\tv_fmac_f32_dpp %10, %10, %2 " CTRL "\n\tv_fmac_f32_dpp %11, %11, %3 " CTRL "\n\t" \
        "v_fmac_f32_dpp %12, %12, %4 " CTRL "\n\tv_fmac_f32_dpp %13, %13, %5 " CTRL "\n\tv_fmac_f32_dpp %14, %14, %6 " CTRL "\n\tv_fmac_f32_dpp %15, %15, %7 " CTRL "\n\t" \
        "v_mul_f32_dpp %0, %0, %0 " CTRL "\n\tv_mul_f32_dpp %1, %1, %1 " CTRL "\n\tv_mul_f32_dpp %2, %2, %2 " CTRL "\n\tv_mul_f32_dpp %3, %3, %3 " CTRL "\n\t" \
        "v_mul_f32_dpp %4, %4, %4 " CTRL "\n\tv_mul_f32_dpp %5, %5, %5 " CTRL "\n\tv_mul_f32_dpp %6, %6, %6 " CTRL "\n\tv_mul_f32_dpp %7, %7, %7 " CTRL "\n\t"
#define RNN_SCAN8(o) asm volatile("s_nop 1\n\t" RNN_STEPS("row_shr:1 row_mask:0xf bank_mask:0xf") RNN_STEPS("row_shr:2 row_mask:0xf bank_mask:0xf") RNN_STEPS("row_shr:4 row_mask:0xf bank_mask:0xf") \
            RNN_STEPS("row_shr:8 row_mask:0xf bank_mask:0xf") RNN_STEPS("row_bcast:15 row_mask:0xa bank_mask:0xf") \
            : "+v"(av[o]), "+v"(av[o + 1]), "+v"(av[o + 2]), "+v"(av[o + 3]), "+v"(av[o + 4]), "+v"(av[o + 5]), "+v"(av[o + 6]), "+v"(av[o + 7]), \
              "+v"(bv[o]), "+v"(bv[o + 1]), "+v"(bv[o + 2]), "+v"(bv[o + 3]), "+v"(bv[o + 4]), "+v"(bv[o + 5]), "+v"(bv[o + 6]), "+v"(bv[o + 7]))
        RNN_SCAN8(0); RNN_SCAN8(8);
#undef RNN_SCAN8
#undef RNN_STEPS
        LAS float* cp = comp + (rd & 1) * 512;
        if (r32 == 31) {
#pragma unroll
            for (int g = 0; g < 4; ++g) { *(LAS v4f*)(cp + (wid * 2 + 0) * 32 + 8 * g + 4 * hi) = (v4f){av[4 * g], av[4 * g + 1], av[4 * g + 2], av[4 * g + 3]};
                *(LAS v4f*)(cp + (wid * 2 + 1) * 32 + 8 * g + 4 * hi) = (v4f){bv[4 * g], bv[4 * g + 1], bv[4 * g + 2], bv[4 * g + 3]}; }
        }
        asm volatile("s_waitcnt vmcnt(0) lgkmcnt(0)\n\ts_barrier" ::: "memory");
        float cin1 = carry1;
#pragma unroll
        for (int w = 0; w < 8; ++w) { const float A1 = cp[(w * 2 + 0) * 32 + r32], B1 = cp[(w * 2 + 1) * 32 + r32];
            cin1 = (w == wid) ? carry1 : cin1; carry1 = A1 * carry1 + B1; }
        LAS float* cib = (LAS float*)(lds + LDS_CIN) + wid * 32;
        if (hi == 0) cib[r32] = cin1;
        asm volatile("s_waitcnt lgkmcnt(0)" ::: "memory");
        float cin[16];
#pragma unroll
        for (int g = 0; g < 4; ++g) { const v4f c4 = *(const LAS v4f*)(cib + 8 * g + 4 * hi);
#pragma unroll
            for (int e = 0; e < 4; ++e) cin[4 * g + e] = c4[e]; }
#pragma unroll
        for (int g = 0; g < 4; ++g) { const int c0 = n * 64 + 32 * dh + 8 * g + 4 * hi;
            const float gt[4] = {__builtin_bit_cast(float, gv[g][0] << 16), __builtin_bit_cast(float, gv[g][0] & 0xffff0000u), __builtin_bit_cast(float, gv[g][1] << 16), __builtin_bit_cast(float, gv[g][1] & 0xffff0000u)};
            float y[4];
#pragma unroll
            for (int e = 0; e < 4; ++e) { const int r = 4 * g + e; const float h = av[r] * cin[r] + bv[r]; const float x = gt[e];
                y[e] = h * x * sigm2(x * (-2.3022081981531984f + -0.10294323958041973f * (x * x))); }
            *(u32x2*)(Y + row * DM + DATTN + c0) = (u32x2){cvtpk(y[0], y[1]), cvtpk(y[2], y[3])}; }
    }
#undef RNN_DMA
    __syncthreads();
}
}

typedef __attribute__((address_space(1))) unsigned gu32;
#define RLX_AGENT __ATOMIC_RELAXED, __HIP_MEMORY_SCOPE_AGENT
#define XB_TMO      128
#define XB_XCNT(j)  (256  + 64 * (j))
#define XB_XSUB(j)  (1280 + 64 * (j))
#define XB_XGEN(j)  (2304 + 64 * (j))
#define XB_TOP      3328
#define XB_TOPGEN   3392
#define XCD_BAR_WORDS 3456
#define XB_SPIN_CAP (1u << 18)

__device__ __forceinline__ unsigned xb_ld(unsigned* p)              { return __hip_atomic_load(p, __ATOMIC_RELAXED, __HIP_MEMORY_SCOPE_AGENT); }
__device__ __forceinline__ unsigned xb_add(unsigned* p, unsigned v) { return __hip_atomic_fetch_add(p, v, __ATOMIC_RELAXED, __HIP_MEMORY_SCOPE_AGENT); }
__device__ __forceinline__ unsigned xb_xcc_id() { return (unsigned)__builtin_amdgcn_s_getreg((3 << 11) | 20) & 0xFu; }
#define XB_SPIN(cond, bar) do { unsigned _sp = 0; while (cond) { __builtin_amdgcn_s_sleep(1); \
    if ((++_sp & 255u) == 0u) { if (xb_ld(&(bar)[XB_TMO])) break; if (_sp > XB_SPIN_CAP) { atomicAdd(&(bar)[XB_TMO], 1u); break; } } } } while (0)

struct XcdBarrier {
    unsigned* bar; unsigned x;
    volatile LAS unsigned* st;
};

__device__ __forceinline__ XcdBarrier xcd_barrier_post(unsigned* bar, volatile LAS unsigned* st) {
    XcdBarrier b; b.bar = bar; b.x = xb_xcc_id(); b.st = st;
    if (threadIdx.x == 0) (void)xb_add(&bar[XB_XCNT(b.x)], 1u);
    return b;
}
__device__ __forceinline__ void xcd_barrier_complete(unsigned* bar, unsigned x, unsigned& nloc, unsigned& nx) {
    const unsigned G = gridDim.x * gridDim.y * gridDim.z;
    unsigned sum, cnt, mine, sp = 0u;
    for (;;) {
        sum = 0u; cnt = 0u; mine = 0u;
#pragma unroll
        for (unsigned j = 0; j < 16; ++j) { const unsigned c = xb_ld(&bar[XB_XCNT(j)]); sum += c; cnt += (c > 0u) ? 1u : 0u; mine = (j == x) ? c : mine; }
        if (sum == G) break;
        __builtin_amdgcn_s_sleep(1);
        if ((++sp & 255u) == 0u) { if (xb_ld(&bar[XB_TMO])) break; if (sp > XB_SPIN_CAP) { atomicAdd(&bar[XB_TMO], 1u); break; } }
    }
    nloc = mine > 0u ? mine : 1u; nx = cnt > 0u ? cnt : 1u;
}

struct NoMid { __device__ __forceinline__ void operator()() const {} };
template <class Mid = NoMid> __device__ __forceinline__ void xcd_barrier(const XcdBarrier& b, const Mid& mid = Mid()) {
    asm volatile("s_waitcnt vmcnt(0)" ::: "memory");
    __syncthreads();
    mid();
    if (threadIdx.x == 0) {
        unsigned* bar = b.bar;
        __builtin_amdgcn_s_waitcnt(0);
        unsigned nloc = b.st[0], nx = b.st[1];
        if (nloc == 0u) { xcd_barrier_complete(bar, b.x, nloc, nx); b.st[0] = nloc; b.st[1] = nx; }
        const unsigned old = xb_add(&bar[XB_XSUB(b.x)], 1u);
        const unsigned gen = old / nloc;
        if (old + 1u == (gen + 1u) * nloc) {
            __builtin_amdgcn_fence(__ATOMIC_RELEASE, "agent");
            asm volatile("s_waitcnt vmcnt(0)" ::: "memory");
            const unsigned og = xb_add(&bar[XB_TOP], 1u);
            const unsigned tg = og / nx;
            if (og + 1u == (tg + 1u) * nx) xb_add(&bar[XB_TOPGEN], 1u);
            else XB_SPIN(xb_ld(&bar[XB_TOPGEN]) == tg, bar);
            __builtin_amdgcn_fence(__ATOMIC_ACQUIRE, "agent");
            xb_add(&bar[XB_XGEN(b.x)], 1u);
            asm volatile("s_waitcnt vmcnt(0)" ::: "memory");
        } else {
            XB_SPIN(xb_ld(&bar[XB_XGEN(b.x)]) == gen, bar);
            __builtin_amdgcn_fence(__ATOMIC_ACQUIRE, "agent");
            asm volatile("s_waitcnt vmcnt(0)" ::: "memory");
        }
    }
    __syncthreads();
}

#define XL_SUB(j)   (3520 + 64 * (j))
#define XL_GEN(j)   (4544 + 64 * (j))
#define XL_TABLE    6144
template <class Mid = NoMid> __device__ __forceinline__ void xcd_local_barrier(const XcdBarrier& b, const Mid& mid = Mid()) {
    asm volatile("s_waitcnt vmcnt(0)" ::: "memory");
    __syncthreads();
    unsigned old = 0u, nloc = 1u;
    if (threadIdx.x == 0) {
        __builtin_amdgcn_s_waitcnt(0);
        nloc = b.st[0];
        old = xb_add(&b.bar[XL_SUB(b.x)], 1u);
    }
    mid();
    if (threadIdx.x == 0) {
        unsigned* bar = b.bar;
        const unsigned gen = old / nloc;
        if (old + 1u == (gen + 1u) * nloc) xb_add(&bar[XL_GEN(b.x)], 1u);
        else XB_SPIN(xb_ld(&bar[XL_GEN(b.x)]) == gen, bar);
        __builtin_amdgcn_fence(__ATOMIC_ACQUIRE, "agent");
        asm volatile("s_waitcnt vmcnt(0)" ::: "memory");
    }
    __syncthreads();
}

#define XG_SUB(g)   (6400 + 16 * (g))
#define XG_GEN(g)   (7424 + 16 * (g))
template <class Mid = NoMid> __device__ __forceinline__ void panel_group_barrier(const XcdBarrier& b, unsigned grp, const Mid& mid = Mid()) {
    asm volatile("s_waitcnt vmcnt(0)" ::: "memory");
    __syncthreads();
    unsigned old = 0u;
    if (threadIdx.x == 0) { __builtin_amdgcn_s_waitcnt(0); old = xb_add(&b.bar[XG_SUB(grp)], 1u); }
    mid();
    if (threadIdx.x == 0) {
        unsigned* bar = b.bar;
        const unsigned gen = old >> 2;
        if ((old & 3u) == 3u) xb_add(&bar[XG_GEN(grp)], 1u);
        else XB_SPIN(xb_ld(&bar[XG_GEN(grp)]) == gen, bar);
        __builtin_amdgcn_fence(__ATOMIC_ACQUIRE, "agent");
        asm volatile("s_waitcnt vmcnt(0)" ::: "memory");
    }
    __syncthreads();
}

#define XS_SUB(s, j) (8704 + 1024 * (s) + 64 * (j))
#define XS_TOP(s)    (10752 + 128 * (s))
#define XS_FLAG(s)   (10752 + 128 * (s) + 64)
__device__ __forceinline__ void xcd_split_arrive(const XcdBarrier& b, int set) {
    asm volatile("s_waitcnt vmcnt(0)" ::: "memory");
    __syncthreads();
    if (threadIdx.x == 0) {
        unsigned* bar = b.bar;
        __builtin_amdgcn_s_waitcnt(0);
        unsigned nloc = b.st[0], nx = b.st[1];
        if (nloc == 0u) { xcd_barrier_complete(bar, b.x, nloc, nx); b.st[0] = nloc; b.st[1] = nx; }
        const unsigned old = xb_add(&bar[XS_SUB(set, b.x)], 1u);
        if (old + 1u == nloc) {
            __builtin_amdgcn_fence(__ATOMIC_RELEASE, "agent");
            asm volatile("s_waitcnt vmcnt(0)" ::: "memory");
            const unsigned og = xb_add(&bar[XS_TOP(set)], 1u);
            if (og + 1u == nx) xb_add(&bar[XS_FLAG(set)], 1u);
        }
    }
    __syncthreads();
}
__device__ __forceinline__ void xcd_split_wait(const XcdBarrier& b, int set, int who) {
    if ((int)threadIdx.x == who) {
        unsigned* bar = b.bar;
        XB_SPIN(xb_ld(&bar[XS_FLAG(set)]) == 0u, bar);
        __builtin_amdgcn_fence(__ATOMIC_ACQUIRE, "agent");
        asm volatile("s_waitcnt vmcnt(0)" ::: "memory");
    }
}

__device__ __forceinline__ int srcblk(int mode, int nb) {
    if (mode == 1) { const int t = nb >> 3, bj = (nb >> 2) & 1, jb = nb & 3; return bj * 88 + 4 * t + jb; }
    if (mode == 2) { if (nb < 32) { const int t = nb >> 3, bj = (nb >> 2) & 1, wc = nb & 3; return 8 * t + 2 * wc + bj; } return nb; }
    return nb;
}
__device__ __forceinline__ void transpose_item(const float* W, int K, int N, const float* gain, bf16* WT, int mode, LAS float* scr, int item, int lane) {
    const int nblk = N / 32, kb = item / nblk, nb = item % nblk, k0 = 64 * kb, n0d = 32 * nb, n0s = 32 * srcblk(mode, nb);
    const int k0d = (mode == 3) ? (21 - (kb >> 1)) * 128 + 64 * (kb & 1) : k0;
#pragma unroll
    for (int i = 0; i < 8; ++i) { const int kk = 8 * i + (lane >> 3), cc = 4 * (lane & 7);
        const v4f w = __builtin_nontemporal_load((const v4f*)(W + (size_t)(k0 + kk) * N + n0s + cc)); const float gk = gain ? gain[k0 + kk] : 1.0f;
        scr[kk * 33 + cc] = w.x * gk; scr[kk * 33 + cc + 1] = w.y * gk; scr[kk * 33 + cc + 2] = w.z * gk; scr[kk * 33 + cc + 3] = w.w * gk; }
    asm volatile("s_waitcnt lgkmcnt(0)" ::: "memory");
    const int c = lane & 7;
    const bool qkmap = (mode == 2) && nb < 32 && ((nb >> 2) & 1) == 0;
#pragma unroll
    for (int j = 0; j < 4; ++j) { const int n = (lane >> 3) + 8 * j; const int ncol = (qkmap && n < 16) ? 4 * (n >> 3) + 8 * ((n >> 2) & 1) + (n & 3) : n; const LAS float* s = scr + (8 * c) * 33 + ncol;
        v4u o; o.x = pk2(s[0 * 33], s[1 * 33]); o.y = pk2(s[2 * 33], s[3 * 33]); o.z = pk2(s[4 * 33], s[5 * 33]); o.w = pk2(s[6 * 33], s[7 * 33]);
        *(v4u*)(WT + (size_t)(n0d + n) * K + k0d + 8 * c) = o; }
    asm volatile("s_waitcnt lgkmcnt(0)" ::: "memory");
}
__device__ __forceinline__ void xprep_row(const float* xrow, bf16* orow, float* ssrow, int lane) {
    const v4f* xr = (const v4f*)xrow + lane;
    v4f v[4]; float s = 0.f;
#pragma unroll
    for (int j = 0; j < 4; ++j) { v[j] = __builtin_nontemporal_load(xr + 64 * j); s += (v[j].x * v[j].x + v[j].y * v[j].y) + (v[j].z * v[j].z + v[j].w * v[j].w); }
    s = wave_sum(s);
    unsigned long long* o8 = (unsigned long long*)orow + lane;
#pragma unroll
    for (int j = 0; j < 4; ++j) o8[64 * j] = (unsigned long long)pk2(v[j].x, v[j].y) | ((unsigned long long)pk2(v[j].z, v[j].w) << 32);
    if (lane < 16) ssrow[lane] = lane == 0 ? s : 0.f;
}

struct Args {
    const float* in[25]; float* out; unsigned char* ws; float invf[8]; int ph_lo, ph_hi;
};
constexpr int NWAVES = 8, NTHREADS = 512;
constexpr int RING_BYTES = 131072, MISC_OFF = RING_BYTES + 256, LDS_BYTES = 147456;
constexpr int CW_BAR = 4096;
constexpr size_t CTL_ZERO_BYTES = 65536;

__device__ __forceinline__ void p0_rows_all(const Args& a, int tid);
__device__ __forceinline__ void p0_prologue(const Args& a, LAS unsigned char* lds, int tid, int r_lo, int r_hi, bool rows_too) {
    const int lane = tid & 63, wave = tid >> 6;
    LAS float* scr = (LAS float*)(lds + wave * 16384);
    const int gw = blockIdx.x * NWAVES + wave, NGW = gridDim.x * NWAVES;
    unsigned char* ws = a.ws;
    constexpr int I1 = (DM / 64) * (NFF / 32), I2 = (DFF / 64) * (DM / 32), I3 = (DM / 64) * (NPROJ / 32), I4 = (DM / 64) * (DM / 32);
    constexpr int NIT = 2 * I1 + 2 * I2 + I3 + I4;
    for (int it = gw + r_lo * NGW, rd = r_lo; it < NIT && rd < r_hi; it += NGW, ++rd) {
        int r = it;
        if (r < I1) { transpose_item(a.in[3], DM, NFF, a.in[2], (bf16*)(ws + WS_W1T), 1, scr, r, lane); continue; } r -= I1;
        if (r < I1) { transpose_item(a.in[23], DM, NFF, a.in[22], (bf16*)(ws + WS_W5T), 1, scr, r, lane); continue; } r -= I1;
        if (r < I2) { transpose_item(a.in[4], DFF, DM, nullptr, (bf16*)(ws + WS_W2T), 3, scr, r, lane); continue; } r -= I2;
        if (r < I2) { transpose_item(a.in[24], DFF, DM, nullptr, (bf16*)(ws + WS_W6T), 3, scr, r, lane); continue; } r -= I2;
        if (r < I3) { transpose_item(a.in[6], DM, NPROJ, a.in[5], (bf16*)(ws + WS_W3T), 2, scr, r, lane); continue; } r -= I3;
        transpose_item(a.in[21], DM, DM, nullptr, (bf16*)(ws + WS_W4T), 0, scr, r, lane);
    }
    if (rows_too) p0_rows_all(a, tid);
}
__device__ __forceinline__ void p0_rows_all(const Args& a, int tid) {
    const int lane = tid & 63, wave = tid >> 6; const int gw = blockIdx.x * NWAVES + wave, NGW = gridDim.x * NWAVES; unsigned char* ws = a.ws;
    const float* x = a.in[0];
    for (int m = gw; m < MTOK; m += NGW) xprep_row(x + (size_t)m * DM, (bf16*)(ws + WS_XB) + (size_t)m * DM, (float*)(ws + WS_SS) + (size_t)m * 16, lane);
    float* tab = (float*)(ws + WS_ROPE); const int* pos = (const int*)a.in[1];
    for (int i = blockIdx.x * NTHREADS + tid; i < MTOK * 8; i += gridDim.x * NTHREADS) {
        const int row = i >> 3, j = i & 7;
        const float ang = (float)pos[row] * a.invf[j];
        tab[row * 16 + j] = (float)cos((double)ang); tab[row * 16 + 8 + j] = (float)sin((double)ang);
    }
}
__device__ __forceinline__ void p0_rows_own(const Args& a, int tid) {
    const int lane = tid & 63, wave = tid >> 6; unsigned char* ws = a.ws;
    const int xl = (int)blockIdx.x & 7, jg = ((int)blockIdx.x >> 3) & 7, m4 = (int)blockIdx.x >> 6, pA = 16 * xl + jg, pB = pA + 8;
    const float* x = a.in[0];
    for (int i = 0; i < 16; ++i) { const int r = m4 * 8 + wave + 32 * i, m = (r < 256 ? pA : pB) * 256 + (r & 255);
        xprep_row(x + (size_t)m * DM, (bf16*)(ws + WS_XB) + (size_t)m * DM, (float*)(ws + WS_SS) + (size_t)m * 16, lane); }
    float* tab = (float*)(ws + WS_ROPE); const int* pos = (const int*)a.in[1];
    for (int e = m4 * NTHREADS + tid; e < 512 * 8; e += 4 * NTHREADS) {
        const int r = e >> 3, j = e & 7, row = (r < 256 ? pA : pB) * 256 + (r & 255);
        const float ang = (float)pos[row] * a.invf[j];
        tab[row * 16 + j] = (float)cos((double)ang); tab[row * 16 + 8 + j] = (float)sin((double)ang);
    }
}

constexpr int RTAB_OFF = RING_BYTES + 1024;
struct RinvPre {
    const float* ss; int pmA, pmB; LAS float* rtab;
    __device__ __forceinline__ void operator()() const { const int tid = threadIdx.x; const size_t row = (size_t)((tid >> 8) ? pmB : pmA) * 256 + (tid & 255); rtab[tid] = rinv_of(ss, row); }
};
__device__ __forceinline__ RinvPre rinv_prepass(const float* ss, const pg8::StaticOrder& S, LAS unsigned char* lds) {
    pg8::Unit u; int n = 0; while (S.next(n, u)) ++n;
    RinvPre p{ss, 0, 0, (LAS float*)(lds + RTAB_OFF)};
    if (n == 0) return p;
    S.next(0, u); p.pmA = u.pm; S.next(n - 1, u); p.pmB = u.pm;
    return p;
}
struct RevOrder : pg8::StaticOrder {
    int n;
    __device__ void init_rev(int M, int N, int G_, int c_) { init(M, N, G_, c_); pg8::Unit u; n = 0; while (pg8::StaticOrder::next(n, u)) ++n; }
    __device__ bool next(int i, pg8::Unit& u) const { return i < n ? pg8::StaticOrder::next(n - 1 - i, u) : false; }
};
struct BMid { LAS unsigned char* lds; const bf16* Bt; int K, pn; __device__ __forceinline__ void operator()() const { pg8::stage_b_first(lds, Bt, K, pn); } };
__device__ __forceinline__ int first_pn_static(int M, int N, int G, int c) { pg8::StaticOrder S; S.init(M, N, G, c); pg8::Unit u; return S.next(0, u) ? u.pn : 0; }
__device__ __forceinline__ int first_pn_rev(int M, int N, int G, int c) { RevOrder S; S.init_rev(M, N, G, c); pg8::Unit u; return S.next(0, u) ? u.pn : 0; }
#ifdef PROBE_CLK
#define CK_BEGIN() do { if (tid == 0) { const unsigned long long c_ = __builtin_readcyclecounter(), r_ = __builtin_amdgcn_s_memrealtime(); MISC[0] = (unsigned)c_; MISC[1] = (unsigned)(c_ >> 32); MISC[2] = (unsigned)r_; MISC[3] = (unsigned)(r_ >> 32); } } while (0)
#define CK_END(w) do { if (tid == 0) { const unsigned long long c1_ = __builtin_readcyclecounter(), r1_ = __builtin_amdgcn_s_memrealtime(); \
        const unsigned long long c0_ = (unsigned long long)MISC[0] | ((unsigned long long)MISC[1] << 32), r0_ = (unsigned long long)MISC[2] | ((unsigned long long)MISC[3] << 32); \
        MISC[w] = (unsigned)(((c1_ - c0_) * 100ull) / (r1_ - r0_)); MISC[(w) - 2] = (unsigned)(r1_ - r0_); } } while (0)
#define CK_SPIN() do { if (tid == 0) { const unsigned f1_ = MISC[12], f4_ = MISC[13]; const unsigned long long ticks_ = (PROBE_CLK == 7) ? (unsigned long long)MISC[11] : (PROBE_CLK == 8) ? (unsigned long long)MISC[15] : (PROBE_CLK >= 4) ? (unsigned long long)MISC[14] : (PROBE_CLK >= 2) ? ((unsigned long long)MISC[11] + 40000ull * (unsigned long long)(MISC[14] / 100u)) : ((unsigned long long)f1_ + 3000ull * (unsigned long long)((f4_ + 25u) / 50u)) * 100ull;     \
        const unsigned long long t0_ = __builtin_amdgcn_s_memrealtime(); while (__builtin_amdgcn_s_memrealtime() - t0_ < ticks_) __builtin_amdgcn_s_sleep(8); } } while (0)
#else
#define CK_BEGIN() do { } while (0)
#define CK_END(w) do { } while (0)
#define CK_SPIN() do { } while (0)
#endif
#ifndef PG8_ALIGN
#define PG8_ALIGN true
#endif
#ifndef PG8_SP2
#define PG8_SP2 true
#endif
__global__ void __launch_bounds__(NTHREADS, 2) mk_fwd(Args a) {
    extern __shared__ __attribute__((aligned(16))) unsigned char lds_raw[];
    cg::grid_group grid = cg::this_grid();
    LAS unsigned char* lds = (LAS unsigned char*)lds_raw;
    const int tid = threadIdx.x;
    unsigned char* ws = a.ws;
    const int lo = a.ph_lo, hi = a.ph_hi, G = gridDim.x;
    bf16 *W1T = (bf16*)(ws + WS_W1T), *W2T = (bf16*)(ws + WS_W2T), *W3T = (bf16*)(ws + WS_W3T), *W4T = (bf16*)(ws + WS_W4T), *W5T = (bf16*)(ws + WS_W5T), *W6T = (bf16*)(ws + WS_W6T);
    float* tab = (float*)(ws + WS_ROPE); float* ss0 = (float*)(ws + WS_SS); float* ss1 = ss0 + (size_t)MTOK * 16; float* ss2 = ss1 + (size_t)MTOK * 16;
    bf16 *XB = (bf16*)(ws + WS_XB), *Y = (bf16*)(ws + WS_Y), *ACT = (bf16*)(ws + WS_ACT);
    bf16 *Qb = ACT, *Kb = ACT + 512, *Vb = ACT + 1024, *XR = ACT + 1536, *GATE = ACT + 2048;
    float* out = a.out;
#ifndef PROBE_DUP
#define PROBE_DUP -1
#endif
#define REP(k) for (int rep_ = 0; rep_ < ((PROBE_DUP) == (k) ? 2 : 1); ++rep_)
#define REPSYNC() do { if (rep_) xcd_barrier(bar); } while (0)
#define IN(k) (lo <= (k) && (k) < hi)
    volatile LAS unsigned* MISC = (volatile LAS unsigned*)(lds + MISC_OFF);
    if (tid < 16) MISC[tid] = 0u;
    __syncthreads();
    XcdBarrier bar = xcd_barrier_post((unsigned*)(ws + WS_CTL) + CW_BAR, MISC + 8);
    if (tid == 0) __hip_atomic_store((unsigned*)(ws + WS_CTL) + CW_BAR + XL_TABLE + blockIdx.x, bar.x + 1u, __ATOMIC_RELAXED, __HIP_MEMORY_SCOPE_AGENT);
    const unsigned pgrp = ((unsigned)blockIdx.x & 7u) * 8u + (((unsigned)blockIdx.x >> 3) & 7u);
    bool split_b = false;
    bool local_ok = false;
#ifndef MK_LOCAL_SEAMS
#define MK_LOCAL_SEAMS 1
#endif
#ifndef MK_GROUP_SEAMS
#define MK_GROUP_SEAMS 1
#endif
#ifndef MK_CG_SEAM0
#define MK_CG_SEAM0 0
#endif
#define SEAMX(k, MID) do { if (IN(k) && IN((k) + 1)) { if (MK_CG_SEAM0 && (k) == 0) grid.sync(); else if (MK_LOCAL_SEAMS && local_ok && MK_GROUP_SEAMS && ((k) == 1 || (k) == 2 || (k) == 5 || (k) == 6)) panel_group_barrier(bar, pgrp, MID); else if (MK_LOCAL_SEAMS && local_ok && (k) >= 1) xcd_local_barrier(bar, MID); else xcd_barrier(bar, MID); } } while (0)
#define SEAM(k) SEAMX(k, NoMid())
#define BPRE(k) (IN(k) && IN((k) + 1) && !(MK_CG_SEAM0 && (k) == 0))

    const BMid mid1{lds, W1T, DM, first_pn_static(MTOK, NFF, G, (int)blockIdx.x)};
    if (G == 256 && lo == 0 && hi > 2 && !MK_CG_SEAM0) {
        p0_prologue(a, lds, tid, 0, 2, false);
        xcd_split_arrive(bar, 0);
        p0_rows_own(a, tid);
        p0_prologue(a, lds, tid, 2, 1 << 20, false);
        xcd_split_arrive(bar, 1);
        xcd_split_wait(bar, 0, 0);
        __syncthreads();
        if (MK_LOCAL_SEAMS) {
            const unsigned* tblx = (const unsigned*)(ws + WS_CTL) + CW_BAR + XL_TABLE;
            bool okt = true;
            if (tid < 256) { const unsigned mine = __hip_atomic_load(tblx + tid, __ATOMIC_RELAXED, __HIP_MEMORY_SCOPE_AGENT), lead = __hip_atomic_load(tblx + (tid & 7), __ATOMIC_RELAXED, __HIP_MEMORY_SCOPE_AGENT); okt = (mine == lead) && mine != 0u;
                if (tid < 8) { for (int j = 0; j < 8; ++j) if (j != tid && __hip_atomic_load(tblx + j, __ATOMIC_RELAXED, __HIP_MEMORY_SCOPE_AGENT) == mine) okt = false; } }
            local_ok = __syncthreads_and(okt ? 1 : 0) != 0;
        }
        if (MK_LOCAL_SEAMS && local_ok && MK_GROUP_SEAMS) panel_group_barrier(bar, pgrp, mid1); else xcd_barrier(bar, mid1);
        split_b = true;
    } else {
        if (IN(0)) { p0_prologue(a, lds, tid, 0, 1 << 20, true); }
        SEAMX(0, mid1);
    }
#ifdef PROBE_SYNCS
    for (int i_ = 0; i_ < PROBE_SYNCS; ++i_) xcd_barrier(bar);
#endif
    if (IN(1)) REP(1) { REPSYNC(); pg8::Gemm g{XB, W1T, MTOK, NFF, DM}; pg8::StaticOrder S; S.init(MTOK, NFF, G, (int)blockIdx.x);
        const RinvPre rp = rinv_prepass(ss0, S, lds); pg8::EpiSwiglu E{ACT, (const LAS float*)(lds + RTAB_OFF), rp.pmA}; CK_BEGIN(); pg8::gemm_phase<pg8::EpiSwiglu, pg8::StaticOrder, PG8_ALIGN, PG8_SP2, RinvPre>(lds, g, S, E, rp, BPRE(0)); CK_END(12); }
    if (split_b) xcd_split_wait(bar, 1, 64);
    { const BMid mid{lds, W2T, DFF, first_pn_rev(MTOK, DM, G, (int)blockIdx.x)}; SEAMX(1, mid); }
    if (IN(2)) REP(2) { REPSYNC(); pg8::Gemm g{ACT, W2T, MTOK, DM, DFF}; RevOrder S; S.init_rev(MTOK, DM, G, (int)blockIdx.x);
        pg8::EpiResid<true, true> E{nullptr, XB, nullptr, ss1, 0.5f}; pg8::gemm_phase<pg8::EpiResid<true, true>, RevOrder, PG8_ALIGN, PG8_SP2>(lds, g, S, E, pg8::NoPre(), BPRE(1)); }
    { const BMid mid{lds, W3T, DM, first_pn_static(MTOK, NPROJ, G, (int)blockIdx.x)}; SEAMX(2, mid); }
    if (IN(3)) REP(3) { REPSYNC(); pg8::Gemm g{XB, W3T, MTOK, NPROJ, DM}; pg8::StaticOrder S; S.init(MTOK, NPROJ, G, (int)blockIdx.x);
        const RinvPre rp = rinv_prepass(ss1, S, lds); pg8::EpiProj E{(const LAS float*)(lds + RTAB_OFF), rp.pmA, tab, a.in[7], a.in[8], Qb, 0.125f * 1.4426950408889634f}; pg8::gemm_phase<pg8::EpiProj, pg8::StaticOrder, PG8_ALIGN, PG8_SP2, RinvPre>(lds, g, S, E, rp, BPRE(2)); }
    if (IN(3) && IN(4)) {
        const int vcu0 = (G % 8 == 0) ? ((int)blockIdx.x % 8) * (G / 8) + (int)blockIdx.x / 8 : (int)blockIdx.x;
        if (vcu0 < BATCH * 16) rnn::rnn_consts((vcu0 >> 1) & 7, vcu0 & 1, a.in[14], a.in[15], a.in[16], a.in[17], a.in[18], a.in[19], a.in[20], lds);
        const int l64 = tid & 63;
        float d1 = a.in[9][l64] * a.in[10][l64], d2 = a.in[11][l64] * a.in[12][l64], gq = fabsf(a.in[7][l64]), gk = fabsf(a.in[8][l64]);
        d1 = wave_sum(d1); d2 = wave_sum(d2);
#pragma unroll
        for (int o_ = 1; o_ < 64; o_ <<= 1) { gq = fmaxf(gq, __shfl_xor(gq, o_)); gk = fmaxf(gk, __shfl_xor(gk, o_)); }
        if (tid == 0) { MISC[4] = __float_as_uint(expf(d1) - expf(d2) + LAMBDA_INIT); MISC[5] = __float_as_uint(-8.0f * gq * gk * 1.4426950408889634f); }
    }
    SEAM(3);
    if (IN(4)) {
#ifdef PROBE_CLK
        if (tid == 0) { const unsigned long long r_ = __builtin_amdgcn_s_memrealtime(); MISC[6] = (unsigned)r_; MISC[7] = (unsigned)(r_ >> 32); }
#endif
        const int vcu = (G % 8 == 0) ? ((int)blockIdx.x % 8) * (G / 8) + (int)blockIdx.x / 8 : (int)blockIdx.x;
        if (lo > 3) { for (int u = vcu; u < BATCH * 16; u += G) rnn::rnn_unit<false>(u >> 4, (u >> 1) & 7, u & 1, XR, GATE, Y, a.in[14], a.in[15], a.in[16], a.in[17], a.in[18], a.in[19], a.in[20], lds);
            if (tid == 0) { MISC[4] = 0x7fc00000u; MISC[5] = 0x7fc00000u; } __syncthreads(); }
        else { if (vcu < BATCH * 16) rnn::rnn_unit<true>(vcu >> 4, (vcu >> 1) & 7, vcu & 1, XR, GATE, Y, a.in[14], a.in[15], a.in[16], a.in[17], a.in[18], a.in[19], a.in[20], lds);
            for (int u = vcu + G; u < BATCH * 16; u += G) rnn::rnn_unit<false>(u >> 4, (u >> 1) & 7, u & 1, XR, GATE, Y, a.in[14], a.in[15], a.in[16], a.in[17], a.in[18], a.in[19], a.in[20], lds); }
        const float lam = __uint_as_float(MISC[4]), negm_s = __uint_as_float(MISC[5]);
#ifdef PROBE_CLK
        if (tid == 0) { const unsigned long long r0_ = (unsigned long long)MISC[6] | ((unsigned long long)MISC[7] << 32); MISC[15] = (unsigned)(__builtin_amdgcn_s_memrealtime() - r0_); }
#endif
        CK_BEGIN();
        REP(42) for (int v = vcu; v < 256; v += G) {
            const int bh = v >> 2, s = v & 3;
            for (int i = 0; i < 4; ++i) { const int cc = (i == 0) ? s : (i == 1) ? 7 - s : (i == 2) ? 8 + s : 15 - s;
                attn::attn_unit(bh >> 2, bh & 3, cc, Qb, Kb, Vb, Y, lam, negm_s, a.in[13], lds); }
        }
        CK_END(13);
        __syncthreads();
    }
    { const BMid mid{lds, W4T, DM, first_pn_static(MTOK, DM, G, (int)blockIdx.x)}; SEAMX(4, mid); }
    if (IN(5)) { pg8::Gemm g{Y, W4T, MTOK, DM, DM}; pg8::StaticOrder S; S.init(MTOK, DM, G, (int)blockIdx.x);
        pg8::EpiResid<true, true> E{nullptr, XB, nullptr, ss2, 1.0f}; pg8::gemm_phase<pg8::EpiResid<true, true>, pg8::StaticOrder, PG8_ALIGN, PG8_SP2>(lds, g, S, E, pg8::NoPre(), BPRE(4)); }
    { const BMid mid{lds, W5T, DM, first_pn_static(MTOK, NFF, G, (int)blockIdx.x)}; SEAMX(5, mid); }
    if (IN(6)) REP(6) { REPSYNC(); pg8::Gemm g{XB, W5T, MTOK, NFF, DM}; pg8::StaticOrder S; S.init(MTOK, NFF, G, (int)blockIdx.x);
        const RinvPre rp = rinv_prepass(ss2, S, lds); pg8::EpiSwiglu E{ACT, (const LAS float*)(lds + RTAB_OFF), rp.pmA}; pg8::gemm_phase<pg8::EpiSwiglu, pg8::StaticOrder, PG8_ALIGN, PG8_SP2, RinvPre>(lds, g, S, E, rp, BPRE(5)); }
    { const BMid mid{lds, W6T, DFF, first_pn_rev(MTOK, DM, G, (int)blockIdx.x)}; SEAMX(6, mid); }
    if (IN(7)) { pg8::Gemm g{ACT, W6T, MTOK, DM, DFF}; RevOrder S; S.init_rev(MTOK, DM, G, (int)blockIdx.x);
        pg8::EpiResid<true, false> E{nullptr, XB, out, nullptr, 0.5f}; pg8::gemm_phase<pg8::EpiResid<true, false>, RevOrder, PG8_ALIGN, PG8_SP2>(lds, g, S, E, pg8::NoPre(), BPRE(6)); }
    CK_SPIN();
#undef IN
#undef SEAM
#undef SEAMX
#undef BPRE
}

extern "C" void kernel_launch(void* const* d_in, const int* in_sizes, int n_in, void* d_out, int out_size, void* d_ws, size_t ws_size, hipStream_t stream) {
    static int grid_blocks = 0;
    if (grid_blocks == 0) {
        if (n_in != 25 || in_sizes[0] != MTOK * DM || out_size != MTOK * DM || ws_size < WS_END) { fprintf(stderr, "kernel_launch: unexpected shapes (n_in %d, ws %zu)\n", n_in, ws_size); grid_blocks = -1; return; }
        int dev = 0, cus = 0, per_cu = 0;
        if (hipGetDevice(&dev) != hipSuccess || hipDeviceGetAttribute(&cus, hipDeviceAttributeMultiprocessorCount, dev) != hipSuccess) { grid_blocks = -1; return; }
        if (hipFuncSetAttribute((const void*)mk_fwd, hipFuncAttributeMaxDynamicSharedMemorySize, LDS_BYTES) != hipSuccess) { fprintf(stderr, "kernel_launch: hipFuncSetAttribute failed\n"); grid_blocks = -1; return; }
        if (hipOccupancyMaxActiveBlocksPerMultiprocessor(&per_cu, (const void*)mk_fwd, NTHREADS, LDS_BYTES) != hipSuccess || per_cu < 1) { fprintf(stderr, "kernel_launch: occupancy query says %d blocks/CU\n", per_cu); grid_blocks = -1; return; }
        if (cus != 256) { fprintf(stderr, "kernel_launch: built for a 256-CU device (MI355X), found %d CUs; nothing launched\n", cus); grid_blocks = -1; return; }
        grid_blocks = 256;
    }
    if (grid_blocks < 0) return;
    if (hipMemsetAsync((char*)d_ws + WS_CTL, 0, CTL_ZERO_BYTES, stream) != hipSuccess) { fprintf(stderr, "kernel_launch: hipMemsetAsync failed\n"); return; }
    Args a{};
    for (int i = 0; i < 25; ++i) a.in[i] = (const float*)d_in[i];
    a.out = (float*)d_out; a.ws = (unsigned char*)d_ws;
    for (int j = 0; j < 8; ++j) a.invf[j] = (float)pow(500000.0, -(double)j / 8.0);
    a.ph_lo = 0; a.ph_hi = 8;
    void* args[] = {&a};
    hipError_t e = hipLaunchCooperativeKernel((const void*)mk_fwd, dim3(grid_blocks), dim3(NTHREADS), args, LDS_BYTES, stream);
    if (e != hipSuccess) fprintf(stderr, "cooperative launch failed: %s (grid %d)\n", hipGetErrorString(e), grid_blocks);
}
```

```cpp
#include <hip/hip_runtime.h>
#include <hip/hip_cooperative_groups.h>
#include <cstdio>
#include <cstdint>
#include <cmath>
namespace cg = cooperative_groups;

constexpr int DM = 1024, BATCH = 16, SEQ = 2048, MTOK = BATCH * SEQ;
constexpr int DFF = 2816, NFF = 2 * DFF, DATTN = 512, DRNN = 512, NPROJ = 2560;
constexpr int PQ = DFF;
constexpr float EPS = 1e-6f;
constexpr float LAMBDA_INIT = 0.2f;

typedef unsigned short bf16;
#define LAS __attribute__((address_space(3)))
typedef unsigned v4u __attribute__((ext_vector_type(4)));
typedef float v4f __attribute__((ext_vector_type(4)));

__device__ __forceinline__ unsigned f2bf(float f) { unsigned u = __builtin_bit_cast(unsigned, f); return (u + 0x7fffu + ((u >> 16) & 1u)) >> 16; }
typedef float f32x2_h __attribute__((ext_vector_type(2))); typedef __bf16 bf16x2_h __attribute__((ext_vector_type(2)));
__device__ __forceinline__ unsigned pk2(float lo, float hi) { const f32x2_h v = {lo, hi}; return __builtin_bit_cast(unsigned, __builtin_convertvector(v, bf16x2_h)); }
__device__ __forceinline__ float bf2f(bf16 h) { return __builtin_bit_cast(float, (unsigned)h << 16); }
__device__ __forceinline__ float wave_sum(float v) {
#pragma unroll
    for (int o = 1; o < 64; o <<= 1) v += __shfl_xor(v, o);
    return v;
}
__device__ __forceinline__ float rinv_of(const float* ss, size_t row) {
    const v4f* p = (const v4f*)(ss + row * 16); const v4f a = p[0], b = p[1], c = p[2], d = p[3];
    const float s = ((a.x + a.y) + (a.z + a.w)) + ((b.x + b.y) + (b.z + b.w)) + ((c.x + c.y) + (c.z + c.w)) + ((d.x + d.y) + (d.z + d.w));
    return 1.0f / sqrtf(s * (1.0f / DM) + EPS);
}

__device__ __forceinline__ float rinv_fq(const float* ss, size_t row, int fq) {
    const v4f a = *(const v4f*)(ss + row * 16 + 4 * fq); float s = (a.x + a.y) + (a.z + a.w);
    s += __shfl_xor(s, 16); s += __shfl_xor(s, 32);
    return 1.0f / sqrtf(s * (1.0f / DM) + EPS);
}

constexpr size_t MiB = 1u << 20;
constexpr size_t WS_CTL = 0;
constexpr size_t WS_W1T = 1 * MiB;
constexpr size_t WS_W2T = 12 * MiB;
constexpr size_t WS_W3T = 18 * MiB;
constexpr size_t WS_W4T = 23 * MiB;
constexpr size_t WS_W5T = 25 * MiB;
constexpr size_t WS_W6T = 36 * MiB;
constexpr size_t WS_ROPE = 42 * MiB;
constexpr size_t WS_SS = 44 * MiB;
constexpr size_t WS_XB = 50 * MiB;
constexpr size_t WS_Y = 114 * MiB;
constexpr size_t WS_ACT = 178 * MiB;
constexpr size_t WS_END = 354 * MiB;

namespace pg8 {
#define PG8_LAS __attribute__((address_space(3)))
typedef unsigned short bf16_t;
typedef short bf16x8 __attribute__((ext_vector_type(8)));
typedef float f32x4 __attribute__((ext_vector_type(4)));
typedef unsigned u32x4 __attribute__((ext_vector_type(4)));
constexpr int BM = 256, BK = 64, HALF = 128, HTB = HALF * BK * 2  , STAGE_BYTES = 8 * HTB, NXCD = 8, WGM = 8;

__host__ __device__ __forceinline__ int lds_byte(int r, int c) { const int st = (r >> 4) * 2 + (c >> 5), rr = r & 15, cc = c & 31, ob = rr * 64 + cc * 2; return st * 1024 + (ob ^ (((ob >> 9) & 1) << 5)); }
__host__ __device__ __forceinline__ void stage_rc(int b, int& R, int& C) { const int st = b / 1024, sb = b % 1024, swz = sb ^ (((sb >> 9) & 1) << 5); R = (st >> 1) * 16 + swz / 64; C = (st & 1) * 32 + (swz % 64) / 2; }
__host__ __device__ __forceinline__ int perm32(int rho) { const int n = rho >> 4, i = rho & 15; return 8 * (i >> 2) + 4 * n + (i & 3); }

struct Unit { int pm, pn; };
struct Gemm { const bf16_t* A; const bf16_t* Bt; int M, N, K; };

struct StaticOrder {
    int nM, nN, nwg, G, c;
    __host__ __device__ void init(int M, int N, int G_, int c_) { nM = M / BM; nN = N / BM; nwg = nM * nN; G = G_; c = c_; }
    __host__ __device__ bool next(int i, Unit& u) const {
        const long L = (long)i * G + c; if (L >= nwg) return false;
        int wgid = (int)L; { const int q = nwg / NXCD, r = nwg % NXCD, xcd = wgid % NXCD, off = wgid / NXCD; wgid = (xcd < r ? xcd * (q + 1) : r * (q + 1) + (xcd - r) * q) + off; }
        const int nig = WGM * nN, gid = wgid / nig, fm = gid * WGM, gsz = (nM % WGM == 0) ? WGM : ((nM - fm) < WGM ? (nM - fm) : WGM);
        u.pm = fm + ((wgid % nig) % gsz); u.pn = (wgid % nig) / gsz; return true;
    }
    __device__ __forceinline__ void a_ready(const Unit&) const {}
    __device__ __forceinline__ void done(const Unit&) const {}
};
__device__ __forceinline__ unsigned cvt_pk_bf16(float lo, float hi) { unsigned r; asm volatile("v_cvt_pk_bf16_f32 %0, %1, %2" : "=v"(r) : "v"(lo), "v"(hi)); return r; }
struct EpiSwiglu {
    static constexpr bool PERM = true, AFTER_DRAIN = false;
    bf16_t* act; const PG8_LAS float* rtab; int pmA;
    __device__ __forceinline__ void operator()(const f32x4 (&acc)[2][2][4][2], const Unit& u, int wr, int wc, int fr, int fq) const {
        const int row0 = u.pm * BM + wr * 64 + fr, col0 = (21 - u.pn) * 128 + wc * 32 + 8 * fq;
        const PG8_LAS float* rt = rtab + (u.pm == pmA ? 0 : 256) + wr * 64 + fr;
        float rv[8];
#pragma unroll
        for (int i = 0; i < 8; ++i) rv[i] = rt[(i >> 2) * HALF + (i & 3) * 16];
        bf16_t* const rowp = act + (size_t)row0 * DFF + col0;
#pragma unroll
        for (int ai = 0; ai < 2; ++ai)
#pragma unroll
            for (int m = 0; m < 4; ++m) {
                const float r = rv[ai * 4 + m];
                const float nr = -1.4426950408889634f * r, ir2 = __builtin_amdgcn_rcpf(r * r);
                unsigned w[4];
#pragma unroll
                for (int n = 0; n < 2; ++n) {
                    typedef float f2 __attribute__((ext_vector_type(2)));
                    const f32x4 g = acc[ai][0][m][n], uu = acc[ai][1][m][n];
                    const f2 ga = {g[0], g[1]}, gb = {g[2], g[3]}, ua = {uu[0], uu[1]}, ub = {uu[2], uu[3]};
                    const f2 ta = ga * nr, tb = gb * nr;
                    f2 ea, eb; ea.x = __builtin_amdgcn_exp2f(ta.x); ea.y = __builtin_amdgcn_exp2f(ta.y); eb.x = __builtin_amdgcn_exp2f(tb.x); eb.y = __builtin_amdgcn_exp2f(tb.y);
                    const f2 da = ea * ir2 + ir2, db = eb * ir2 + ir2;
                    f2 ia, ib; ia.x = __builtin_amdgcn_rcpf(da.x); ia.y = __builtin_amdgcn_rcpf(da.y); ib.x = __builtin_amdgcn_rcpf(db.x); ib.y = __builtin_amdgcn_rcpf(db.y);
                    const f2 ha = (ga * ua) * ia, hb = (gb * ub) * ib;
                    w[2 * n] = cvt_pk_bf16(ha.x, ha.y); w[2 * n + 1] = cvt_pk_bf16(hb.x, hb.y); }
                *(u32x4*)(rowp + (size_t)(ai * HALF + m * 16) * DFF) = (u32x4){w[0], w[1], w[2], w[3]};
            }
    }
};
template <bool IN_BF16, bool OUT_BF16> struct EpiResid {
    static constexpr bool PERM = true, AFTER_DRAIN = false;
    const float* xin; bf16_t* xb; float* out; float* ssout; float alpha;
    __device__ __forceinline__ void operator()(const f32x4 (&acc)[2][2][4][2], const Unit& u, int wr, int wc, int fr, int fq) const {
        const int row0 = u.pm * BM + wr * 64 + fr, col0 = u.pn * BM + wc * 32 + 8 * fq;
        bf16_t* const xrow0 = xb + (size_t)row0 * DM + col0;
        float* const orow0 = OUT_BF16 ? nullptr : out + (size_t)row0 * DM + col0;
        float* const ssrow0 = OUT_BF16 ? ssout + (size_t)row0 * 16 + 4 * u.pn + wc : nullptr;
        u32x4 w[2][4][2];
        if (IN_BF16) {
#pragma unroll
            for (int ai = 0; ai < 2; ++ai)
#pragma unroll
                for (int m = 0; m < 4; ++m)
#pragma unroll
                    for (int bj = 0; bj < 2; ++bj) w[ai][m][bj] = *(const u32x4*)(xrow0 + (size_t)(ai * HALF + m * 16) * DM + bj * HALF);
        }
#pragma unroll
        for (int ai = 0; ai < 2; ++ai)
#pragma unroll
            for (int m = 0; m < 4; ++m) {
                const size_t row = (size_t)(row0 + ai * HALF + m * 16); float s = 0.f;
                typedef float f2 __attribute__((ext_vector_type(2)));
                f2 s2 = {0.f, 0.f};
#pragma unroll
                for (int bj = 0; bj < 2; ++bj) { const size_t p = row * DM + col0 + bj * HALF; const size_t po = (size_t)(ai * HALF + m * 16) * DM + bj * HALF;
                    f32x4 x0, x1;
                    if (IN_BF16) { const u32x4 wv = w[ai][m][bj];
                        x0 = (f32x4){__builtin_bit_cast(float, wv[0] << 16), __builtin_bit_cast(float, wv[0] & 0xffff0000u), __builtin_bit_cast(float, wv[1] << 16), __builtin_bit_cast(float, wv[1] & 0xffff0000u)};
                        x1 = (f32x4){__builtin_bit_cast(float, wv[2] << 16), __builtin_bit_cast(float, wv[2] & 0xffff0000u), __builtin_bit_cast(float, wv[3] << 16), __builtin_bit_cast(float, wv[3] & 0xffff0000u)}; }
                    else { x0 = __builtin_nontemporal_load((const f32x4*)(xin + p)); x1 = __builtin_nontemporal_load((const f32x4*)(xin + p + 4)); }
                    const f32x4 v0 = x0 + alpha * acc[ai][bj][m][0], v1 = x1 + alpha * acc[ai][bj][m][1];
                    if (OUT_BF16) { *(u32x4*)(xrow0 + po) = (u32x4){cvt_pk_bf16(v0[0], v0[1]), cvt_pk_bf16(v0[2], v0[3]), cvt_pk_bf16(v1[0], v1[1]), cvt_pk_bf16(v1[2], v1[3])};
                        { const f2 a = {v0[0], v0[1]}, b = {v0[2], v0[3]}, c = {v1[0], v1[1]}, d = {v1[2], v1[3]}; s2 = a * a + s2; s2 = b * b + s2; s2 = c * c + s2; s2 = d * d + s2; } }
                    else { __builtin_nontemporal_store(v0, (f32x4*)(orow0 + po)); __builtin_nontemporal_store(v1, (f32x4*)(orow0 + po + 4)); } }
                if (OUT_BF16) { s = s2.x + s2.y; s += __shfl_xor(s, 16); s += __shfl_xor(s, 32); if (fq == 0) ssrow0[(size_t)(ai * HALF + m * 16) * 16] = s; }
            }
    }
};
#ifndef EPI_ROPE_AHEAD
#define EPI_ROPE_AHEAD 1
#endif
struct EpiProj {
    static constexpr bool PERM = true, AFTER_DRAIN = false;
    const PG8_LAS float* rtab; int pmA; const float* tab; const float* qn; const float* kn; bf16_t* qkv; float qscale; const float* ident;
    __device__ __forceinline__ void operator()(const f32x4 (&acc)[2][2][4][2], const Unit& u, int wr, int wc, int fr, int fq) const {
        const int row0 = u.pm * BM + wr * 64 + fr, kind = u.pn >> 1, half = u.pn & 1;
        const PG8_LAS float* rt = rtab + (u.pm == pmA ? 0 : 256) + wr * 64 + fr;
        bf16_t* base = qkv + kind * 512;
        if (kind >= 2) {
            const int col0 = half * 256 + wc * 32 + 8 * fq;
            bf16_t* const brow0 = base + (size_t)row0 * PQ + col0;
            float rv[8];
#pragma unroll
            for (int i = 0; i < 8; ++i) rv[i] = rt[(i >> 2) * HALF + (i & 3) * 16];
#pragma unroll
            for (int ai = 0; ai < 2; ++ai)
#pragma unroll
                for (int m = 0; m < 4; ++m) { const float r = rv[ai * 4 + m];
#pragma unroll
                    for (int bj = 0; bj < 2; ++bj) { const f32x4 v0 = acc[ai][bj][m][0] * r, v1 = acc[ai][bj][m][1] * r;
                        *(u32x4*)(brow0 + (size_t)(ai * HALF + m * 16) * PQ + bj * HALF) = (u32x4){cvt_pk_bf16(v0[0], v0[1]), cvt_pk_bf16(v0[2], v0[3]), cvt_pk_bf16(v1[0], v1[1]), cvt_pk_bf16(v1[2], v1[3])}; } }
        } else {
            const int g = 4 * half + wc; const float* gp = kind == 0 ? qn : kn; const float sc = kind == 0 ? qscale : 1.0f;
            bf16_t* const hrow0 = base + (size_t)row0 * PQ + 64 * g;
            const bool rot = fq < 2; const int d00 = rot ? 4 * fq : 8 * fq, d01 = rot ? 8 + 4 * fq : 8 * fq + 4;
            f32x4 gn[2][2];
            gn[0][0] = *(const f32x4*)(gp + d00); gn[0][1] = *(const f32x4*)(gp + d01); gn[1][0] = *(const f32x4*)(gp + 32 + 8 * fq); gn[1][1] = *(const f32x4*)(gp + 36 + 8 * fq);
            constexpr int AH = EPI_ROPE_AHEAD;
            const float* tcs = (rot ? tab + (size_t)row0 * 16 : ident) + 4 * (fq & 1);
            f32x4 csq[AH + 1], snq[AH + 1];
#pragma unroll
            for (int i = 0; i < AH; ++i) { const size_t ro = (size_t)((i >> 2) * HALF + (i & 3) * 16) * 16; csq[i] = *(const f32x4*)(tcs + ro); snq[i] = *(const f32x4*)(tcs + ro + 8); }
            float nr[8];
#pragma unroll
            for (int ai = 0; ai < 2; ++ai)
#pragma unroll
                for (int m = 0; m < 4; ++m) { typedef float f2 __attribute__((ext_vector_type(2))); f2 s2 = {0.f, 0.f};
#pragma unroll
                    for (int bj = 0; bj < 2; ++bj)
#pragma unroll
                        for (int n = 0; n < 2; ++n) { const f32x4 a4 = acc[ai][bj][m][n]; const f2 a = {a4[0], a4[1]}, b = {a4[2], a4[3]}; s2 = a * a + s2; s2 = b * b + s2; }
                    nr[ai * 4 + m] = s2.x + s2.y; }
#pragma unroll
            for (int i = 0; i < 8; ++i) nr[i] += __shfl_xor(nr[i], 16);
#pragma unroll
            for (int i = 0; i < 8; ++i) nr[i] += __shfl_xor(nr[i], 32);
#pragma unroll
            for (int i = 0; i < 8; ++i) { const float r = rt[(i >> 2) * HALF + (i & 3) * 16]; nr[i] = r * sc * __builtin_amdgcn_rsqf(nr[i] * (r * r) * (1.0f / 64.0f) + EPS); }
#pragma unroll
            for (int ai = 0; ai < 2; ++ai)
#pragma unroll
                for (int m = 0; m < 4; ++m) { const size_t row = (size_t)(row0 + ai * HALF + m * 16);
                    { const int i = ai * 4 + m + AH; if (i < 8) { const size_t ro = (size_t)((i >> 2) * HALF + (i & 3) * 16) * 16; csq[i % (AH + 1)] = *(const f32x4*)(tcs + ro); snq[i % (AH + 1)] = *(const f32x4*)(tcs + ro + 8); } }
                    const f32x4 cs = csq[(ai * 4 + m) % (AH + 1)], sn = snq[(ai * 4 + m) % (AH + 1)];
                    f32x4 v[2][2]; const float nrm = nr[ai * 4 + m];
#pragma unroll
                    for (int bj = 0; bj < 2; ++bj)
#pragma unroll
                        for (int n = 0; n < 2; ++n) v[bj][n] = acc[ai][bj][m][n] * nrm * gn[bj][n];
                    { const f32x4 x1 = v[0][0], x2 = v[0][1], o1 = x1 * cs - x2 * sn, o2 = x2 * cs + x1 * sn;
                      v[0][0] = o1; v[0][1] = o2; }
                    typedef unsigned u32x2e __attribute__((ext_vector_type(2)));
                    bf16_t* orow = hrow0 + (size_t)(ai * HALF + m * 16) * PQ;
                    *(u32x2e*)(orow + d00) = (u32x2e){cvt_pk_bf16(v[0][0][0], v[0][0][1]), cvt_pk_bf16(v[0][0][2], v[0][0][3])};
                    *(u32x2e*)(orow + d01) = (u32x2e){cvt_pk_bf16(v[0][1][0], v[0][1][1]), cvt_pk_bf16(v[0][1][2], v[0][1][3])};
                    *(u32x4*)(orow + 32 + 8 * fq) = (u32x4){cvt_pk_bf16(v[1][0][0], v[1][0][1]), cvt_pk_bf16(v[1][0][2], v[1][0][3]), cvt_pk_bf16(v[1][1][0], v[1][1][1]), cvt_pk_bf16(v[1][1][2], v[1][1][3])};
                }
        }
    }
};
struct NoPre { __device__ __forceinline__ void operator()() const {} };
__device__ __forceinline__ void stage_b_first(PG8_LAS unsigned char* lds, const bf16_t* Bt, int K, int pn) {
    const int tid = threadIdx.x, wid = __builtin_amdgcn_readfirstlane(tid >> 6);
    const size_t hstep = (size_t)HALF * K * 2; const char* cB = (const char*)Bt + (size_t)pn * 2 * hstep;
#pragma unroll
    for (int h = 0; h < 2; ++h)
#pragma unroll
        for (int i = 0; i < 2; ++i) { int R, C; stage_rc(tid * 16 + i * 8192, R, C); const int Rb = (R & ~31) + perm32(R & 31);
            __builtin_amdgcn_global_load_lds((const unsigned*)(cB + h * hstep + (size_t)(Rb * K + C) * 2u), (PG8_LAS unsigned*)(lds + (4 + h) * HTB + (unsigned)wid * 1024u + i * 8192), 16, 0, 0); }
}
template <class Epi, class Sched, bool ALIGN_EPI = false, bool SP2 = false, class Pre = NoPre>
__device__ __forceinline__ void gemm_phase(PG8_LAS unsigned char* lds, const Gemm g, const Sched& S, const Epi& E, const Pre& pre = Pre(), const bool bpre = false) {
    const int tid = threadIdx.x, wid = __builtin_amdgcn_readfirstlane(tid >> 6), lane = tid & 63, wr = wid >> 2, wc = wid & 3, fr = lane & 15, fq = lane >> 4;
    const int K = g.K, nt = K / BK;
    unsigned voffA[2], voffB[2];
#pragma unroll
    for (int i = 0; i < 2; ++i) { int R, C; stage_rc(tid * 16 + i * 8192, R, C); const int Rb = Epi::PERM ? ((R & ~31) + perm32(R & 31)) : R;
        voffA[i] = (unsigned)(R * K + C) * 2u; voffB[i] = (unsigned)(Rb * K + C) * 2u; }
    const size_t kstep = (size_t)(BK * 2);
    const size_t hstep = (size_t)HALF * K * 2;
    const size_t tstep = 2 * hstep;
    const unsigned ldsw = (unsigned)wid * 1024u;
    const int aoff = lds_byte(wr * 64 + fr, fq * 8), boff = lds_byte(wc * 32 + fr, fq * 8);
#define PG8_SA(b, h) (((b) * 2 + (h)) * HTB)
#define PG8_SB(b, h) ((4 + (b) * 2 + (h)) * HTB)
    const unsigned ldsw0 = (unsigned)__builtin_amdgcn_readfirstlane((unsigned)(uintptr_t)lds + (unsigned)wid * 1024u);
#define PG8_STAGE(bufoff, gbase, voff) do { _Pragma("unroll") for (int _i = 0; _i < 2; ++_i) { unsigned keep_; \
        asm volatile("s_mov_b32 %0, m0\n\ts_mov_b32 m0, %3\n\ts_nop 0\n\tglobal_load_lds_dwordx4 %1, %2\n\ts_mov_b32 m0, %0" : "=&s"(keep_) \
                     : "v"((voff)[_i]), "s"((const char*)(gbase)), "s"(ldsw0 + (unsigned)(bufoff) + (unsigned)(_i * 8192)) : "memory"); } } while (0)
#define PG8_LDA(dst, b, h) do { _Pragma("unroll") for (int m = 0; m < 4; ++m) _Pragma("unroll") for (int k = 0; k < 2; ++k) dst[m][k] = *(const PG8_LAS bf16x8*)(lds + PG8_SA(b, h) + aoff + m * 2048 + k * 1024); } while (0)
#define PG8_LDB(dst, b, h) do { _Pragma("unroll") for (int n = 0; n < 2; ++n) _Pragma("unroll") for (int k = 0; k < 2; ++k) dst[n][k] = *(const PG8_LAS bf16x8*)(lds + PG8_SB(b, h) + boff + n * 2048 + k * 1024); } while (0)
#define PG8_MMA(ai, bj, At, Bt) do { __builtin_amdgcn_s_setprio(1); _Pragma("unroll") for (int m = 0; m < 4; ++m) _Pragma("unroll") for (int n = 0; n < 2; ++n) _Pragma("unroll") for (int k = 0; k < 2; ++k) \
        acc[ai][bj][m][n] = __builtin_amdgcn_mfma_f32_16x16x32_bf16(Bt[n][k], At[m][k], acc[ai][bj][m][n], 0, 0, 0); __builtin_amdgcn_s_setprio(0); } while (0)
#define PG8_MMAZ(ai, bj, At, Bt) do { __builtin_amdgcn_s_setprio(1); _Pragma("unroll") for (int m = 0; m < 4; ++m) _Pragma("unroll") for (int n = 0; n < 2; ++n) { \
        acc[ai][bj][m][n] = __builtin_amdgcn_mfma_f32_16x16x32_bf16(Bt[n][0], At[m][0], (f32x4){0.f, 0.f, 0.f, 0.f}, 0, 0, 0); \
        acc[ai][bj][m][n] = __builtin_amdgcn_mfma_f32_16x16x32_bf16(Bt[n][1], At[m][1], acc[ai][bj][m][n], 0, 0, 0); } __builtin_amdgcn_s_setprio(0); } while (0)
#define PG8_WAIT_V(n) asm volatile("s_waitcnt vmcnt(" #n ")" ::: "memory")
#define PG8_WAIT_L(n) asm volatile("s_waitcnt lgkmcnt(" #n ")" ::: "memory")
#define PG8_BAR __builtin_amdgcn_s_barrier()
#define PG8_SCHED __builtin_amdgcn_sched_barrier(0)
    Unit cur, nxt; int ui = 0;
    if (!S.next(0, cur)) return;
    f32x4 acc[2][2][4][2];
#pragma unroll
    for (int a = 0; a < 2; ++a)
#pragma unroll
        for (int b = 0; b < 2; ++b)
#pragma unroll
            for (int m = 0; m < 4; ++m)
#pragma unroll
                for (int n = 0; n < 2; ++n) acc[a][b][m][n] = (f32x4){0.f, 0.f, 0.f, 0.f};
    bf16x8 At[4][2], B0[2][2], B1[2][2];
    const char* cA = (const char*)g.A + (size_t)cur.pm * tstep; const char* cB = (const char*)g.Bt + (size_t)cur.pn * tstep;
    S.a_ready(cur);
    if constexpr (SP2) {
        if (!bpre) { PG8_STAGE(PG8_SB(0, 0), cB, voffB); PG8_STAGE(PG8_SB(0, 1), cB + hstep, voffB); }
        PG8_STAGE(PG8_SA(0, 0), cA, voffA); PG8_STAGE(PG8_SA(0, 1), cA + hstep, voffA);
        pre();
        if (wr == 1) PG8_BAR;
        PG8_WAIT_V(2); PG8_BAR;
        PG8_STAGE(PG8_SB(1, 0), cB + kstep, voffB); PG8_STAGE(PG8_SA(1, 0), cA + kstep, voffA); PG8_STAGE(PG8_SB(1, 1), cB + hstep + kstep, voffB);
        PG8_WAIT_V(6); PG8_BAR;
    } else {
        PG8_STAGE(PG8_SB(0, 0), cB, voffB); PG8_STAGE(PG8_SA(0, 0), cA, voffA); PG8_STAGE(PG8_SB(0, 1), cB + hstep, voffB); PG8_STAGE(PG8_SA(0, 1), cA + hstep, voffA);
        if (wr == 1) PG8_BAR;
        PG8_WAIT_V(4); PG8_BAR;
        PG8_STAGE(PG8_SB(1, 0), cB + kstep, voffB); PG8_STAGE(PG8_SA(1, 0), cA + kstep, voffA); PG8_STAGE(PG8_SB(1, 1), cB + hstep + kstep, voffB);
        PG8_WAIT_V(6); PG8_BAR;
    }
    for (;;) {
        const bool has_next = S.next(ui + 1, nxt);
        const char* nA = has_next ? (const char*)g.A + (size_t)nxt.pm * tstep : cA; const char* nB = has_next ? (const char*)g.Bt + (size_t)nxt.pn * tstep : cB;
        { const int t = 0;
            const bool last = (t == nt - 2);
            const char* a1 = cA + (size_t)(t + 1) * kstep;
            const char* a2 = last ? nA : cA + (size_t)(t + 2) * kstep; const char* b2 = last ? nB : cB + (size_t)(t + 2) * kstep;
            const char* a3 = a2 + kstep; const char* b3 = b2 + kstep;
            if (last && has_next) S.a_ready(nxt);
            if constexpr (SP2) {
            PG8_LDB(B0, 0, 0); PG8_LDB(B1, 0, 1); PG8_SCHED; PG8_LDA(At, 0, 0); PG8_STAGE(PG8_SA(1, 1), a1 + hstep, voffA);
            PG8_WAIT_V(8); PG8_WAIT_L(0); PG8_BAR; PG8_MMAZ(0, 0, At, B0); PG8_MMAZ(0, 1, At, B1); PG8_BAR; PG8_SCHED;
            PG8_LDA(At, 0, 1); PG8_STAGE(PG8_SB(0, 0), b2, voffB); PG8_STAGE(PG8_SB(0, 1), b2 + hstep, voffB); PG8_STAGE(PG8_SA(0, 0), a2, voffA);
            PG8_WAIT_V(8); PG8_WAIT_L(0); PG8_BAR; PG8_MMAZ(1, 0, At, B0); PG8_MMAZ(1, 1, At, B1); PG8_BAR; PG8_SCHED;
            PG8_LDB(B0, 1, 0); PG8_LDB(B1, 1, 1); PG8_SCHED; PG8_LDA(At, 1, 0); PG8_STAGE(PG8_SA(0, 1), a2 + hstep, voffA);
            PG8_WAIT_V(8); PG8_WAIT_L(0); PG8_BAR; PG8_MMA(0, 0, At, B0); PG8_MMA(0, 1, At, B1); PG8_BAR; PG8_SCHED;
            PG8_LDA(At, 1, 1); PG8_STAGE(PG8_SB(1, 0), b3, voffB); PG8_STAGE(PG8_SB(1, 1), b3 + hstep, voffB); PG8_STAGE(PG8_SA(1, 0), a3, voffA);
            PG8_WAIT_V(8); PG8_WAIT_L(0); PG8_BAR; PG8_MMA(1, 0, At, B0); PG8_MMA(1, 1, At, B1); PG8_BAR; PG8_SCHED;
            } else {
            PG8_LDB(B0, 0, 0); PG8_SCHED; PG8_LDA(At, 0, 0); PG8_STAGE(PG8_SA(1, 1), a1 + hstep, voffA);
            PG8_WAIT_L(8); PG8_BAR; PG8_WAIT_L(0); PG8_MMAZ(0, 0, At, B0); PG8_BAR; PG8_SCHED;
            PG8_LDB(B1, 0, 1); PG8_STAGE(PG8_SB(0, 0), b2, voffB);
            PG8_BAR; PG8_WAIT_L(0); PG8_MMAZ(0, 1, At, B1); PG8_BAR;
            PG8_LDA(At, 0, 1); PG8_STAGE(PG8_SA(0, 0), a2, voffA);
            PG8_BAR; PG8_WAIT_L(0); PG8_MMAZ(1, 0, At, B0); PG8_BAR; PG8_SCHED;
            PG8_STAGE(PG8_SB(0, 1), b2 + hstep, voffB);
            PG8_WAIT_V(6); PG8_BAR; PG8_MMAZ(1, 1, At, B1); PG8_BAR;
            PG8_LDB(B0, 1, 0); PG8_SCHED; PG8_LDA(At, 1, 0); PG8_STAGE(PG8_SA(0, 1), a2 + hstep, voffA);
            PG8_WAIT_L(8); PG8_BAR; PG8_WAIT_L(0); PG8_MMA(0, 0, At, B0); PG8_BAR; PG8_SCHED;
            PG8_LDB(B1, 1, 1); PG8_STAGE(PG8_SB(1, 0), b3, voffB);
            PG8_BAR; PG8_WAIT_L(0); PG8_MMA(0, 1, At, B1); PG8_BAR;
            PG8_LDA(At, 1, 1); PG8_STAGE(PG8_SA(1, 0), a3, voffA);
            PG8_BAR; PG8_WAIT_L(0); PG8_MMA(1, 0, At, B0); PG8_BAR; PG8_SCHED;
            PG8_STAGE(PG8_SB(1, 1), b3 + hstep, voffB);
            PG8_WAIT_V(6); PG8_BAR; PG8_MMA(1, 1, At, B1); PG8_BAR;
            }
                }
        for (int t = 2; t < nt; t += 2) {
            const bool last = (t == nt - 2);
            const char* a1 = cA + (size_t)(t + 1) * kstep;
            const char* a2 = last ? nA : cA + (size_t)(t + 2) * kstep; const char* b2 = last ? nB : cB + (size_t)(t + 2) * kstep;
            const char* a3 = a2 + kstep; const char* b3 = b2 + kstep;
            if (last && has_next) S.a_ready(nxt);
            if constexpr (SP2) {
            PG8_LDB(B0, 0, 0); PG8_LDB(B1, 0, 1); PG8_SCHED; PG8_LDA(At, 0, 0); PG8_STAGE(PG8_SA(1, 1), a1 + hstep, voffA);
            PG8_WAIT_V(8); PG8_WAIT_L(0); PG8_BAR; PG8_MMA(0, 0, At, B0); PG8_MMA(0, 1, At, B1); PG8_BAR; PG8_SCHED;
            PG8_LDA(At, 0, 1); PG8_STAGE(PG8_SB(0, 0), b2, voffB); PG8_STAGE(PG8_SB(0, 1), b2 + hstep, voffB); PG8_STAGE(PG8_SA(0, 0), a2, voffA);
            PG8_WAIT_V(8); PG8_WAIT_L(0); PG8_BAR; PG8_MMA(1, 0, At, B0); PG8_MMA(1, 1, At, B1); PG8_BAR; PG8_SCHED;
            PG8_LDB(B0, 1, 0); PG8_LDB(B1, 1, 1); PG8_SCHED; PG8_LDA(At, 1, 0); PG8_STAGE(PG8_SA(0, 1), a2 + hstep, voffA);
            PG8_WAIT_V(8); PG8_WAIT_L(0); PG8_BAR; PG8_MMA(0, 0, At, B0); PG8_MMA(0, 1, At, B1); PG8_BAR; PG8_SCHED;
            PG8_LDA(At, 1, 1); PG8_STAGE(PG8_SB(1, 0), b3, voffB); PG8_STAGE(PG8_SB(1, 1), b3 + hstep, voffB); PG8_STAGE(PG8_SA(1, 0), a3, voffA);
            PG8_WAIT_V(8); PG8_WAIT_L(0); PG8_BAR; PG8_MMA(1, 0, At, B0); PG8_MMA(1, 1, At, B1); PG8_BAR; PG8_SCHED;
            } else {
            PG8_LDB(B0, 0, 0); PG8_SCHED; PG8_LDA(At, 0, 0); PG8_STAGE(PG8_SA(1, 1), a1 + hstep, voffA);
            PG8_WAIT_L(8); PG8_BAR; PG8_WAIT_L(0); PG8_MMA(0, 0, At, B0); PG8_BAR; PG8_SCHED;
            PG8_LDB(B1, 0, 1); PG8_STAGE(PG8_SB(0, 0), b2, voffB);
            PG8_BAR; PG8_WAIT_L(0); PG8_MMA(0, 1, At, B1); PG8_BAR;
            PG8_LDA(At, 0, 1); PG8_STAGE(PG8_SA(0, 0), a2, voffA);
            PG8_BAR; PG8_WAIT_L(0); PG8_MMA(1, 0, At, B0); PG8_BAR; PG8_SCHED;
            PG8_STAGE(PG8_SB(0, 1), b2 + hstep, voffB);
            PG8_WAIT_V(6); PG8_BAR; PG8_MMA(1, 1, At, B1); PG8_BAR;
            PG8_LDB(B0, 1, 0); PG8_SCHED; PG8_LDA(At, 1, 0); PG8_STAGE(PG8_SA(0, 1), a2 + hstep, voffA);
            PG8_WAIT_L(8); PG8_BAR; PG8_WAIT_L(0); PG8_MMA(0, 0, At, B0); PG8_BAR; PG8_SCHED;
            PG8_LDB(B1, 1, 1); PG8_STAGE(PG8_SB(1, 0), b3, voffB);
            PG8_BAR; PG8_WAIT_L(0); PG8_MMA(0, 1, At, B1); PG8_BAR;
            PG8_LDA(At, 1, 1); PG8_STAGE(PG8_SA(1, 0), a3, voffA);
            PG8_BAR; PG8_WAIT_L(0); PG8_MMA(1, 0, At, B0); PG8_BAR; PG8_SCHED;
            PG8_STAGE(PG8_SB(1, 1), b3 + hstep, voffB);
            PG8_WAIT_V(6); PG8_BAR; PG8_MMA(1, 1, At, B1); PG8_BAR;
            }
                }
        if constexpr (ALIGN_EPI) { if (wr == 0) PG8_BAR; }
        if constexpr (!Epi::AFTER_DRAIN) { E(acc, cur, wr, wc, fr, fq); S.done(cur); }
        if (!has_next) break;
#pragma unroll
        for (int a = 0; a < 2; ++a)
#pragma unroll
            for (int b = 0; b < 2; ++b)
#pragma unroll
                for (int m = 0; m < 4; ++m)
#pragma unroll
                    for (int n = 0; n < 2; ++n) acc[a][b][m][n] = (f32x4){0.f, 0.f, 0.f, 0.f};
        cur = nxt; cA = nA; cB = nB; ++ui;
        if constexpr (ALIGN_EPI) { if (wr == 1) PG8_BAR; }
    }
    PG8_WAIT_V(0);
    if constexpr (!ALIGN_EPI) { if (wr == 0) PG8_BAR; }
    PG8_BAR;
    if constexpr (Epi::AFTER_DRAIN) { E.fused(acc, cur, wr, wc, fr, fq, lds, wid, lane); S.done(cur); }
#undef PG8_SA
#undef PG8_SB
#undef PG8_STAGE
#undef PG8_LDA
#undef PG8_LDB
#undef PG8_MMA
#undef PG8_MMAZ
#undef PG8_WAIT_V
#undef PG8_WAIT_L
#undef PG8_BAR
#undef PG8_SCHED
}
}

#ifndef ATT_PROBE
#define ATT_PROBE 0
#endif
namespace attn {
using bf16x8 = __attribute__((ext_vector_type(8))) short;
using s16x4 = __attribute__((ext_vector_type(4))) short;
using f32x16 = __attribute__((ext_vector_type(16))) float;
using u32x4 = __attribute__((ext_vector_type(4))) unsigned;
typedef short v4i16_t __attribute__((ext_vector_type(4)));
typedef __attribute__((address_space(3))) const char* lds_cptr;
constexpr int SLOTB = 32768, NSLOT = 3, LDS_T0 = NSLOT * SLOTB  , LDS_WS = 133120  , LDS_X = 0  , LDS_STG = 65536  ;
__device__ __forceinline__ int crow(int r, int hi) { return (r & 3) + 8 * (r >> 2) + 4 * hi; }
__device__ __forceinline__ void glds16s(const void* gbase_uniform, unsigned voff_bytes, unsigned lds_dst) { unsigned keep;
    asm volatile("s_mov_b32 %0, m0\n\ts_mov_b32 m0, %3\n\ts_nop 0\n\tglobal_load_lds_dwordx4 %1, %2\n\ts_mov_b32 m0, %0" : "=&s"(keep) : "v"(voff_bytes), "s"(gbase_uniform), "s"(lds_dst) : "memory"); }
__device__ __forceinline__ void glds16(const void* gsrc, unsigned lds_dst) { unsigned keep;
    asm volatile("s_mov_b32 %0, m0\n\ts_mov_b32 m0, %2\n\ts_nop 0\n\tglobal_load_lds_dwordx4 %1, off\n\ts_mov_b32 m0, %0" : "=&s"(keep) : "v"(gsrc), "s"(lds_dst) : "memory"); }
typedef float f32x2_t __attribute__((ext_vector_type(2))); typedef __bf16 bf16x2_t __attribute__((ext_vector_type(2)));
__device__ __forceinline__ unsigned cvtpk(float lo, float hi) { f32x2_t v = {lo, hi}; bf16x2_t b = __builtin_convertvector(v, bf16x2_t); return __builtin_bit_cast(unsigned, b); }
__device__ __forceinline__ s16x4 vtr(lds_cptr p) { return __builtin_bit_cast(s16x4, __builtin_amdgcn_ds_read_tr16_b64_v4i16((__attribute__((address_space(3))) v4i16_t*)p)); }
#define ATT_WAIT_BAR(N) asm volatile("s_waitcnt vmcnt(" #N ") lgkmcnt(0)\n\ts_barrier" ::: "memory")

__device__ __forceinline__ int cc_of(int s, int i) { return (i == 0) ? s : (i == 1) ? 7 - s : (i == 2) ? 8 + s : 15 - s; }
__device__ __forceinline__ void attn_cu(int b, int h, int s4, const bf16* Q, const bf16* __restrict__ K, const bf16* __restrict__ V, bf16* Y, float lam, float negm_s, const float* subln, LAS unsigned char* lds) {
    const int tid = threadIdx.x, lane = tid & 63, r32 = lane & 31, hi = lane >> 5; const int wid = __builtin_amdgcn_readfirstlane(tid >> 6);
    const int qg = wid & 3, map = wid >> 2;
    const size_t rowbase = (size_t)b * SEQ;
    const bf16* Qg = Q + (rowbase + 32 * qg) * PQ + h * 128 + map * 64;
    const bf16* Kh = K + rowbase * PQ + h * 128; const bf16* Vh = V + rowbase * PQ + h * 128;
    const unsigned lds0 = (unsigned)(uintptr_t)lds;
    const lds_cptr lds3 = (lds_cptr)lds;
    LAS float* wsf = (LAS float*)(lds + LDS_WS) + wid * 64;
    const unsigned koff = (unsigned)(((size_t)(8 * wid + (lane >> 3)) * PQ) * 2 + 16 * ((lane & 7) ^ ((4 * wid + (lane >> 4)) & 7)));
    const unsigned voff = (unsigned)(((size_t)(16 * (wid & 3) + (lane >> 2)) * PQ + (wid >> 2) * 32 + (lane & 3) * 8) * 2);
    const unsigned kdst = lds0 + wid * 1024, vdst = lds0 + 16384 + wid * 1024;
#define ATT_DMA(t, slot) do { const bf16* kb_ = Kh + (size_t)(t) * 64 * PQ; const bf16* vb_ = Vh + (size_t)(t) * 64 * PQ; const unsigned sl_ = (unsigned)(slot); \
        glds16s(kb_, koff, (unsigned)__builtin_amdgcn_readfirstlane(kdst + sl_)); glds16s(kb_ + 64, koff, (unsigned)__builtin_amdgcn_readfirstlane(kdst + sl_ + 8192u)); \
        glds16s(vb_, voff, (unsigned)__builtin_amdgcn_readfirstlane(vdst + sl_)); glds16s(vb_ + 64, voff, (unsigned)__builtin_amdgcn_readfirstlane(vdst + sl_ + 8192u)); } while (0)
#define ATT_DMA1(t, slot, i) do { const bf16* kb_ = Kh + (size_t)(t) * 64 * PQ; const bf16* vb_ = Vh + (size_t)(t) * 64 * PQ; const unsigned sl_ = (unsigned)(slot); \
        if ((i) == 0) glds16s(kb_, koff, (unsigned)__builtin_amdgcn_readfirstlane(kdst + sl_)); if ((i) == 1) glds16s(kb_ + 64, koff, (unsigned)__builtin_amdgcn_readfirstlane(kdst + sl_ + 8192u)); \
        if ((i) == 2) glds16s(vb_, voff, (unsigned)__builtin_amdgcn_readfirstlane(vdst + sl_)); if ((i) == 3) glds16s(vb_ + 64, voff, (unsigned)__builtin_amdgcn_readfirstlane(vdst + sl_ + 8192u)); } while (0)
    __syncthreads();
    ATT_DMA(0, LDS_T0);
    bf16x8 qn[4];
#pragma unroll
    for (int s = 0; s < 4; ++s) qn[s] = *reinterpret_cast<const bf16x8*>(Qg + (size_t)(128 * cc_of(s4, 0) + r32) * PQ + hi * 8 + s * 16);
    __builtin_amdgcn_s_waitcnt(0x0F70);
    const lds_cptr kp0 = lds3 + map * 8192 + r32 * 128;
    const unsigned kx0 = (unsigned)((hi ^ ((r32 >> 1) & 7)) << 4);
    const lds_cptr vp0 = lds3 + 16384 + ((lane >> 4) & 1) * 32 + (lane & 3) * 8 + (4 * hi + ((lane & 15) >> 2)) * 64;
#pragma unroll 1
    for (int ui = 0; ui < 4; ++ui) {
    const int cc = cc_of(s4, ui), q0 = 128 * cc, NT = 2 * cc + 2, my_nt = 2 * cc + (qg >> 1) + 1;
    ATT_DMA(1, 0);
    bf16x8 qr[4];
#pragma unroll
    for (int s = 0; s < 4; ++s) qr[s] = qn[s];
    f32x16 o[4]; o[0] = f32x16{}; o[1] = f32x16{}; o[2] = f32x16{}; o[3] = f32x16{};
    float nm_ = negm_s;
    f32x16 lacc = f32x16{};
    bf16x8 ones; { unsigned o1 = 0x3F803F80u; asm volatile("" : "+v"(o1)); const u32x4 o4 = {o1, o1, o1, o1}; ones = __builtin_bit_cast(bf16x8, o4); }
    int slot = LDS_T0, s2 = SLOTB;
    for (int t = 0; t < my_nt; ++t) {
        if (t == 0) { ATT_WAIT_BAR(8); } else if (t + 1 < NT) { ATT_WAIT_BAR(4); } else { ATT_WAIT_BAR(0); }
        {
            const lds_cptr kp = kp0 + slot; const lds_cptr vp = vp0 + slot;
            bf16x8 kf[8];
#pragma unroll
            for (int s = 0; s < 4; ++s) { const lds_cptr ks = kp + (kx0 ^ (unsigned)(32 * s)); kf[2 * s] = *(const __attribute__((address_space(3))) bf16x8*)(ks); kf[2 * s + 1] = *(const __attribute__((address_space(3))) bf16x8*)(ks + 4096); }
            f32x16 negm; { float nt_ = nm_; asm volatile("" : "+v"(nt_));
                _Pragma("unroll") for (int r = 0; r < 16; ++r) negm[r] = nt_; }
            f32x16 p0 = __builtin_amdgcn_mfma_f32_32x32x16_bf16(kf[0], qr[0], negm, 0, 0, 0), p1 = __builtin_amdgcn_mfma_f32_32x32x16_bf16(kf[1], qr[0], negm, 0, 0, 0);
#pragma unroll
            for (int s = 1; s < 4; ++s) { p0 = __builtin_amdgcn_mfma_f32_32x32x16_bf16(kf[2 * s], qr[s], p0, 0, 0, 0); p1 = __builtin_amdgcn_mfma_f32_32x32x16_bf16(kf[2 * s + 1], qr[s], p1, 0, 0, 0); }
#define ATT_VLOAD(VF, KS) do { _Pragma("unroll") for (int db = 0; db < 4; ++db) { const s16x4 vlo = vtr(vp + db * 4096 + (KS) * 1024), vhi = vtr(vp + db * 4096 + (KS) * 1024 + 512); \
                VF[db] = (bf16x8){vlo[0], vlo[1], vlo[2], vlo[3], vhi[0], vhi[1], vhi[2], vhi[3]}; } } while (0)
#define ATT_EXPK(P, B, W) do { _Pragma("unroll") for (int r = 0; r < 8; ++r) { P[(B) + r] = __builtin_amdgcn_exp2f(P[(B) + r]); } \
                W = (u32x4){cvtpk(P[(B)], P[(B) + 1]), cvtpk(P[(B) + 2], P[(B) + 3]), cvtpk(P[(B) + 4], P[(B) + 5]), cvtpk(P[(B) + 6], P[(B) + 7])}; } while (0)
#define ATT_PVK(VF, W) do { _Pragma("unroll") for (int db = 0; db < 4; ++db) o[db] = __builtin_amdgcn_mfma_f32_32x32x16_bf16(__builtin_bit_cast(bf16x8, W), VF[db], o[db], 0, 0, 0); \
                lacc = __builtin_amdgcn_mfma_f32_32x32x16_bf16(__builtin_bit_cast(bf16x8, W), ones, lacc, 0, 0, 0); } while (0)
            bf16x8 vfa[4], vfb[4]; u32x4 pwa, pwb;
            __builtin_amdgcn_sched_barrier(0);
            ATT_VLOAD(vfa, 0);
            const bool dma_ = t + 2 < NT;
            __builtin_amdgcn_sched_barrier(0);
            ATT_EXPK(p0, 0, pwa); if (dma_) ATT_DMA1(t + 2, s2, 0);
            ATT_VLOAD(vfb, 1); __builtin_amdgcn_sched_barrier(0);
            ATT_PVK(vfa, pwa); ATT_EXPK(p0, 8, pwb); if (dma_) ATT_DMA1(t + 2, s2, 1); __builtin_amdgcn_sched_barrier(0);
            ATT_VLOAD(vfa, 2); __builtin_amdgcn_sched_barrier(0);
            ATT_PVK(vfb, pwb); ATT_EXPK(p1, 0, pwa); if (dma_) ATT_DMA1(t + 2, s2, 2); __builtin_amdgcn_sched_barrier(0);
            ATT_VLOAD(vfb, 3); __builtin_amdgcn_sched_barrier(0);
            ATT_PVK(vfa, pwa); ATT_EXPK(p1, 8, pwb); if (dma_) ATT_DMA1(t + 2, s2, 3); __builtin_amdgcn_sched_barrier(0);
            ATT_PVK(vfb, pwb);
#undef ATT_VLOAD
#undef ATT_EXPK
#undef ATT_PVK
        }
        slot = (t == 0) ? 0 : (slot + SLOTB == NSLOT * SLOTB ? 0 : slot + SLOTB);
        s2 = (s2 + SLOTB == NSLOT * SLOTB) ? 0 : s2 + SLOTB;
    }
    if (my_nt < NT) ATT_WAIT_BAR(0);
    int lane_e = lane; asm volatile("" : "+v"(lane_e));
    const int r32e = lane_e & 31, hie = lane_e >> 5;
    float sc[16];
#pragma unroll
    for (int r = 0; r < 16; ++r) sc[r] = (map == 0 ? 1.0f : lam) * __builtin_amdgcn_rcpf(lacc[r]);
    ATT_WAIT_BAR(0);
    LAS float* xb = (LAS float*)(lds + LDS_X) + qg * 4096;
    LAS bf16* stg = (LAS bf16*)(lds + LDS_STG) + qg * 4096;
    bf16* Yw = Y + (rowbase + q0 + 32 * qg) * DM + h * 128;
#define ATT_EPI(RK, RS, MINE_MINUS) do { \
        _Pragma("unroll") for (int db = 0; db < 4; ++db) _Pragma("unroll") for (int r = 0; r < 8; ++r) xb[(db * 16 + (RS) + r) * 64 + lane_e] = o[db][(RS) + r] * sc[(RS) + r]; \
        ATT_WAIT_BAR(0); \
        if (ui < 3) { _Pragma("unroll") for (int s = 0; s < 4; ++s) qn[s] = *reinterpret_cast<const bf16x8*>(Qg + (size_t)(128 * cc_of(s4, ui + 1) + r32e) * PQ + hie * 8 + s * 16); }     \
        float ss[8]; \
        _Pragma("unroll") for (int r = 0; r < 8; ++r) ss[r] = 0.f; \
        _Pragma("unroll") for (int db = 0; db < 4; ++db) _Pragma("unroll") for (int r = 0; r < 8; ++r) { const float x = xb[(db * 16 + (RK) + r) * 64 + lane_e]; \
            const float d = (MINE_MINUS) ? (o[db][(RK) + r] * sc[(RK) + r] - x) : (x - o[db][(RK) + r] * sc[(RK) + r]); o[db][(RK) + r] = d; ss[r] += d * d; } \
        _Pragma("unroll") for (int r = 0; r < 8; ++r) { \
            _Pragma("unroll") for (int m = 1; m < 32; m <<= 1) ss[r] += __shfl_xor(ss[r], m); \
            ss[r] = (1.0f - LAMBDA_INIT) * __builtin_amdgcn_rsqf(ss[r] * (1.0f / 128.0f) + EPS); } \
        _Pragma("unroll") for (int db = 0; db < 4; ++db) { const float gsub = subln[32 * db + r32e]; \
            _Pragma("unroll") for (int r = 0; r < 8; ++r) stg[crow((RK) + r, hie) * 128 + 32 * db + r32e] = (bf16)cvtpk(o[db][(RK) + r] * ss[r] * gsub, 0.f); }     \
        asm volatile("s_waitcnt lgkmcnt(0)" ::: "memory"); \
        _Pragma("unroll") for (int i = 0; i < 4; ++i) { const int id = i * 64 + lane_e, row = 2 * (RK) + (id >> 4), ch = id & 15;     \
            const u32x4 v = *(const LAS u32x4*)(stg + row * 128 + ch * 8); *(u32x4*)(Yw + (size_t)row * DM + ch * 8) = v; } \
    } while (0)
    if (map == 0) ATT_EPI(0, 8, true); else ATT_EPI(8, 0, false);
#undef ATT_EPI
    __builtin_amdgcn_s_waitcnt(0x0F74);
    asm volatile("s_waitcnt lgkmcnt(0)\n\ts_barrier" ::: "memory");
    }
#undef ATT_DMA
#undef ATT_DMA1
}
#undef ATT_WAIT_BAR
}

namespace rnn {
using bf16x8 = __attribute__((ext_vector_type(8))) short;
using f32x16 = __attribute__((ext_vector_type(16))) float;
typedef float f32x2_t __attribute__((ext_vector_type(2))); typedef __bf16 bf16x2_t __attribute__((ext_vector_type(2)));
typedef unsigned u32x2 __attribute__((ext_vector_type(2)));
__device__ __forceinline__ unsigned cvtpk(float lo, float hi) { f32x2_t v = {lo, hi}; bf16x2_t b = __builtin_convertvector(v, bf16x2_t); return __builtin_bit_cast(unsigned, b); }
__device__ __forceinline__ float sigm2(float z) { return __builtin_amdgcn_rcpf(1.0f + __builtin_amdgcn_exp2f(z)); }
constexpr int LDS_CV = 86016  , LDS_CW = 0  , LDS_CH = 1536  , LDS_COMP = 2048  , LDS_CIN = 6144  , LDS_W = 8192  ,
              LDS_XS = 16384  , XS_BYTES = 264 * 128;
__device__ __forceinline__ void glds16s(const void* gbase_uniform, unsigned voff_bytes, unsigned lds_dst) { unsigned keep;
    asm volatile("s_mov_b32 %0, m0\n\ts_mov_b32 m0, %3\n\ts_nop 0\n\tglobal_load_lds_dwordx4 %1, %2\n\ts_mov_b32 m0, %0" : "=&s"(keep) : "v"(voff_bytes), "s"(gbase_uniform), "s"(lds_dst) : "memory"); }
__device__ __forceinline__ void glds16(const void* gsrc, unsigned lds_dst) { unsigned keep;
    asm volatile("s_mov_b32 %0, m0\n\ts_mov_b32 m0, %2\n\ts_nop 0\n\tglobal_load_lds_dwordx4 %1, off\n\ts_mov_b32 m0, %0" : "=&s"(keep) : "v"(gsrc), "s"(lds_dst) : "memory"); }

__device__ __forceinline__ void rnn_consts(int n, int dh, const float* conv_w, const float* conv_b, const float* w_a, const float* b_a, const float* w_x, const float* b_x, const float* a_param, LAS unsigned char* lds) {
    const int tid = threadIdx.x, lane = tid & 63, r32 = lane & 31, hi = lane >> 5; const int wid = __builtin_amdgcn_readfirstlane(tid >> 6);
    LAS float* cwl = (LAS float*)(lds + LDS_CW); LAS float* chl = (LAS float*)(lds + LDS_CH);
    for (int it = tid; it < 18 * 64; it += 512) { const int f = it >> 6, l = it & 63, m = l & 31, kg = l >> 5; bf16x8 fr = {0, 0, 0, 0, 0, 0, 0, 0};
        if (f < 16) { const int cblk = f >> 3, tap = (f >> 1) & 3, ks = f & 1, j0 = m - 16 * ks - 8 * kg;
            if (j0 >= 0 && j0 < 8) { const short wv = (short)f2bf(conv_w[tap * DRNN + n * 64 + 32 * cblk + m]);
#pragma unroll
                for (int j = 0; j < 8; ++j) fr[j] = (j == j0) ? wv : fr[j]; } }
        else if (kg == 0) fr[0] = (short)f2bf(conv_b[n * 64 + 32 * (f - 16) + m]);
        *(LAS bf16x8*)(lds + LDS_CV + it * 16) = fr; }
    if (tid >= 320 && tid < 352) { const int ch = n * 64 + 32 * dh + tid - 320; chl[tid - 320] = -1.4426950408889634f * b_a[ch]; chl[32 + tid - 320] = -1.4426950408889634f * b_x[ch]; chl[64 + tid - 320] = -8.0f * 1.4426950408889634f * log1pf(expf(-a_param[ch])); }
    { const int mat = wid >> 2, s = wid & 3; const float* wsrc = mat ? w_x : w_a; bf16x8 f;
#pragma unroll
        for (int j = 0; j < 8; ++j) { const int c = 16 * s + 8 * (j >> 2) + 4 * hi + (j & 3); f[j] = (short)f2bf(-1.4426950408889634f * wsrc[(size_t)(n * 64 + c) * 64 + 32 * dh + r32]); }
        *(LAS bf16x8*)(lds + LDS_W + (wid * 64 + lane) * 16) = f; }
}

template <bool PREP> __device__ __forceinline__ void rnn_unit(int b, int n, int dh, const bf16* __restrict__ XR, const bf16* __restrict__ GATE, bf16* __restrict__ Y, const float* conv_w, const float* conv_b,
                                         const float* w_a, const float* b_a, const float* w_x, const float* b_x, const float* a_param, LAS unsigned char* lds) {
    const int tid = threadIdx.x, lane = tid & 63, r32 = lane & 31, hi = lane >> 5; const int wid = __builtin_amdgcn_readfirstlane(tid >> 6);
    LAS float* cwl = (LAS float*)(lds + LDS_CW); LAS float* chl = (LAS float*)(lds + LDS_CH); LAS float* comp = (LAS float*)(lds + LDS_COMP);
    __syncthreads();
    const size_t seq0 = (size_t)b * SEQ;
    const unsigned lds0 = (unsigned)(uintptr_t)lds;
    const bf16* xbase = XR + ((long)seq0 - 8) * PQ + n * 64;
    const unsigned xoff = (unsigned)(((size_t)(lane >> 3) * PQ + 8 * ((lane & 7) ^ ((4 * wid + (lane >> 4)) & 7))) * 2);
    const unsigned xoff32 = (unsigned)(((size_t)(lane >> 3) * PQ + 8 * ((lane & 7) ^ ((lane >> 4) & 7))) * 2);
#define RNN_DMA(rd_, buf_) do { const bf16* xs_ = xbase + (size_t)(rd_) * 256 * PQ; const unsigned db_ = lds0 + LDS_XS + (unsigned)(buf_) * XS_BYTES; \
        _Pragma("unroll") for (int j_ = 0; j_ < 4; ++j_) { const int i_ = wid + 8 * j_; \
            glds16s(xs_ + (size_t)(8 * i_) * PQ, xoff, (unsigned)__builtin_amdgcn_readfirstlane(db_ + 1024u * i_)); } \
        if (wid == 0) glds16s(xs_ + (size_t)256 * PQ, xoff32, (unsigned)__builtin_amdgcn_readfirstlane(db_ + 32768u)); } while (0)
    RNN_DMA(0, 0);
    if (!PREP) rnn_consts(n, dh, conv_w, conv_b, w_a, b_a, w_x, b_x, a_param, lds);
    const LAS bf16x8* wfr = (const LAS bf16x8*)(lds + LDS_W) + lane;
    float carry1 = 0.f;
    asm volatile("s_waitcnt vmcnt(0) lgkmcnt(0)\n\ts_barrier" ::: "memory");
    if (wid == 0) *(LAS v4u*)(lds + LDS_XS + lane * 16) = (v4u){0u, 0u, 0u, 0u};
    asm volatile("s_waitcnt lgkmcnt(0)\n\ts_barrier" ::: "memory");
    for (int rd = 0; rd < SEQ / 256; ++rd) {
        const int t = 32 * (8 * rd + wid) + r32; const size_t row = seq0 + t;
        if (rd + 1 < SEQ / 256) RNN_DMA(rd + 1, (rd + 1) & 1);
        u32x2 gv[4];
#pragma unroll
        for (int g = 0; g < 4; ++g) gv[g] = *(const u32x2*)(GATE + row * PQ + n * 64 + 32 * dh + 8 * g + 4 * hi);
        const LAS unsigned char* xsb = lds + LDS_XS + (rd & 1) * XS_BYTES;
        const int rl0 = 5 + 32 * wid + r32;
        f32x16 xacc[2];
        { const bf16x8 onesf = __builtin_bit_cast(bf16x8, (v4u){0x3F803F80u, 0x3F803F80u, 0x3F803F80u, 0x3F803F80u});
          const LAS bf16x8* cvf = (const LAS bf16x8*)(lds + LDS_CV) + lane;
#pragma unroll
          for (int cb = 0; cb < 2; ++cb) xacc[cb] = __builtin_amdgcn_mfma_f32_32x32x16_bf16(cvf[(16 + cb) * 64], onesf, f32x16{}, 0, 0, 0);
#pragma unroll
          for (int k = 0; k < 4; ++k) { const int rl = rl0 + k; const LAS unsigned char* xrow = xsb + rl * 128; const int swz = (rl >> 1) & 7;
#pragma unroll
              for (int cb = 0; cb < 2; ++cb)
#pragma unroll
                  for (int ks = 0; ks < 2; ++ks) { const bf16x8 xb8 = *(const LAS bf16x8*)(xrow + (((4 * cb + 2 * ks + hi) ^ swz) << 4));
                      xacc[cb] = __builtin_amdgcn_mfma_f32_32x32x16_bf16(cvf[(8 * cb + 2 * k + ks) * 64], xb8, xacc[cb], 0, 0, 0); } } }
        bf16x8 xf[4]; float xsel[16];
#pragma unroll
        for (int s = 0; s < 4; ++s) { const int cb = s >> 1, r0 = 8 * (s & 1);
            xf[s] = __builtin_bit_cast(bf16x8, (v4u){cvtpk(xacc[cb][r0], xacc[cb][r0 + 1]), cvtpk(xacc[cb][r0 + 2], xacc[cb][r0 + 3]), cvtpk(xacc[cb][r0 + 4], xacc[cb][r0 + 5]), cvtpk(xacc[cb][r0 + 6], xacc[cb][r0 + 7])}); }
#pragma unroll
        for (int r = 0; r < 16; ++r) xsel[r] = dh ? xacc[1][r] : xacc[0][r];
        f32x16 ga, gx; float sp[16];
#pragma unroll
        for (int g = 0; g < 4; ++g) { const v4f a4 = *(const LAS v4f*)(chl + 8 * g + 4 * hi), x4 = *(const LAS v4f*)(chl + 32 + 8 * g + 4 * hi), s4 = *(const LAS v4f*)(chl + 64 + 8 * g + 4 * hi);
#pragma unroll
            for (int e = 0; e < 4; ++e) { ga[4 * g + e] = a4[e]; gx[4 * g + e] = x4[e]; sp[4 * g + e] = s4[e]; } }
#pragma unroll
        for (int s = 0; s < 4; ++s) { ga = __builtin_amdgcn_mfma_f32_32x32x16_bf16(wfr[s * 64], xf[s], ga, 0, 0, 0); gx = __builtin_amdgcn_mfma_f32_32x32x16_bf16(wfr[(4 + s) * 64], xf[s], gx, 0, 0, 0); }
        float av[16], bv[16];
#pragma unroll
        for (int r = 0; r < 16; ++r) { const float rg = sigm2(ga[r]), ig = sigm2(gx[r]);
            const float aa = __builtin_amdgcn_exp2f(sp[r] * rg); av[r] = aa; bv[r] = __builtin_amdgcn_sqrtf(fmaxf(1.0f - aa * aa, 0.f)) * ig * xsel[r]; }
#define RNN_STEPS(CTRL) \
        "v_fmac_f32_dpp %8, %8, %0 " CTRL "\n\tv_fmac_f32_dpp %9, %9, %1 " CTRL "\n\tv_fmac_f32_dpp %10, %10, %2 " CTRL "\n\tv_fmac_f32_dpp %11, %11, %3 " CTRL "\n\t" \
        "v_fmac_f32_dpp %12, %12, %4 " CTRL "\n\tv_fmac_f32_dpp %13, %13, %5 " CTRL "\n\tv_fmac_f32_dpp %14, %14, %6 " CTRL "\n\tv_fmac_f32_dpp %15, %15, %7 " CTRL "\n\t" \
        "v_mul_f32_dpp %0, %0, %0 " CTRL "\n\tv_mul_f32_dpp %1, %1, %1 " CTRL "\n\tv_mul_f32_dpp %2, %2, %2 " CTRL "\n\tv_mul_f32_dpp %3, %3, %3 " CTRL "\n\t" \
        "v_mul_f32_dpp %4, %4, %4 " CTRL "\n\tv_mul_f32_dpp %5, %5, %5 " CTRL "\n\tv_mul_f32_dpp %6, %6, %6 " CTRL "\n\tv_mul_f32_dpp %7, %7, %7 " CTRL "\n\t"
#define RNN_SCAN8(o) asm volatile("s_nop 1\n\t" RNN_STEPS("row_shr:1 row_mask:0xf bank_mask:0xf") RNN_STEPS("row_shr:2 row_mask:0xf bank_mask:0xf") RNN_STEPS("row_shr:4 row_mask:0xf bank_mask:0xf") \
            RNN_STEPS("row_shr:8 row_mask:0xf bank_mask:0xf") RNN_STEPS("row_bcast:15 row_mask:0xa bank_mask:0xf") \
            : "+v"(av[o]), "+v"(av[o + 1]), "+v"(av[o + 2]), "+v"(av[o + 3]), "+v"(av[o + 4]), "+v"(av[o + 5]), "+v"(av[o + 6]), "+v"(av[o + 7]), \
              "+v"(bv[o]), "+v"(bv[o + 1]), "+v"(bv[o + 2]), "+v"(bv[o + 3]), "+v"(bv[o + 4]), "+v"(bv[o + 5]), "+v"(bv[o + 6]), "+v"(bv[o + 7]))
        RNN_SCAN8(0); RNN_SCAN8(8);
#undef RNN_SCAN8
#undef RNN_STEPS
        LAS float* cp = comp + (rd & 1) * 512;
        if (r32 == 31) {
#pragma unroll
            for (int g = 0; g < 4; ++g) { *(LAS v4f*)(cp + (wid * 2 + 0) * 32 + 8 * g + 4 * hi) = (v4f){av[4 * g], av[4 * g + 1], av[4 * g + 2], av[4 * g + 3]};
                *(LAS v4f*)(cp + (wid * 2 + 1) * 32 + 8 * g + 4 * hi) = (v4f){bv[4 * g], bv[4 * g + 1], bv[4 * g + 2], bv[4 * g + 3]}; }
        }
        asm volatile("s_waitcnt vmcnt(0) lgkmcnt(0)\n\ts_barrier" ::: "memory");
        float cin1 = carry1;
#pragma unroll
        for (int w = 0; w < 8; ++w) { const float A1 = cp[(w * 2 + 0) * 32 + r32], B1 = cp[(w * 2 + 1) * 32 + r32];
            cin1 = (w == wid) ? carry1 : cin1; carry1 = A1 * carry1 + B1; }
        LAS float* cib = (LAS float*)(lds + LDS_CIN) + wid * 32;
        if (hi == 0) cib[r32] = cin1;
        asm volatile("s_waitcnt lgkmcnt(0)" ::: "memory");
        float cin[16];
#pragma unroll
        for (int g = 0; g < 4; ++g) { const v4f c4 = *(const LAS v4f*)(cib + 8 * g + 4 * hi);
#pragma unroll
            for (int e = 0; e < 4; ++e) cin[4 * g + e] = c4[e]; }
#pragma unroll
        for (int g = 0; g < 4; ++g) { const int c0 = n * 64 + 32 * dh + 8 * g + 4 * hi;
            const float gt[4] = {__builtin_bit_cast(float, gv[g][0] << 16), __builtin_bit_cast(float, gv[g][0] & 0xffff0000u), __builtin_bit_cast(float, gv[g][1] << 16), __builtin_bit_cast(float, gv[g][1] & 0xffff0000u)};
            float y[4];
#pragma unroll
            for (int e = 0; e < 4; ++e) { const int r = 4 * g + e; const float h = av[r] * cin[r] + bv[r]; const float x = gt[e];
                y[e] = h * x * sigm2(x * (-2.3022081981531984f + -0.10294323958041973f * (x * x))); }
            *(u32x2*)(Y + row * DM + DATTN + c0) = (u32x2){cvtpk(y[0], y[1]), cvtpk(y[2], y[3])}; }
    }
#undef RNN_DMA
    __syncthreads();
}
}

typedef __attribute__((address_space(1))) unsigned gu32;
#define RLX_AGENT __ATOMIC_RELAXED, __HIP_MEMORY_SCOPE_AGENT
#define XB_TMO      128
#define XB_XCNT(j)  (256  + 64 * (j))
#define XB_XSUB(j)  (1280 + 64 * (j))
#define XB_XGEN(j)  (2304 + 64 * (j))
#define XB_TOP      3328
#define XB_TOPGEN   3392
#define XCD_BAR_WORDS 3456
#define XB_SPIN_CAP (1u << 18)

__device__ __forceinline__ unsigned xb_ld(unsigned* p)              { return __hip_atomic_load(p, __ATOMIC_RELAXED, __HIP_MEMORY_SCOPE_AGENT); }
__device__ __forceinline__ unsigned xb_add(unsigned* p, unsigned v) { return __hip_atomic_fetch_add(p, v, __ATOMIC_RELAXED, __HIP_MEMORY_SCOPE_AGENT); }
__device__ __forceinline__ unsigned xb_xcc_id() { return (unsigned)__builtin_amdgcn_s_getreg((3 << 11) | 20) & 0xFu; }
#define XB_SPIN(cond, bar) do { unsigned _sp = 0; while (cond) { __builtin_amdgcn_s_sleep(1); \
    if ((++_sp & 255u) == 0u) { if (xb_ld(&(bar)[XB_TMO])) break; if (_sp > XB_SPIN_CAP) { atomicAdd(&(bar)[XB_TMO], 1u); break; } } } } while (0)

struct XcdBarrier {
    unsigned* bar; unsigned x;
    volatile LAS unsigned* st;
};

__device__ __forceinline__ XcdBarrier xcd_barrier_post(unsigned* bar, volatile LAS unsigned* st) {
    XcdBarrier b; b.bar = bar; b.x = xb_xcc_id(); b.st = st;
    if (threadIdx.x == 0) (void)xb_add(&bar[XB_XCNT(b.x)], 1u);
    return b;
}
__device__ __forceinline__ void xcd_barrier_complete(unsigned* bar, unsigned x, unsigned& nloc, unsigned& nx) {
    const unsigned G = gridDim.x * gridDim.y * gridDim.z;
    unsigned sum, cnt, mine, sp = 0u;
    for (;;) {
        sum = 0u; cnt = 0u; mine = 0u;
#pragma unroll
        for (unsigned j = 0; j < 16; ++j) { const unsigned c = xb_ld(&bar[XB_XCNT(j)]); sum += c; cnt += (c > 0u) ? 1u : 0u; mine = (j == x) ? c : mine; }
        if (sum == G) break;
        __builtin_amdgcn_s_sleep(1);
        if ((++sp & 255u) == 0u) { if (xb_ld(&bar[XB_TMO])) break; if (sp > XB_SPIN_CAP) { atomicAdd(&bar[XB_TMO], 1u); break; } }
    }
    nloc = mine > 0u ? mine : 1u; nx = cnt > 0u ? cnt : 1u;
}

struct NoMid { __device__ __forceinline__ void operator()() const {} };
template <class Mid = NoMid> __device__ __forceinline__ void xcd_barrier(const XcdBarrier& b, const Mid& mid = Mid()) {
    asm volatile("s_waitcnt vmcnt(0)" ::: "memory");
    __syncthreads();
    mid();
    if (threadIdx.x == 0) {
        unsigned* bar = b.bar;
        __builtin_amdgcn_s_waitcnt(0);
        unsigned nloc = b.st[0], nx = b.st[1];
        if (nloc == 0u) { xcd_barrier_complete(bar, b.x, nloc, nx); b.st[0] = nloc; b.st[1] = nx; }
        const unsigned old = xb_add(&bar[XB_XSUB(b.x)], 1u);
        const unsigned gen = old / nloc;
        if (old + 1u == (gen + 1u) * nloc) {
            __builtin_amdgcn_fence(__ATOMIC_RELEASE, "agent");
            asm volatile("s_waitcnt vmcnt(0)" ::: "memory");
            const unsigned og = xb_add(&bar[XB_TOP], 1u);
            const unsigned tg = og / nx;
            if (og + 1u == (tg + 1u) * nx) xb_add(&bar[XB_TOPGEN], 1u);
            else XB_SPIN(xb_ld(&bar[XB_TOPGEN]) == tg, bar);
            __builtin_amdgcn_fence(__ATOMIC_ACQUIRE, "agent");
            xb_add(&bar[XB_XGEN(b.x)], 1u);
            asm volatile("s_waitcnt vmcnt(0)" ::: "memory");
        } else {
            XB_SPIN(xb_ld(&bar[XB_XGEN(b.x)]) == gen, bar);
            __builtin_amdgcn_fence(__ATOMIC_ACQUIRE, "agent");
            asm volatile("s_waitcnt vmcnt(0)" ::: "memory");
        }
    }
    __syncthreads();
}

#define XL_SUB(j)   (3520 + 64 * (j))
#define XL_GEN(j)   (4544 + 64 * (j))
#define XL_TABLE    6144
template <class Mid = NoMid> __device__ __forceinline__ void xcd_local_barrier(const XcdBarrier& b, const Mid& mid = Mid()) {
    asm volatile("s_waitcnt vmcnt(0)" ::: "memory");
    __syncthreads();
    unsigned old = 0u, nloc = 1u;
    if (threadIdx.x == 0) {
        __builtin_amdgcn_s_waitcnt(0);
        nloc = b.st[0];
        old = xb_add(&b.bar[XL_SUB(b.x)], 1u);
    }
    mid();
    if (threadIdx.x == 0) {
        unsigned* bar = b.bar;
        const unsigned gen = old / nloc;
        if (old + 1u == (gen + 1u) * nloc) xb_add(&bar[XL_GEN(b.x)], 1u);
        else XB_SPIN(xb_ld(&bar[XL_GEN(b.x)]) == gen, bar);
        __builtin_amdgcn_fence(__ATOMIC_ACQUIRE, "agent");
        asm volatile("s_waitcnt vmcnt(0)" ::: "memory");
    }
    __syncthreads();
}

#define XG_SUB(g)   (6400 + 16 * (g))
#define XG_GEN(g)   (7424 + 16 * (g))
template <class Mid = NoMid> __device__ __forceinline__ void panel_group_barrier(const XcdBarrier& b, unsigned grp, const Mid& mid = Mid()) {
    asm volatile("s_waitcnt vmcnt(0)" ::: "memory");
    __syncthreads();
    unsigned old = 0u;
    if (threadIdx.x == 0) { __builtin_amdgcn_s_waitcnt(0); old = xb_add(&b.bar[XG_SUB(grp)], 1u); }
    mid();
    if (threadIdx.x == 0) {
        unsigned* bar = b.bar;
        const unsigned gen = old >> 2;
        if ((old & 3u) == 3u) xb_add(&bar[XG_GEN(grp)], 1u);
        else XB_SPIN(xb_ld(&bar[XG_GEN(grp)]) == gen, bar);
        __builtin_amdgcn_fence(__ATOMIC_ACQUIRE, "agent");
        asm volatile("s_waitcnt vmcnt(0)" ::: "memory");
    }
    __syncthreads();
}

#define XS_SUB(s, j) (8704 + 1024 * (s) + 64 * (j))
#define XS_TOP(s)    (10752 + 128 * (s))
#define XS_FLAG(s)   (10752 + 128 * (s) + 64)
__device__ __forceinline__ void xcd_split_arrive(const XcdBarrier& b, int set) {
    asm volatile("s_waitcnt vmcnt(0)" ::: "memory");
    __syncthreads();
    if (threadIdx.x == 0) {
        unsigned* bar = b.bar;
        __builtin_amdgcn_s_waitcnt(0);
        unsigned nloc = b.st[0], nx = b.st[1];
        if (nloc == 0u) { xcd_barrier_complete(bar, b.x, nloc, nx); b.st[0] = nloc; b.st[1] = nx; }
        const unsigned old = xb_add(&bar[XS_SUB(set, b.x)], 1u);
        if (old + 1u == nloc) {
            __builtin_amdgcn_fence(__ATOMIC_RELEASE, "agent");
            asm volatile("s_waitcnt vmcnt(0)" ::: "memory");
            const unsigned og = xb_add(&bar[XS_TOP(set)], 1u);
            if (og + 1u == nx) xb_add(&bar[XS_FLAG(set)], 1u);
        }
    }
    __syncthreads();
}
__device__ __forceinline__ void xcd_split_wait(const XcdBarrier& b, int set, int who) {
    if ((int)threadIdx.x == who) {
        unsigned* bar = b.bar;
        XB_SPIN(xb_ld(&bar[XS_FLAG(set)]) == 0u, bar);
        __builtin_amdgcn_fence(__ATOMIC_ACQUIRE, "agent");
        asm volatile("s_waitcnt vmcnt(0)" ::: "memory");
    }
}

__device__ __forceinline__ int srcblk(int mode, int nb) {
    if (mode == 1) { const int t = nb >> 3, bj = (nb >> 2) & 1, jb = nb & 3; return bj * 88 + 4 * t + jb; }
    if (mode == 2) { if (nb < 32) { const int t = nb >> 3, bj = (nb >> 2) & 1, wc = nb & 3; return 8 * t + 2 * wc + bj; } return nb; }
    return nb;
}
__device__ __forceinline__ void transpose_item(const float* W, int K, int N, const float* gain, bf16* WT, int mode, LAS float* scr, int item, int lane) {
    const int nblk = N / 32, kb = item / nblk, nb = item % nblk, k0 = 64 * kb, n0d = 32 * nb, n0s = 32 * srcblk(mode, nb);
    const int k0d = (mode == 3) ? (21 - (kb >> 1)) * 128 + 64 * (kb & 1) : k0;
#pragma unroll
    for (int i = 0; i < 8; ++i) { const int kk = 8 * i + (lane >> 3), cc = 4 * (lane & 7);
        const v4f w = __builtin_nontemporal_load((const v4f*)(W + (size_t)(k0 + kk) * N + n0s + cc)); const float gk = gain ? gain[k0 + kk] : 1.0f;
        scr[kk * 33 + cc] = w.x * gk; scr[kk * 33 + cc + 1] = w.y * gk; scr[kk * 33 + cc + 2] = w.z * gk; scr[kk * 33 + cc + 3] = w.w * gk; }
    asm volatile("s_waitcnt lgkmcnt(0)" ::: "memory");
    const int c = lane & 7;
    const bool qkmap = (mode == 2) && nb < 32 && ((nb >> 2) & 1) == 0;
#pragma unroll
    for (int j = 0; j < 4; ++j) { const int n = (lane >> 3) + 8 * j; const int ncol = (qkmap && n < 16) ? 4 * (n >> 3) + 8 * ((n >> 2) & 1) + (n & 3) : n; const LAS float* s = scr + (8 * c) * 33 + ncol;
        v4u o; o.x = pk2(s[0 * 33], s[1 * 33]); o.y = pk2(s[2 * 33], s[3 * 33]); o.z = pk2(s[4 * 33], s[5 * 33]); o.w = pk2(s[6 * 33], s[7 * 33]);
        *(v4u*)(WT + (size_t)(n0d + n) * K + k0d + 8 * c) = o; }
    asm volatile("s_waitcnt lgkmcnt(0)" ::: "memory");
}
__device__ __forceinline__ void xprep_row(const float* xrow, bf16* orow, float* ssrow, int lane) {
    const v4f* xr = (const v4f*)xrow + lane;
    v4f v[4]; float s = 0.f;
#pragma unroll
    for (int j = 0; j < 4; ++j) { v[j] = __builtin_nontemporal_load(xr + 64 * j); s += (v[j].x * v[j].x + v[j].y * v[j].y) + (v[j].z * v[j].z + v[j].w * v[j].w); }
    s = wave_sum(s);
    unsigned long long* o8 = (unsigned long long*)orow + lane;
#pragma unroll
    for (int j = 0; j < 4; ++j) o8[64 * j] = (unsigned long long)pk2(v[j].x, v[j].y) | ((unsigned long long)pk2(v[j].z, v[j].w) << 32);
    if (lane < 16) ssrow[lane] = lane == 0 ? s : 0.f;
}

struct Args {
    const float* in[25]; float* out; unsigned char* ws; float invf[8]; int ph_lo, ph_hi;
};
constexpr int NWAVES = 8, NTHREADS = 512;
constexpr int RING_BYTES = 131072, MISC_OFF = RING_BYTES + 256, LDS_BYTES = 147456;
constexpr int CW_BAR = 4096;
constexpr size_t CTL_ZERO_BYTES = 65536;

__device__ __forceinline__ void p0_rows_all(const Args& a, int tid);
__device__ __forceinline__ void p0_prologue(const Args& a, LAS unsigned char* lds, int tid, int r_lo, int r_hi, bool rows_too) {
    const int lane = tid & 63, wave = tid >> 6;
    LAS float* scr = (LAS float*)(lds + wave * 16384);
    const int gw = blockIdx.x * NWAVES + wave, NGW = gridDim.x * NWAVES;
    unsigned char* ws = a.ws;
    constexpr int I1 = (DM / 64) * (NFF / 32), I2 = (DFF / 64) * (DM / 32), I3 = (DM / 64) * (NPROJ / 32), I4 = (DM / 64) * (DM / 32);
    constexpr int NIT = 2 * I1 + 2 * I2 + I3 + I4;
    for (int it = gw + r_lo * NGW, rd = r_lo; it < NIT && rd < r_hi; it += NGW, ++rd) {
        int r = it;
        if (r < I1) { transpose_item(a.in[3], DM, NFF, a.in[2], (bf16*)(ws + WS_W1T), 1, scr, r, lane); continue; } r -= I1;
        if (r < I1) { transpose_item(a.in[23], DM, NFF, a.in[22], (bf16*)(ws + WS_W5T), 1, scr, r, lane); continue; } r -= I1;
        if (r < I2) { transpose_item(a.in[4], DFF, DM, nullptr, (bf16*)(ws + WS_W2T), 3, scr, r, lane); continue; } r -= I2;
        if (r < I2) { transpose_item(a.in[24], DFF, DM, nullptr, (bf16*)(ws + WS_W6T), 3, scr, r, lane); continue; } r -= I2;
        if (r < I3) { transpose_item(a.in[6], DM, NPROJ, a.in[5], (bf16*)(ws + WS_W3T), 2, scr, r, lane); continue; } r -= I3;
        transpose_item(a.in[21], DM, DM, nullptr, (bf16*)(ws + WS_W4T), 0, scr, r, lane);
    }
    if (rows_too) p0_rows_all(a, tid);
}
__device__ __forceinline__ void p0_rows_all(const Args& a, int tid) {
    const int lane = tid & 63, wave = tid >> 6; const int gw = blockIdx.x * NWAVES + wave, NGW = gridDim.x * NWAVES; unsigned char* ws = a.ws;
    const float* x = a.in[0];
    for (int m = gw; m < MTOK; m += NGW) xprep_row(x + (size_t)m * DM, (bf16*)(ws + WS_XB) + (size_t)m * DM, (float*)(ws + WS_SS) + (size_t)m * 16, lane);
    float* tab = (float*)(ws + WS_ROPE); const int* pos = (const int*)a.in[1];
    for (int i = blockIdx.x * NTHREADS + tid; i < MTOK * 8; i += gridDim.x * NTHREADS) {
        const int row = i >> 3, j = i & 7;
        const float ang = (float)pos[row] * a.invf[j];
        tab[row * 16 + j] = (float)cos((double)ang); tab[row * 16 + 8 + j] = (float)sin((double)ang);
    }
}
__device__ __forceinline__ void p0_rows_own(const Args& a, int tid) {
    const int lane = tid & 63, wave = tid >> 6; unsigned char* ws = a.ws;
    const int xl = (int)blockIdx.x & 7, jg = ((int)blockIdx.x >> 3) & 7, m4 = (int)blockIdx.x >> 6, pA = 16 * xl + jg, pB = pA + 8;
    const float* x = a.in[0];
    for (int i = 0; i < 16; ++i) { const int r = m4 * 8 + wave + 32 * i, m = (r < 256 ? pA : pB) * 256 + (r & 255);
        xprep_row(x + (size_t)m * DM, (bf16*)(ws + WS_XB) + (size_t)m * DM, (float*)(ws + WS_SS) + (size_t)m * 16, lane); }
    float* tab = (float*)(ws + WS_ROPE); const int* pos = (const int*)a.in[1];
    for (int e = m4 * NTHREADS + tid; e < 512 * 8; e += 4 * NTHREADS) {
        const int r = e >> 3, j = e & 7, row = (r < 256 ? pA : pB) * 256 + (r & 255);
        const float ang = (float)pos[row] * a.invf[j];
        tab[row * 16 + j] = (float)cos((double)ang); tab[row * 16 + 8 + j] = (float)sin((double)ang);
    }
}

constexpr int RTAB_OFF = RING_BYTES + 1024;
struct RinvPre {
    const float* ss; int pmA, pmB; LAS float* rtab;
    __device__ __forceinline__ void operator()() const { const int tid = threadIdx.x; const size_t row = (size_t)((tid >> 8) ? pmB : pmA) * 256 + (tid & 255); rtab[tid] = rinv_of(ss, row); }
};
__device__ __forceinline__ RinvPre rinv_prepass(const float* ss, const pg8::StaticOrder& S, LAS unsigned char* lds) {
    pg8::Unit u; int n = 0; while (S.next(n, u)) ++n;
    RinvPre p{ss, 0, 0, (LAS float*)(lds + RTAB_OFF)};
    if (n == 0) return p;
    S.next(0, u); p.pmA = u.pm; S.next(n - 1, u); p.pmB = u.pm;
    return p;
}
struct RevOrder : pg8::StaticOrder {
    int n;
    __device__ void init_rev(int M, int N, int G_, int c_) { init(M, N, G_, c_); pg8::Unit u; n = 0; while (pg8::StaticOrder::next(n, u)) ++n; }
    __device__ bool next(int i, pg8::Unit& u) const { return i < n ? pg8::StaticOrder::next(n - 1 - i, u) : false; }
};
struct BMid { LAS unsigned char* lds; const bf16* Bt; int K, pn; __device__ __forceinline__ void operator()() const { pg8::stage_b_first(lds, Bt, K, pn); } };
__device__ __forceinline__ int first_pn_static(int M, int N, int G, int c) { pg8::StaticOrder S; S.init(M, N, G, c); pg8::Unit u; return S.next(0, u) ? u.pn : 0; }
__device__ __forceinline__ int first_pn_rev(int M, int N, int G, int c) { RevOrder S; S.init_rev(M, N, G, c); pg8::Unit u; return S.next(0, u) ? u.pn : 0; }
#ifndef PG8_ALIGN
#define PG8_ALIGN true
#endif
#ifndef PG8_SP2
#define PG8_SP2 true
#endif
__global__ void __launch_bounds__(NTHREADS, 2) mk_fwd(Args a) {
    extern __shared__ __attribute__((aligned(16))) unsigned char lds_raw[];
    cg::grid_group grid = cg::this_grid();
    LAS unsigned char* lds = (LAS unsigned char*)lds_raw;
    const int tid = threadIdx.x;
    unsigned char* ws = a.ws;
    const int lo = a.ph_lo, hi = a.ph_hi, G = gridDim.x;
    bf16 *W1T = (bf16*)(ws + WS_W1T), *W2T = (bf16*)(ws + WS_W2T), *W3T = (bf16*)(ws + WS_W3T), *W4T = (bf16*)(ws + WS_W4T), *W5T = (bf16*)(ws + WS_W5T), *W6T = (bf16*)(ws + WS_W6T);
    float* tab = (float*)(ws + WS_ROPE); float* ss0 = (float*)(ws + WS_SS); float* ss1 = ss0 + (size_t)MTOK * 16; float* ss2 = ss1 + (size_t)MTOK * 16;
    bf16 *XB = (bf16*)(ws + WS_XB), *Y = (bf16*)(ws + WS_Y), *ACT = (bf16*)(ws + WS_ACT);
    bf16 *Qb = ACT, *Kb = ACT + 512, *Vb = ACT + 1024, *XR = ACT + 1536, *GATE = ACT + 2048;
    float* out = a.out;
#ifndef PROBE_DUP
#define PROBE_DUP -1
#endif
#define REP(k) for (int rep_ = 0; rep_ < ((PROBE_DUP) == (k) ? 2 : 1); ++rep_)
#define REPSYNC() do { if (rep_) xcd_barrier(bar); } while (0)
#define IN(k) (lo <= (k) && (k) < hi)
    volatile LAS unsigned* MISC = (volatile LAS unsigned*)(lds + MISC_OFF);
    if (tid < 16) MISC[tid] = 0u;
    __syncthreads();
    XcdBarrier bar = xcd_barrier_post((unsigned*)(ws + WS_CTL) + CW_BAR, MISC + 8);
    if (tid == 0) __hip_atomic_store((unsigned*)(ws + WS_CTL) + CW_BAR + XL_TABLE + blockIdx.x, bar.x + 1u, __ATOMIC_RELAXED, __HIP_MEMORY_SCOPE_AGENT);
    const unsigned pgrp = ((unsigned)blockIdx.x & 7u) * 8u + (((unsigned)blockIdx.x >> 3) & 7u);
    bool split_b = false;
    bool local_ok = false;
#ifndef MK_LOCAL_SEAMS
#define MK_LOCAL_SEAMS 1
#endif
#ifndef MK_GROUP_SEAMS
#define MK_GROUP_SEAMS 1
#endif
#ifndef MK_CG_SEAM0
#define MK_CG_SEAM0 0
#endif
#define SEAMX(k, MID) do { if (IN(k) && IN((k) + 1)) { if (MK_CG_SEAM0 && (k) == 0) grid.sync(); else if (MK_LOCAL_SEAMS && local_ok && MK_GROUP_SEAMS && ((k) == 1 || (k) == 2 || (k) == 5 || (k) == 6)) panel_group_barrier(bar, pgrp, MID); else if (MK_LOCAL_SEAMS && local_ok && (k) >= 1) xcd_local_barrier(bar, MID); else xcd_barrier(bar, MID); } } while (0)
#define SEAM(k) SEAMX(k, NoMid())
#define BPRE(k) (IN(k) && IN((k) + 1) && !(MK_CG_SEAM0 && (k) == 0))

    const BMid mid1{lds, W1T, DM, first_pn_static(MTOK, NFF, G, (int)blockIdx.x)};
    if (IN(0) && tid < 16) { float* idt = (float*)(ws + WS_CTL + 65536);
        for (int r = (int)blockIdx.x; r < 256; r += G) idt[r * 16 + tid] = tid < 8 ? 1.0f : 0.0f; }
    if (G == 256 && lo == 0 && hi > 2 && !MK_CG_SEAM0) {
        p0_prologue(a, lds, tid, 0, 2, false);
        xcd_split_arrive(bar, 0);
        p0_rows_own(a, tid);
        p0_prologue(a, lds, tid, 2, 1 << 20, false);
        xcd_split_arrive(bar, 1);
        xcd_split_wait(bar, 0, 0);
        __syncthreads();
        if (MK_LOCAL_SEAMS) {
            const unsigned* tblx = (const unsigned*)(ws + WS_CTL) + CW_BAR + XL_TABLE;
            bool okt = true;
            if (tid < 256) { const unsigned mine = __hip_atomic_load(tblx + tid, __ATOMIC_RELAXED, __HIP_MEMORY_SCOPE_AGENT), lead = __hip_atomic_load(tblx + (tid & 7), __ATOMIC_RELAXED, __HIP_MEMORY_SCOPE_AGENT); okt = (mine == lead) && mine != 0u;
                if (tid < 8) { for (int j = 0; j < 8; ++j) if (j != tid && __hip_atomic_load(tblx + j, __ATOMIC_RELAXED, __HIP_MEMORY_SCOPE_AGENT) == mine) okt = false; } }
            local_ok = __syncthreads_and(okt ? 1 : 0) != 0;
        }
        if (MK_LOCAL_SEAMS && local_ok && MK_GROUP_SEAMS) panel_group_barrier(bar, pgrp, mid1); else xcd_barrier(bar, mid1);
        split_b = true;
    } else {
        if (IN(0)) { p0_prologue(a, lds, tid, 0, 1 << 20, true); }
        SEAMX(0, mid1);
    }
#ifdef PROBE_SYNCS
    for (int i_ = 0; i_ < PROBE_SYNCS; ++i_) xcd_barrier(bar);
#endif
    if (IN(1)) REP(1) { REPSYNC(); pg8::Gemm g{XB, W1T, MTOK, NFF, DM}; pg8::StaticOrder S; S.init(MTOK, NFF, G, (int)blockIdx.x);
        const RinvPre rp = rinv_prepass(ss0, S, lds); pg8::EpiSwiglu E{ACT, (const LAS float*)(lds + RTAB_OFF), rp.pmA}; pg8::gemm_phase<pg8::EpiSwiglu, pg8::StaticOrder, PG8_ALIGN, PG8_SP2, RinvPre>(lds, g, S, E, rp, BPRE(0)); }
    if (split_b) xcd_split_wait(bar, 1, 64);
    { const BMid mid{lds, W2T, DFF, first_pn_rev(MTOK, DM, G, (int)blockIdx.x)}; SEAMX(1, mid); }
    if (IN(2)) REP(2) { REPSYNC(); pg8::Gemm g{ACT, W2T, MTOK, DM, DFF}; RevOrder S; S.init_rev(MTOK, DM, G, (int)blockIdx.x);
        pg8::EpiResid<true, true> E{nullptr, XB, nullptr, ss1, 0.5f}; pg8::gemm_phase<pg8::EpiResid<true, true>, RevOrder, PG8_ALIGN, PG8_SP2>(lds, g, S, E, pg8::NoPre(), BPRE(1)); }
    { const BMid mid{lds, W3T, DM, first_pn_static(MTOK, NPROJ, G, (int)blockIdx.x)}; SEAMX(2, mid); }
    if (IN(3)) REP(3) { REPSYNC(); pg8::Gemm g{XB, W3T, MTOK, NPROJ, DM}; pg8::StaticOrder S; S.init(MTOK, NPROJ, G, (int)blockIdx.x);
        const RinvPre rp = rinv_prepass(ss1, S, lds); pg8::EpiProj E{(const LAS float*)(lds + RTAB_OFF), rp.pmA, tab, a.in[7], a.in[8], Qb, 0.125f * 1.4426950408889634f, (const float*)(ws + WS_CTL + 65536)}; pg8::gemm_phase<pg8::EpiProj, pg8::StaticOrder, PG8_ALIGN, PG8_SP2, RinvPre>(lds, g, S, E, rp, BPRE(2)); }
    if (IN(3) && IN(4)) {
        const int vcu0 = (G % 8 == 0) ? ((int)blockIdx.x % 8) * (G / 8) + (int)blockIdx.x / 8 : (int)blockIdx.x;
        if (vcu0 < BATCH * 16) rnn::rnn_consts((vcu0 >> 1) & 7, vcu0 & 1, a.in[14], a.in[15], a.in[16], a.in[17], a.in[18], a.in[19], a.in[20], lds);
        const int l64 = tid & 63;
        float d1 = a.in[9][l64] * a.in[10][l64], d2 = a.in[11][l64] * a.in[12][l64], gq = fabsf(a.in[7][l64]), gk = fabsf(a.in[8][l64]);
        d1 = wave_sum(d1); d2 = wave_sum(d2);
#pragma unroll
        for (int o_ = 1; o_ < 64; o_ <<= 1) { gq = fmaxf(gq, __shfl_xor(gq, o_)); gk = fmaxf(gk, __shfl_xor(gk, o_)); }
        if (tid == 0) { MISC[4] = __float_as_uint(expf(d1) - expf(d2) + LAMBDA_INIT); MISC[5] = __float_as_uint(-8.0f * gq * gk * 1.4426950408889634f); }
    }
    SEAM(3);
    if (IN(4)) {
        const int vcu = (G % 8 == 0) ? ((int)blockIdx.x % 8) * (G / 8) + (int)blockIdx.x / 8 : (int)blockIdx.x;
        if (lo > 3) { for (int u = vcu; u < BATCH * 16; u += G) rnn::rnn_unit<false>(u >> 4, (u >> 1) & 7, u & 1, XR, GATE, Y, a.in[14], a.in[15], a.in[16], a.in[17], a.in[18], a.in[19], a.in[20], lds);
            if (tid == 0) { MISC[4] = 0x7fc00000u; MISC[5] = 0x7fc00000u; } __syncthreads(); }
        else { if (vcu < BATCH * 16) rnn::rnn_unit<true>(vcu >> 4, (vcu >> 1) & 7, vcu & 1, XR, GATE, Y, a.in[14], a.in[15], a.in[16], a.in[17], a.in[18], a.in[19], a.in[20], lds);
            for (int u = vcu + G; u < BATCH * 16; u += G) rnn::rnn_unit<false>(u >> 4, (u >> 1) & 7, u & 1, XR, GATE, Y, a.in[14], a.in[15], a.in[16], a.in[17], a.in[18], a.in[19], a.in[20], lds); }
        const float lam = __uint_as_float(MISC[4]), negm_s = __uint_as_float(MISC[5]);
        REP(42) for (int v = vcu; v < 256; v += G) {
            const int bh = v >> 2, s = v & 3;
            attn::attn_cu(bh >> 2, bh & 3, s, Qb, Kb, Vb, Y, lam, negm_s, a.in[13], lds);
        }
        __syncthreads();
    }
    { const BMid mid{lds, W4T, DM, first_pn_static(MTOK, DM, G, (int)blockIdx.x)}; SEAMX(4, mid); }
    if (IN(5)) { pg8::Gemm g{Y, W4T, MTOK, DM, DM}; pg8::StaticOrder S; S.init(MTOK, DM, G, (int)blockIdx.x);
        pg8::EpiResid<true, true> E{nullptr, XB, nullptr, ss2, 1.0f}; pg8::gemm_phase<pg8::EpiResid<true, true>, pg8::StaticOrder, PG8_ALIGN, PG8_SP2>(lds, g, S, E, pg8::NoPre(), BPRE(4)); }
    { const BMid mid{lds, W5T, DM, first_pn_static(MTOK, NFF, G, (int)blockIdx.x)}; SEAMX(5, mid); }
    if (IN(6)) REP(6) { REPSYNC(); pg8::Gemm g{XB, W5T, MTOK, NFF, DM}; pg8::StaticOrder S; S.init(MTOK, NFF, G, (int)blockIdx.x);
        const RinvPre rp = rinv_prepass(ss2, S, lds); pg8::EpiSwiglu E{ACT, (const LAS float*)(lds + RTAB_OFF), rp.pmA}; pg8::gemm_phase<pg8::EpiSwiglu, pg8::StaticOrder, PG8_ALIGN, PG8_SP2, RinvPre>(lds, g, S, E, rp, BPRE(5)); }
    { const BMid mid{lds, W6T, DFF, first_pn_rev(MTOK, DM, G, (int)blockIdx.x)}; SEAMX(6, mid); }
    if (IN(7)) { pg8::Gemm g{ACT, W6T, MTOK, DM, DFF}; RevOrder S; S.init_rev(MTOK, DM, G, (int)blockIdx.x);
        pg8::EpiResid<true, false> E{nullptr, XB, out, nullptr, 0.5f}; pg8::gemm_phase<pg8::EpiResid<true, false>, RevOrder, PG8_ALIGN, PG8_SP2>(lds, g, S, E, pg8::NoPre(), BPRE(6)); }
#undef IN
#undef SEAM
#undef SEAMX
#undef BPRE
}

extern "C" void kernel_launch(void* const* d_in, const int* in_sizes, int n_in, void* d_out, int out_size, void* d_ws, size_t ws_size, hipStream_t stream) {
    static int grid_blocks = 0;
    if (grid_blocks == 0) {
        if (n_in != 25 || in_sizes[0] != MTOK * DM || out_size != MTOK * DM || ws_size < WS_END) { fprintf(stderr, "kernel_launch: unexpected shapes (n_in %d, ws %zu)\n", n_in, ws_size); grid_blocks = -1; return; }
        int dev = 0, cus = 0, per_cu = 0;
        if (hipGetDevice(&dev) != hipSuccess || hipDeviceGetAttribute(&cus, hipDeviceAttributeMultiprocessorCount, dev) != hipSuccess) { grid_blocks = -1; return; }
        if (hipFuncSetAttribute((const void*)mk_fwd, hipFuncAttributeMaxDynamicSharedMemorySize, LDS_BYTES) != hipSuccess) { fprintf(stderr, "kernel_launch: hipFuncSetAttribute failed\n"); grid_blocks = -1; return; }
        if (hipOccupancyMaxActiveBlocksPerMultiprocessor(&per_cu, (const void*)mk_fwd, NTHREADS, LDS_BYTES) != hipSuccess || per_cu < 1) { fprintf(stderr, "kernel_launch: occupancy query says %d blocks/CU\n", per_cu); grid_blocks = -1; return; }
        if (cus != 256) { fprintf(stderr, "kernel_launch: built for a 256-CU device (MI355X), found %d CUs; nothing launched\n", cus); grid_blocks = -1; return; }
        grid_blocks = 256;
    }
    if (grid_blocks < 0) return;
    if (hipMemsetAsync((char*)d_ws + WS_CTL, 0, CTL_ZERO_BYTES, stream) != hipSuccess) { fprintf(stderr, "kernel_launch: hipMemsetAsync failed\n"); return; }
    Args a{};
    for (int i = 0; i < 25; ++i) a.in[i] = (const float*)d_in[i];
    a.out = (float*)d_out; a.ws = (unsigned char*)d_ws;
    for (int j = 0; j < 8; ++j) a.invf[j] = (float)pow(500000.0, -(double)j / 8.0);
    a.ph_lo = 0; a.ph_hi = 8;
    void* args[] = {&a};
    hipError_t e = hipLaunchCooperativeKernel((const void*)mk_fwd, dim3(grid_blocks), dim3(NTHREADS), args, LDS_BYTES, stream);
    if (e != hipSuccess) fprintf(stderr, "cooperative launch failed: %s (grid %d)\n", hipGetErrorString(e), grid_blocks);
}
```
